# Optimizing an MI355X kernel written in HIP

```python
import math
import jax, jax.numpy as jnp
from jax import lax
import numpy as np

D_MODEL = 1024
BATCH = 16
SEQ = 256
DEPTH = 4
DEC_BATCH = 8
DEC_SEQ = 2048
PAST_LEN = 512

GRID_W = 64
HEAD_DIM = 64
A_HEADS = 8
A_KV_HEADS = 2
B_HEADS = 8
C_HEADS = 8
NA_ROWS = 8
NA_COLS = 16
D_FF = 2816
N_MOD = 9
N_EVEN = (DEPTH + 1) // 2
N_ODD = DEPTH // 2
Q_BLOCK = 128
ROPE_THETA = 10000.0
NORM_EPS = 1e-6
MASK_VALUE = -1e30
AB_IN = (A_HEADS + 2 * A_KV_HEADS + 3 * B_HEADS) * HEAD_DIM
AB_OUT = (A_HEADS + B_HEADS) * HEAD_DIM
C_IN = 3 * C_HEADS * 2 * HEAD_DIM
C_OUT = C_HEADS * 2 * HEAD_DIM

kernel_name = 'hybrid_diffusion_prefix_trunk_step'


def rmsnorm(x, w):
    xf = x.astype(jnp.float32)
    y = xf * lax.rsqrt(jnp.mean(xf * xf, axis=-1, keepdims=True) + NORM_EPS)
    return (y * w.astype(jnp.float32)).astype(x.dtype)


def swiglu(h, w1, w3, w2):
    return (jax.nn.silu(h @ w1) * (h @ w3)) @ w2


def rope_tables(n_tokens, dim, dtype):
    t = jnp.arange(n_tokens)
    row = (t // GRID_W).astype(jnp.float32)
    col = (t % GRID_W).astype(jnp.float32)
    n_freq = dim // 4
    inv_freq = ROPE_THETA ** (-jnp.arange(n_freq, dtype=jnp.float32) / n_freq)
    ang_r = row[:, None] * inv_freq
    ang_c = col[:, None] * inv_freq
    ang = jnp.concatenate([ang_r, ang_r, ang_c, ang_c], axis=-1)
    return jnp.cos(ang).astype(dtype), jnp.sin(ang).astype(dtype)


def apply_axial_rope(x, cos, sin):
    S, Dh = cos.shape
    shape = (1, S) + (1,) * (x.ndim - 3) + (Dh,)
    cos = cos.reshape(shape)
    sin = sin.reshape(shape)
    x1r, x2r, x1c, x2c = jnp.split(x, 4, axis=-1)
    rot = jnp.concatenate([-x2r, x1r, -x2c, x1c], axis=-1)
    return x * cos + rot * sin


def map_query_blocks(fn, q):
    B, S = q.shape[0], q.shape[1]
    nb = S // Q_BLOCK
    qb = jnp.moveaxis(q.reshape((B, nb, Q_BLOCK) + q.shape[2:]), 1, 0)
    out = lax.map(fn, (jnp.arange(nb), qb))
    out = jnp.moveaxis(out, 0, 1)
    return out.reshape((B, S) + out.shape[3:])


def gqa_attention(q, k, v):
    B, S, Hq, Dh = q.shape
    Hkv = k.shape[2]
    G = Hq // Hkv
    Dv = v.shape[-1]
    scale = Dh ** -0.5

    def block(args):
        _, qb = args
        qg = qb.reshape(B, Q_BLOCK, Hkv, G, Dh)
        s = jnp.einsum('bqhgd,bkhd->bhgqk', qg, k).astype(jnp.float32) * scale
        p = jax.nn.softmax(s, axis=-1).astype(v.dtype)
        o = jnp.einsum('bhgqk,bkhd->bqhgd', p, v)
        return o.reshape(B, Q_BLOCK, Hq, Dv)

    return map_query_blocks(block, q)


def neighbourhood_attention(q, k, v, k_ctx, v_ctx, rpb):
    B, S, H, Dh = q.shape
    rows = S // GRID_W
    win_r = min(NA_ROWS, rows)
    win_c = min(NA_COLS, GRID_W)
    q_rows = Q_BLOCK // GRID_W
    band = min(win_r + q_rows - 1, rows)
    n_band = band * GRID_W
    scale = Dh ** -0.5
    k_grid = k.reshape(B, rows, GRID_W, H, Dh)
    v_grid = v.reshape(B, rows, GRID_W, H, v.shape[-1])
    q_local = jnp.arange(Q_BLOCK)
    q_col = q_local % GRID_W
    k_local = jnp.arange(n_band)
    k_col = k_local % GRID_W
    col_start = jnp.clip(q_col - win_c // 2, 0, GRID_W - win_c)
    col_in = (k_col[None, :] >= col_start[:, None]) & (k_col[None, :] < col_start[:, None] + win_c)
    dc = jnp.clip(k_col[None, :] - q_col[:, None] + NA_COLS - 1, 0, 2 * NA_COLS - 2)

    def block(args):
        j, qb = args
        q_row = j * q_rows + q_local // GRID_W
        row_start = jnp.clip(q_row - win_r // 2, 0, rows - win_r)
        band_start = jnp.clip(row_start[0], 0, rows - band)
        kb = lax.dynamic_slice_in_dim(k_grid, band_start, band, axis=1).reshape(B, n_band, H, Dh)
        vb = lax.dynamic_slice_in_dim(v_grid, band_start, band, axis=1).reshape(B, n_band, H, v.shape[-1])
        k_row = band_start + k_local // GRID_W
        row_in = (k_row[None, :] >= row_start[:, None]) & (k_row[None, :] < row_start[:, None] + win_r)
        dr = jnp.clip(k_row[None, :] - q_row[:, None] + NA_ROWS - 1, 0, 2 * NA_ROWS - 2)
        bias = rpb[:, dr, dc].astype(jnp.float32)
        s_nb = jnp.einsum('bqhd,bkhd->bhqk', qb, kb).astype(jnp.float32) * scale + bias
        s_nb = jnp.where(row_in & col_in, s_nb, MASK_VALUE)
        s_ctx = jnp.einsum('bqhd,bkhd->bhqk', qb, k_ctx).astype(jnp.float32) * scale
        p = jax.nn.softmax(jnp.concatenate([s_nb, s_ctx], axis=-1), axis=-1).astype(v.dtype)
        return (jnp.einsum('bhqk,bkhd->bqhd', p[..., :n_band], vb)
                + jnp.einsum('bhqk,bkhd->bqhd', p[..., n_band:], v_ctx))

    return map_query_blocks(block, q)


def diff_attention(q, k, v, lam):
    Dh = q.shape[-1]
    scale = Dh ** -0.5

    def block(args):
        _, qb = args
        s = jnp.einsum('bqhjd,bkhjd->bhjqk', qb, k).astype(jnp.float32) * scale
        p = jax.nn.softmax(s, axis=-1)
        a = (p[:, :, 0] - lam * p[:, :, 1]).astype(v.dtype)
        return jnp.einsum('bhqk,bkhd->bqhd', a, v)

    return map_query_blocks(block, q)


def diff_lambda(lam_params, lam_init):
    lp = lam_params.astype(jnp.float32)
    return jnp.exp(jnp.sum(lp[0] * lp[1])) - jnp.exp(jnp.sum(lp[2] * lp[3])) + lam_init


def even_project(h, w_in, q_norm, k_norm):
    B, S, _ = h.shape
    sizes = [A_HEADS * HEAD_DIM, A_KV_HEADS * HEAD_DIM, A_KV_HEADS * HEAD_DIM,
             B_HEADS * HEAD_DIM, B_HEADS * HEAD_DIM]
    splits = [sum(sizes[:i + 1]) for i in range(len(sizes))]
    aq, ak, av, bq, bk, bv = jnp.split(h @ w_in, splits, axis=-1)
    aq = rmsnorm(aq.reshape(B, S, A_HEADS, HEAD_DIM), q_norm)
    ak = rmsnorm(ak.reshape(B, S, A_KV_HEADS, HEAD_DIM), k_norm)
    av = av.reshape(B, S, A_KV_HEADS, HEAD_DIM)
    bq = bq.reshape(B, S, B_HEADS, HEAD_DIM)
    bk = bk.reshape(B, S, B_HEADS, HEAD_DIM)
    bv = bv.reshape(B, S, B_HEADS, HEAD_DIM)
    return aq, ak, av, bq, bk, bv


def even_merge(oa, ob, w_out):
    B, S = oa.shape[0], oa.shape[1]
    return jnp.concatenate([oa.reshape(B, S, -1), ob.reshape(B, S, -1)], axis=-1) @ w_out


def even_mixer_ctx(h, w_in, w_out, q_norm, k_norm):
    aq, ak, av, bq, bk, bv = even_project(h, w_in, q_norm, k_norm)
    oa = gqa_attention(aq, ak, av)
    ob = gqa_attention(bq, bk, bv)
    return even_merge(oa, ob, w_out), (ak, av, bk, bv)


def even_mixer_lat(h, w_in, w_out, q_norm, k_norm, rpb, cos, sin, ak_c, av_c, bk_c, bv_c):
    aq, ak, av, bq, bk, bv = even_project(h, w_in, q_norm, k_norm)
    aq = apply_axial_rope(aq, cos, sin)
    ak = apply_axial_rope(ak, cos, sin)
    oa = gqa_attention(aq, jnp.concatenate([ak, ak_c], axis=1), jnp.concatenate([av, av_c], axis=1))
    ob = neighbourhood_attention(bq, bk, bv, bk_c, bv_c, rpb)
    return even_merge(oa, ob, w_out), ()


def odd_project(h, w_in):
    B, S, _ = h.shape
    q, k, v = jnp.split(h @ w_in, 3, axis=-1)
    return (q.reshape(B, S, C_HEADS, 2, HEAD_DIM), k.reshape(B, S, C_HEADS, 2, HEAD_DIM),
            v.reshape(B, S, C_HEADS, 2 * HEAD_DIM))


def odd_output(o, subln, lam_init, w_out):
    B, S = o.shape[0], o.shape[1]
    o = rmsnorm(o, subln) * (1.0 - lam_init)
    return o.reshape(B, S, C_OUT) @ w_out


def odd_mixer_ctx(h, w_in, w_out, lam_params, subln, lam_init):
    B, S, _ = h.shape
    q, k, v = odd_project(h, w_in)
    o = diff_attention(q, k, v, diff_lambda(lam_params, lam_init))
    return odd_output(o, subln, lam_init, w_out), (k.reshape(B, S, C_HEADS, 2 * HEAD_DIM), v)


def odd_mixer_lat(h, w_in, w_out, lam_params, subln, lam_init, cos, sin, k_c, v_c):
    B, _, _ = h.shape
    q, k, v = odd_project(h, w_in)
    q = apply_axial_rope(q, cos, sin)
    k = apply_axial_rope(k, cos, sin)
    k_c = k_c.reshape(B, k_c.shape[1], C_HEADS, 2, HEAD_DIM)
    o = diff_attention(q, jnp.concatenate([k, k_c], axis=1), jnp.concatenate([v, v_c], axis=1),
                       diff_lambda(lam_params, lam_init))
    return odd_output(o, subln, lam_init, w_out), ()


def macaron_layer(x, mod, norm_w, w1, w3, w2, mixer):
    m = [mod[:, i][:, None, :] for i in range(N_MOD)]
    h = rmsnorm(x, norm_w[0]) * (1.0 + m[1]) + m[0]
    x = x + 0.5 * m[2] * swiglu(h, w1[0], w3[0], w2[0])
    h = rmsnorm(x, norm_w[1]) * (1.0 + m[4]) + m[3]
    mix_out, extras = mixer(h)
    x = x + m[5] * mix_out
    h = rmsnorm(x, norm_w[2]) * (1.0 + m[7]) + m[6]
    x = x + 0.5 * m[8] * swiglu(h, w1[1], w3[1], w2[1])
    return x, extras


def setup_inputs(seed: int = 0) -> dict:
    key = jax.random.key(seed)
    ks = jax.random.split(key, 32)
    f32 = jnp.float32

    def nrm(k, shape, scale=1.0):
        return jax.random.normal(k, shape, f32) * scale

    return {
        'x_prompt': nrm(ks[0], (BATCH, SEQ, D_MODEL)),
        'x_sample': nrm(ks[1], (DEC_BATCH, DEC_SEQ, D_MODEL)),
        'cache_a_k': nrm(ks[2], (DEC_BATCH, N_EVEN, PAST_LEN, A_KV_HEADS, HEAD_DIM)),
        'cache_a_v': nrm(ks[3], (DEC_BATCH, N_EVEN, PAST_LEN, A_KV_HEADS, HEAD_DIM)),
        'cache_b_k': nrm(ks[4], (DEC_BATCH, N_EVEN, PAST_LEN, B_HEADS, HEAD_DIM)),
        'cache_b_v': nrm(ks[5], (DEC_BATCH, N_EVEN, PAST_LEN, B_HEADS, HEAD_DIM)),
        'cache_c_k': nrm(ks[6], (DEC_BATCH, N_ODD, PAST_LEN, C_HEADS, 2 * HEAD_DIM)),
        'cache_c_v': nrm(ks[7], (DEC_BATCH, N_ODD, PAST_LEN, C_HEADS, 2 * HEAD_DIM)),
        'c': nrm(ks[8], (DEC_BATCH, D_MODEL)),
        'c_ctx': nrm(ks[9], (D_MODEL,)),
        'w_mod': nrm(ks[10], (DEPTH, D_MODEL, N_MOD * D_MODEL), 0.5 * D_MODEL ** -0.5),
        'b_mod': nrm(ks[11], (DEPTH, N_MOD * D_MODEL), 0.01),
        'norm_w': 1.0 + nrm(ks[12], (DEPTH, 3, D_MODEL), 0.02),
        'ffn_w1': nrm(ks[13], (DEPTH, 2, D_MODEL, D_FF), D_MODEL ** -0.5),
        'ffn_w3': nrm(ks[14], (DEPTH, 2, D_MODEL, D_FF), D_MODEL ** -0.5),
        'ffn_w2': nrm(ks[15], (DEPTH, 2, D_FF, D_MODEL), D_FF ** -0.5),
        'w_in_ab': nrm(ks[16], (N_EVEN, D_MODEL, AB_IN), D_MODEL ** -0.5),
        'w_out_ab': nrm(ks[17], (N_EVEN, AB_OUT, D_MODEL), AB_OUT ** -0.5),
        'a_q_norm': 1.0 + nrm(ks[18], (N_EVEN, HEAD_DIM), 0.02),
        'a_k_norm': 1.0 + nrm(ks[19], (N_EVEN, HEAD_DIM), 0.02),
        'b_rpb': nrm(ks[20], (N_EVEN, B_HEADS, 2 * NA_ROWS - 1, 2 * NA_COLS - 1), 0.1),
        'w_in_c': nrm(ks[21], (N_ODD, D_MODEL, C_IN), D_MODEL ** -0.5),
        'w_out_c': nrm(ks[22], (N_ODD, C_OUT, D_MODEL), C_OUT ** -0.5),
        'c_lambda': nrm(ks[23], (N_ODD, 4, HEAD_DIM), 0.1),
        'c_subln': 1.0 + nrm(ks[24], (N_ODD, 2 * HEAD_DIM), 0.02),
        'final_norm': 1.0 + nrm(ks[25], (D_MODEL,), 0.02),
    }


def reference(x_prompt, x_sample, cache_a_k, cache_a_v, cache_b_k, cache_b_v, cache_c_k, cache_c_v,
              c, c_ctx, w_mod, b_mod, norm_w, ffn_w1, ffn_w3, ffn_w2, w_in_ab, w_out_ab,
              a_q_norm, a_k_norm, b_rpb, w_in_c, w_out_c, c_lambda, c_subln, final_norm):
    lam_inits = [0.8 - 0.6 * math.exp(-0.3 * l) for l in range(DEPTH)]

    xp = x_prompt
    ak_l, av_l, bk_l, bv_l, ck_l, cv_l = [], [], [], [], [], []
    for l in range(DEPTH):
        mod = (jax.nn.silu(c_ctx) @ w_mod[l] + b_mod[l]).reshape(1, N_MOD, D_MODEL)
        if l % 2 == 0:
            e = l // 2
            mixer = lambda h: even_mixer_ctx(h, w_in_ab[e], w_out_ab[e], a_q_norm[e], a_k_norm[e])
            xp, (ak, av, bk, bv) = macaron_layer(xp, mod, norm_w[l], ffn_w1[l], ffn_w3[l], ffn_w2[l], mixer)
            ak_l.append(ak); av_l.append(av); bk_l.append(bk); bv_l.append(bv)
        else:
            o = l // 2
            mixer = lambda h: odd_mixer_ctx(h, w_in_c[o], w_out_c[o], c_lambda[o], c_subln[o], lam_inits[l])
            xp, (ck, cv) = macaron_layer(xp, mod, norm_w[l], ffn_w1[l], ffn_w3[l], ffn_w2[l], mixer)
            ck_l.append(ck); cv_l.append(cv)
    y_prompt = rmsnorm(xp, final_norm)
    new_a_k = jnp.stack(ak_l, axis=1)
    new_a_v = jnp.stack(av_l, axis=1)
    new_b_k = jnp.stack(bk_l, axis=1)
    new_b_v = jnp.stack(bv_l, axis=1)
    new_c_k = jnp.stack(ck_l, axis=1)
    new_c_v = jnp.stack(cv_l, axis=1)

    xs = x_sample
    cos, sin = rope_tables(x_sample.shape[1], HEAD_DIM, x_sample.dtype)
    for l in range(DEPTH):
        mod = (jax.nn.silu(c) @ w_mod[l] + b_mod[l]).reshape(-1, N_MOD, D_MODEL)
        if l % 2 == 0:
            e = l // 2
            mixer = lambda h: even_mixer_lat(h, w_in_ab[e], w_out_ab[e], a_q_norm[e], a_k_norm[e], b_rpb[e],
                                             cos, sin, cache_a_k[:, e], cache_a_v[:, e],
                                             cache_b_k[:, e], cache_b_v[:, e])
        else:
            o = l // 2
            mixer = lambda h: odd_mixer_lat(h, w_in_c[o], w_out_c[o], c_lambda[o], c_subln[o], lam_inits[l],
                                            cos, sin, cache_c_k[:, o], cache_c_v[:, o])
        xs, _ = macaron_layer(xs, mod, norm_w[l], ffn_w1[l], ffn_w3[l], ffn_w2[l], mixer)
    y_sample = rmsnorm(xs, final_norm)

    return (y_prompt, y_sample, new_a_k, new_a_v, new_b_k, new_b_v, new_c_k, new_c_v)
```

```cpp
#include <hip/hip_runtime.h>
#include <hip/hip_cooperative_groups.h>
#include <cstdio>
#include <cstdint>
namespace cg = cooperative_groups;
__device__ __forceinline__ int opaque_tid() { int t = threadIdx.x; asm volatile("" : "+v"(t)); return t; }
namespace pg8 {
#define PG8_LAS __attribute__((address_space(3)))
typedef unsigned short bf16_t;
typedef short bf16x8 __attribute__((ext_vector_type(8)));
typedef float f32x4 __attribute__((ext_vector_type(4)));
typedef unsigned u32x4 __attribute__((ext_vector_type(4)));
constexpr int BM = 256, BK = 64, HALF = 128, HTB = HALF * BK * 2  , STAGE_BYTES = 8 * HTB, NXCD = 8, WGM = 8;

__host__ __device__ __forceinline__ int lds_byte(int r, int c) { const int st = (r >> 4) * 2 + (c >> 5), rr = r & 15, cc = c & 31, ob = rr * 64 + cc * 2; return st * 1024 + (ob ^ (((ob >> 9) & 1) << 5)); }
__host__ __device__ __forceinline__ void stage_rc(int b, int& R, int& C) { const int st = b / 1024, sb = b % 1024, swz = sb ^ (((sb >> 9) & 1) << 5); R = (st >> 1) * 16 + swz / 64; C = (st & 1) * 32 + (swz % 64) / 2; }
__host__ __device__ __forceinline__ int perm32(int rho) { const int n = rho >> 4, i = rho & 15; return 8 * (i >> 2) + 4 * n + (i & 3); }

struct Unit { int pm, pn; };
struct Gemm { const bf16_t* A; const bf16_t* Bt; int M, N, K; };

struct StaticOrder {
    int nM, nN, nwg, G, c;
    __host__ __device__ void init(int M, int N, int G_, int c_) { nM = M / BM; nN = N / BM; nwg = nM * nN; G = G_; c = c_; }
    __host__ __device__ bool next(int i, Unit& u) const {
        const long L = (long)i * G + c; if (L >= nwg) return false;
        int wgid = (int)L; { const int q = nwg / NXCD, r = nwg % NXCD, xcd = wgid % NXCD, off = wgid / NXCD; wgid = (xcd < r ? xcd * (q + 1) : r * (q + 1) + (xcd - r) * q) + off; }
        const int nig = WGM * nN, gid = wgid / nig, fm = gid * WGM, gsz = (nM - fm) < WGM ? (nM - fm) : WGM;
        u.pm = fm + ((wgid % nig) % gsz); u.pn = (wgid % nig) / gsz; return true;
    }
    __device__ __forceinline__ void a_ready(const Unit&) const {}
    __device__ __forceinline__ void done(const Unit&) const {}
};

template <class Epi, class Sched, bool ALIGN_EPI = false, bool SP2 = false>
__device__ __forceinline__ void gemm_phase(PG8_LAS unsigned char* lds, const Gemm g, const Sched& S, const Epi& E) {
    const int tid = opaque_tid(), wid = __builtin_amdgcn_readfirstlane(tid >> 6), lane = tid & 63, wr = wid >> 2, wc = wid & 3, fr = lane & 15, fq = lane >> 4;
    const int K = g.K, nt = K / BK;
    unsigned voffA[2], voffB[2];
#pragma unroll
    for (int i = 0; i < 2; ++i) { int R, C; stage_rc(tid * 16 + i * 8192, R, C); const int Rb = Epi::PERM ? ((R & ~31) + perm32(R & 31)) : R;
        voffA[i] = (unsigned)(R * K + C) * 2u; voffB[i] = (unsigned)(Rb * K + C) * 2u; }
    const size_t kstep = (size_t)(BK * 2);
    const size_t hstep = (size_t)HALF * K * 2;
    const size_t tstep = 2 * hstep;
    const unsigned ldsw = (unsigned)wid * 1024u;
    const int aoff = lds_byte(wr * 64 + fr, fq * 8), boff = lds_byte(wc * 32 + fr, fq * 8);
#define PG8_SA(b, h) (((b) * 2 + (h)) * HTB)
#define PG8_SB(b, h) ((4 + (b) * 2 + (h)) * HTB)
#define PG8_STAGE(bufoff, gbase, voff) do { _Pragma("unroll") for (int _i = 0; _i < 2; ++_i) \
        __builtin_amdgcn_global_load_lds((const unsigned*)((const char*)(gbase) + (voff)[_i]), (PG8_LAS unsigned*)(lds + (bufoff) + ldsw + _i * 8192), 16, 0, 0); } while (0)
#define PG8_LDA(dst, b, h) do { _Pragma("unroll") for (int m = 0; m < 4; ++m) _Pragma("unroll") for (int k = 0; k < 2; ++k) dst[m][k] = *(const PG8_LAS bf16x8*)(lds + PG8_SA(b, h) + aoff + m * 2048 + k * 1024); } while (0)
#define PG8_LDB(dst, b, h) do { _Pragma("unroll") for (int n = 0; n < 2; ++n) _Pragma("unroll") for (int k = 0; k < 2; ++k) dst[n][k] = *(const PG8_LAS bf16x8*)(lds + PG8_SB(b, h) + boff + n * 2048 + k * 1024); } while (0)
#define PG8_MMA(ai, bj, At, Bt) do { __builtin_amdgcn_s_setprio(1); _Pragma("unroll") for (int m = 0; m < 4; ++m) _Pragma("unroll") for (int n = 0; n < 2; ++n) _Pragma("unroll") for (int k = 0; k < 2; ++k) \
        acc[ai][bj][m][n] = __builtin_amdgcn_mfma_f32_16x16x32_bf16(Bt[n][k], At[m][k], acc[ai][bj][m][n], 0, 0, 0); __builtin_amdgcn_s_setprio(0); } while (0)
#define PG8_WAIT_V(n) asm volatile("s_waitcnt vmcnt(" #n ")" ::: "memory")
#define PG8_WAIT_L(n) asm volatile("s_waitcnt lgkmcnt(" #n ")" ::: "memory")
#define PG8_BAR __builtin_amdgcn_s_barrier()
#define PG8_SCHED __builtin_amdgcn_sched_barrier(0)
    Unit cur, nxt; int ui = 0;
    if (!S.next(0, cur)) return;
    f32x4 acc[2][2][4][2];
#pragma unroll
    for (int a = 0; a < 2; ++a)
#pragma unroll
        for (int b = 0; b < 2; ++b)
#pragma unroll
            for (int m = 0; m < 4; ++m)
#pragma unroll
                for (int n = 0; n < 2; ++n) acc[a][b][m][n] = (f32x4){0.f, 0.f, 0.f, 0.f};
    bf16x8 At[4][2], B0[2][2], B1[2][2];
    const char* cA = (const char*)g.A + (size_t)cur.pm * tstep; const char* cB = (const char*)g.Bt + (size_t)cur.pn * tstep;
    S.a_ready(cur);
    if constexpr (SP2) {
        PG8_STAGE(PG8_SB(0, 0), cB, voffB); PG8_STAGE(PG8_SB(0, 1), cB + hstep, voffB); PG8_STAGE(PG8_SA(0, 0), cA, voffA); PG8_STAGE(PG8_SA(0, 1), cA + hstep, voffA);
        if (wr == 1) PG8_BAR;
        PG8_WAIT_V(2); PG8_BAR;
        PG8_STAGE(PG8_SB(1, 0), cB + kstep, voffB); PG8_STAGE(PG8_SA(1, 0), cA + kstep, voffA); PG8_STAGE(PG8_SB(1, 1), cB + hstep + kstep, voffB);
        PG8_WAIT_V(6); PG8_BAR;
    } else {
        PG8_STAGE(PG8_SB(0, 0), cB, voffB); PG8_STAGE(PG8_SA(0, 0), cA, voffA); PG8_STAGE(PG8_SB(0, 1), cB + hstep, voffB); PG8_STAGE(PG8_SA(0, 1), cA + hstep, voffA);
        if (wr == 1) PG8_BAR;
        PG8_WAIT_V(4); PG8_BAR;
        PG8_STAGE(PG8_SB(1, 0), cB + kstep, voffB); PG8_STAGE(PG8_SA(1, 0), cA + kstep, voffA); PG8_STAGE(PG8_SB(1, 1), cB + hstep + kstep, voffB);
        PG8_WAIT_V(6); PG8_BAR;
    }
    for (;;) {
        const bool has_next = S.next(ui + 1, nxt);
        const char* nA = has_next ? (const char*)g.A + (size_t)nxt.pm * tstep : cA; const char* nB = has_next ? (const char*)g.Bt + (size_t)nxt.pn * tstep : cB;
        for (int t = 0; t < nt; t += 2) {
            const bool last = (t == nt - 2);
            const char* a1 = cA + (size_t)(t + 1) * kstep;
            const char* a2 = last ? nA : cA + (size_t)(t + 2) * kstep; const char* b2 = last ? nB : cB + (size_t)(t + 2) * kstep;
            const char* a3 = a2 + kstep; const char* b3 = b2 + kstep;
            if (last && has_next) S.a_ready(nxt);
            if constexpr (SP2) {
            PG8_LDB(B0, 0, 0); PG8_LDB(B1, 0, 1); PG8_SCHED; PG8_LDA(At, 0, 0); PG8_STAGE(PG8_SA(1, 1), a1 + hstep, voffA);
            PG8_WAIT_V(8); PG8_WAIT_L(0); PG8_BAR; PG8_MMA(0, 0, At, B0); PG8_MMA(0, 1, At, B1); PG8_BAR; PG8_SCHED;
            PG8_LDA(At, 0, 1); PG8_STAGE(PG8_SB(0, 0), b2, voffB); PG8_STAGE(PG8_SB(0, 1), b2 + hstep, voffB); PG8_STAGE(PG8_SA(0, 0), a2, voffA);
            PG8_WAIT_V(8); PG8_WAIT_L(0); PG8_BAR; PG8_MMA(1, 0, At, B0); PG8_MMA(1, 1, At, B1); PG8_BAR; PG8_SCHED;
            PG8_LDB(B0, 1, 0); PG8_LDB(B1, 1, 1); PG8_SCHED; PG8_LDA(At, 1, 0); PG8_STAGE(PG8_SA(0, 1), a2 + hstep, voffA);
            PG8_WAIT_V(8); PG8_WAIT_L(0); PG8_BAR; PG8_MMA(0, 0, At, B0); PG8_MMA(0, 1, At, B1); PG8_BAR; PG8_SCHED;
            PG8_LDA(At, 1, 1); PG8_STAGE(PG8_SB(1, 0), b3, voffB); PG8_STAGE(PG8_SB(1, 1), b3 + hstep, voffB); PG8_STAGE(PG8_SA(1, 0), a3, voffA);
            PG8_WAIT_V(8); PG8_WAIT_L(0); PG8_BAR; PG8_MMA(1, 0, At, B0); PG8_MMA(1, 1, At, B1); PG8_BAR; PG8_SCHED;
            } else {
            PG8_LDB(B0, 0, 0); PG8_SCHED; PG8_LDA(At, 0, 0); PG8_STAGE(PG8_SA(1, 1), a1 + hstep, voffA);
            PG8_WAIT_L(8); PG8_BAR; PG8_WAIT_L(0); PG8_MMA(0, 0, At, B0); PG8_BAR; PG8_SCHED;
            PG8_LDB(B1, 0, 1); PG8_STAGE(PG8_SB(0, 0), b2, voffB);
            PG8_BAR; PG8_WAIT_L(0); PG8_MMA(0, 1, At, B1); PG8_BAR;
            PG8_LDA(At, 0, 1); PG8_STAGE(PG8_SA(0, 0), a2, voffA);
            PG8_BAR; PG8_WAIT_L(0); PG8_MMA(1, 0, At, B0); PG8_BAR; PG8_SCHED;
            PG8_STAGE(PG8_SB(0, 1), b2 + hstep, voffB);
            PG8_WAIT_V(6); PG8_BAR; PG8_MMA(1, 1, At, B1); PG8_BAR;
            PG8_LDB(B0, 1, 0); PG8_SCHED; PG8_LDA(At, 1, 0); PG8_STAGE(PG8_SA(0, 1), a2 + hstep, voffA);
            PG8_WAIT_L(8); PG8_BAR; PG8_WAIT_L(0); PG8_MMA(0, 0, At, B0); PG8_BAR; PG8_SCHED;
            PG8_LDB(B1, 1, 1); PG8_STAGE(PG8_SB(1, 0), b3, voffB);
            PG8_BAR; PG8_WAIT_L(0); PG8_MMA(0, 1, At, B1); PG8_BAR;
            PG8_LDA(At, 1, 1); PG8_STAGE(PG8_SA(1, 0), a3, voffA);
            PG8_BAR; PG8_WAIT_L(0); PG8_MMA(1, 0, At, B0); PG8_BAR; PG8_SCHED;
            PG8_STAGE(PG8_SB(1, 1), b3 + hstep, voffB);
            PG8_WAIT_V(6); PG8_BAR; PG8_MMA(1, 1, At, B1); PG8_BAR;
            }
        }
        if constexpr (ALIGN_EPI) { if (wr == 0) PG8_BAR; }
        if constexpr (!Epi::AFTER_DRAIN) { E(acc, cur, wr, wc, fr, fq); S.done(cur); }
        if (!has_next) break;
#pragma unroll
        for (int a = 0; a < 2; ++a)
#pragma unroll
            for (int b = 0; b < 2; ++b)
#pragma unroll
                for (int m = 0; m < 4; ++m)
#pragma unroll
                    for (int n = 0; n < 2; ++n) acc[a][b][m][n] = (f32x4){0.f, 0.f, 0.f, 0.f};
        cur = nxt; cA = nA; cB = nB; ++ui;
        if constexpr (ALIGN_EPI) { if (wr == 1) PG8_BAR; }
    }
    PG8_WAIT_V(0);
    if constexpr (!ALIGN_EPI) { if (wr == 0) PG8_BAR; }
    PG8_BAR;
    if constexpr (Epi::AFTER_DRAIN) { E.fused(acc, cur, wr, wc, fr, fq, lds, wid, lane); S.done(cur); }
#undef PG8_SA
#undef PG8_SB
#undef PG8_STAGE
#undef PG8_LDA
#undef PG8_LDB
#undef PG8_MMA
#undef PG8_WAIT_V
#undef PG8_WAIT_L
#undef PG8_BAR
#undef PG8_SCHED
}
}

#define LAS __attribute__((address_space(3)))
typedef unsigned short bf16_t;
typedef short bf16x8 __attribute__((ext_vector_type(8)));
typedef short s16x4 __attribute__((ext_vector_type(4)));
typedef float f32x4 __attribute__((ext_vector_type(4)));
typedef float f32x2 __attribute__((ext_vector_type(2)));
typedef float f32x16 __attribute__((ext_vector_type(16)));
typedef unsigned u32x4 __attribute__((ext_vector_type(4)));
typedef unsigned u32x2 __attribute__((ext_vector_type(2)));
typedef __bf16 bf16x2_t __attribute__((ext_vector_type(2)));

constexpr int DM = 1024, NLAT = 16384, NCTX = 4096, MROWS = 20480, DFF = 2816;
constexpr int NQ_E = 2304, NQ_O = 3072;
constexpr float EPS = 1e-6f;
constexpr float LOG2E = 1.4426950408889634f;
constexpr float SCL2 = 0.125f * LOG2E;

constexpr size_t MiB = 1u << 20;
constexpr size_t WS_ROPE = 4096;
constexpr size_t WS_MOD = 1 * MiB;
constexpr size_t WS_W13T = 4 * MiB;
constexpr size_t WS_W2T = 92 * MiB;
constexpr size_t WS_WINAB = 136 * MiB;
constexpr size_t WS_WOUTAB = 145 * MiB;
constexpr size_t WS_WINC = 149 * MiB;
constexpr size_t WS_WOUTC = 161 * MiB;
constexpr size_t WS_CAK = 165 * MiB, WS_CAV = 167 * MiB, WS_CBK = 169 * MiB, WS_CBV = 177 * MiB, WS_CCK = 185 * MiB, WS_CCV = 201 * MiB;
constexpr size_t WS_X = 217 * MiB;
constexpr size_t WS_H = 297 * MiB;
constexpr size_t WS_O = 337 * MiB;
constexpr size_t WS_U = 377 * MiB;
constexpr size_t WS_END = 497 * MiB;

constexpr size_t OUT_YP = 0, OUT_YS = 4194304, OUT_AK = 20971520, OUT_AV = 22020096, OUT_BK = 23068672, OUT_BV = 27262976, OUT_CK = 31457280, OUT_CV = 39845888;

constexpr int LDS_BYTES = 131072 + 1024;

__device__ __forceinline__ unsigned pk2(float lo, float hi) { f32x2 v = {lo, hi}; bf16x2_t b = __builtin_convertvector(v, bf16x2_t); return __builtin_bit_cast(unsigned, b); }
__device__ __forceinline__ float wave_sum(float v) {
#pragma unroll
    for (int o = 1; o < 64; o <<= 1) v += __shfl_xor(v, o);
    return v;
}
__device__ __forceinline__ float fast_exp2(float x) { return __builtin_amdgcn_exp2f(x); }
__device__ __forceinline__ float fast_rcp(float x) { return __builtin_amdgcn_rcpf(x); }

struct Args { const float* in[26]; float* out; unsigned char* ws; int ph_lo, ph_hi; };
__device__ __forceinline__ const float* inp(const Args& a, int i) { asm volatile("" : "+s"(i)); return a.in[i]; }
__device__ __forceinline__ unsigned char* wsp(const Args& a) { unsigned char* p = a.ws; asm volatile("" : "+s"(p)); return p; }

struct EpiSwiGLU {
    static constexpr bool PERM = true, AFTER_DRAIN = false;
    bf16_t* U;
    __device__ __forceinline__ void operator()(const f32x4 (&acc)[2][2][4][2], const pg8::Unit& u, int wr, int wc, int fr, int fq) const {
        const int row0 = u.pm * 256 + wr * 64 + fr, col0 = u.pn * 128 + wc * 32 + 8 * fq;
#pragma unroll
        for (int ai = 0; ai < 2; ++ai)
#pragma unroll
            for (int m = 0; m < 4; ++m) {
                bf16_t* rowp = U + (size_t)(row0 + ai * 128 + m * 16) * DFF + col0;
                float o[8];
#pragma unroll
                for (int n = 0; n < 2; ++n)
#pragma unroll
                    for (int i = 0; i < 4; ++i) { const float a = acc[ai][0][m][n][i], b = acc[ai][1][m][n][i];
                        o[n * 4 + i] = a * fast_rcp(1.f + fast_exp2(-a * LOG2E)) * b; }
                u32x4 w; w.x = pk2(o[0], o[1]); w.y = pk2(o[2], o[3]); w.z = pk2(o[4], o[5]); w.w = pk2(o[6], o[7]);
                *(u32x4*)rowp = w;
            }
    }
};
struct EpiResid {
    static constexpr bool PERM = false, AFTER_DRAIN = false;
    float* x; const float* gate; float coef;
    __device__ __forceinline__ void operator()(const f32x4 (&acc)[2][2][4][2], const pg8::Unit& u, int wr, int wc, int fr, int fq) const {
        const int mi = u.pm < 64 ? (u.pm >> 3) : 8;
        const float* g = gate + (size_t)mi * 9216;
        const int col0 = u.pn * 256 + wc * 32 + 4 * fq;
        f32x4 g4[2][2];
#pragma unroll
        for (int bj = 0; bj < 2; ++bj)
#pragma unroll
            for (int n = 0; n < 2; ++n) g4[bj][n] = *(const f32x4*)(g + col0 + bj * 128 + n * 16) * coef;
#pragma unroll
        for (int ai = 0; ai < 2; ++ai)
#pragma unroll
            for (int m = 0; m < 4; ++m) {
                float* p = x + (size_t)(u.pm * 256 + ai * 128 + wr * 64 + m * 16 + fr) * DM + col0;
#pragma unroll
                for (int bj = 0; bj < 2; ++bj)
#pragma unroll
                    for (int n = 0; n < 2; ++n) { float* q = p + bj * 128 + n * 16; *(f32x4*)q = *(const f32x4*)q + g4[bj][n] * acc[ai][bj][m][n]; }
                asm volatile("" ::: "memory");
            }
    }
};
struct EpiQKV {
    static constexpr bool PERM = false, AFTER_DRAIN = false;
    bf16_t* Q; int ldq; int even; int e; const float* qn; const float* kn; const f32x2* rope; float* out;
    __device__ __forceinline__ void operator()(const f32x4 (&acc)[2][2][4][2], const pg8::Unit& u, int wr, int wc, int fr, int fq) const {
        const int hu = 4 * u.pn + wc;
        const bool lat = u.pm < 64;
        bool do_rope; const float* nw = nullptr; float* ob = nullptr; int ow = 0;
        if (even) {
            do_rope = hu < 10;
            if (hu < 8) nw = qn; else if (hu < 10) { nw = kn; ob = out + OUT_AK + 64 * (hu - 8); ow = 128; }
            else if (hu < 12) { ob = out + OUT_AV + 64 * (hu - 10); ow = 128; }
            else if (hu < 20) {}
            else if (hu < 28) { ob = out + OUT_BK + 64 * (hu - 20); ow = 512; }
            else { ob = out + OUT_BV + 64 * (hu - 28); ow = 512; }
        } else {
            do_rope = hu < 32;
            if (hu < 16) {} else if (hu < 32) { ob = out + OUT_CK + 64 * (hu - 16); ow = 1024; }
            else { ob = out + OUT_CV + 64 * (hu - 32); ow = 1024; }
        }
        f32x4 w4[2][2];
        if (nw) {
#pragma unroll
            for (int bj = 0; bj < 2; ++bj)
#pragma unroll
                for (int n = 0; n < 2; ++n) w4[bj][n] = *(const f32x4*)(nw + 32 * bj + 16 * n + 4 * fq);
        }
#pragma unroll
        for (int ai = 0; ai < 2; ++ai)
#pragma unroll
            for (int m = 0; m < 4; ++m) {
                const int row = u.pm * 256 + ai * 128 + wr * 64 + m * 16 + fr;
                f32x4 v[2][2];
#pragma unroll
                for (int bj = 0; bj < 2; ++bj)
#pragma unroll
                    for (int n = 0; n < 2; ++n) v[bj][n] = acc[ai][bj][m][n];
                if (nw) {
                    float ss = 0.f;
#pragma unroll
                    for (int bj = 0; bj < 2; ++bj)
#pragma unroll
                        for (int n = 0; n < 2; ++n) ss += (v[bj][n][0] * v[bj][n][0] + v[bj][n][1] * v[bj][n][1]) + (v[bj][n][2] * v[bj][n][2] + v[bj][n][3] * v[bj][n][3]);
                    ss += __shfl_xor(ss, 16); ss += __shfl_xor(ss, 32);
                    const float rstd = rsqrtf(ss * (1.f / 64.f) + EPS);
#pragma unroll
                    for (int bj = 0; bj < 2; ++bj)
#pragma unroll
                        for (int n = 0; n < 2; ++n) v[bj][n] = v[bj][n] * rstd * w4[bj][n];
                }
                if (do_rope && lat) {
                    const int t = row & 2047;
#pragma unroll
                    for (int bj = 0; bj < 2; ++bj) {
                        const int pos = bj ? (t & 63) : (t >> 6);
                        const f32x2* rp = rope + pos * 16 + 4 * fq;
#pragma unroll
                        for (int i = 0; i < 4; ++i) { const f32x2 cs = rp[i]; const float x1 = v[bj][0][i], x2 = v[bj][1][i];
                            v[bj][0][i] = x1 * cs.x - x2 * cs.y; v[bj][1][i] = x2 * cs.x + x1 * cs.y; }
                    }
                }
                bf16_t* qp = Q + (size_t)row * ldq + 64 * hu + 4 * fq;
#pragma unroll
                for (int bj = 0; bj < 2; ++bj)
#pragma unroll
                    for (int n = 0; n < 2; ++n) { u32x2 w; w.x = pk2(v[bj][n][0], v[bj][n][1]); w.y = pk2(v[bj][n][2], v[bj][n][3]); *(u32x2*)(qp + 32 * bj + 16 * n) = w; }
                if (ob && !lat) {
                    const int cr = row - NLAT, b = cr >> 8, s = cr & 255;
                    float* op = ob + (size_t)((b * 2 + e) * 256 + s) * ow + 4 * fq;
#pragma unroll
                    for (int bj = 0; bj < 2; ++bj)
#pragma unroll
                        for (int n = 0; n < 2; ++n) *(f32x4*)(op + 32 * bj + 16 * n) = v[bj][n];
                }
            }
    }
};

__device__ __forceinline__ void transpose_item(const float* W, int K, int N, bf16_t* WT, int k0, int n0, int drow, LAS float* scr, int lane) {
#pragma unroll 8
    for (int i = 0; i < 32; ++i) { const int kk = 2 * i + (lane >> 5); scr[kk * 33 + (lane & 31)] = W[(size_t)(k0 + kk) * N + n0 + (lane & 31)]; }
    asm volatile("s_waitcnt lgkmcnt(0)" ::: "memory");
    const int c = lane & 7;
#pragma unroll
    for (int j = 0; j < 4; ++j) { const int n = (lane >> 3) + 8 * j; const LAS float* s = scr + (8 * c) * 33 + n;
        u32x4 o; o.x = pk2(s[0 * 33], s[1 * 33]); o.y = pk2(s[2 * 33], s[3 * 33]); o.z = pk2(s[4 * 33], s[5 * 33]); o.w = pk2(s[6 * 33], s[7 * 33]);
        *(u32x4*)(WT + (size_t)(drow + n) * K + k0 + 8 * c) = o; }
    asm volatile("s_waitcnt lgkmcnt(0)" ::: "memory");
}
__device__ __forceinline__ int qkv_drow(int n0) { const int hu = n0 >> 6, bj = (n0 >> 5) & 1; return 256 * (hu >> 2) + 128 * bj + 32 * (hu & 3); }

__device__ __forceinline__ void cvt_seg(const float* src, bf16_t* dst, int n4, int gt, int NT) {
    for (int i = gt; i < n4; i += NT) { const f32x4 v = ((const f32x4*)src)[i]; u32x2 w; w.x = pk2(v[0], v[1]); w.y = pk2(v[2], v[3]); ((u32x2*)dst)[i] = w; }
}

__device__ __forceinline__ void prologue_phase(const Args& a, LAS unsigned char* lds, int vcu, int G) {
    const int tid = opaque_tid(), lane = tid & 63, wave = __builtin_amdgcn_readfirstlane(tid >> 6);
    unsigned char* ws = wsp(a);
    {
        LAS float* sc = (LAS float*)lds;
        LAS f32x4* red = (LAS f32x4*)(lds + 36864);
        const int first = G - 1 - (int)blockIdx.x;
        if (first < 144) {
            for (int i = tid; i < 9 * 1024; i += 512) { const int r = i >> 10, k = i & 1023; const float cv = r < 8 ? inp(a, 8)[r * 1024 + k] : inp(a, 9)[k]; sc[i] = cv / (1.f + __expf(-cv)); }
            __syncthreads();
            for (int item = first; item < 144; item += G) {
                const int l = item / 36, cb = item % 36, col = cb * 256 + lane * 4;
                const float* wp = inp(a, 10) + ((size_t)l * 1024 + wave * 128) * 9216 + col;
                f32x4 acc[9];
#pragma unroll
                for (int r = 0; r < 9; ++r) acc[r] = (f32x4){0.f, 0.f, 0.f, 0.f};
#pragma unroll 4
                for (int k = 0; k < 128; ++k) {
                    const f32x4 wv = *(const f32x4*)(wp + (size_t)k * 9216);
#pragma unroll
                    for (int r = 0; r < 9; ++r) acc[r] += wv * sc[r * 1024 + wave * 128 + k];
                }
#pragma unroll
                for (int r = 0; r < 9; ++r) red[(wave * 9 + r) * 64 + lane] = acc[r];
                __syncthreads();
                for (int o = tid; o < 9 * 64; o += 512) {
                    const int r = o >> 6, ln = o & 63;
                    f32x4 s = *(const f32x4*)(inp(a, 11) + l * 9216 + cb * 256 + ln * 4);
#pragma unroll
                    for (int w = 0; w < 8; ++w) s += red[(w * 9 + r) * 64 + ln];
                    *(f32x4*)((float*)(ws + WS_MOD) + ((size_t)l * 9 + r) * 9216 + cb * 256 + ln * 4) = s;
                }
                __syncthreads();
            }
        }
        __syncthreads();
    }
    {
        LAS float* scr = (LAS float*)(lds + wave * 8704);
        const int gw = vcu * 8 + wave, NGW = G * 8;
        for (int it = gw; it < 41216; it += NGW) {
            if (it < 33792) {
                const int lf = it / 4224, r = it % 4224, which = r / 1408, q = r % 1408;
                if (which < 2) { const int kb = q / 88, nb = q % 88, n0 = 32 * nb; const int drow = 256 * (n0 >> 7) + (n0 & 127) + 128 * which;
                    transpose_item(inp(a, which == 0 ? 13 : 14) + (size_t)lf * 1024 * DFF, 1024, DFF, (bf16_t*)(ws + WS_W13T) + (size_t)lf * 5632 * 1024, 64 * kb, n0, drow, scr, lane); }
                else { const int kb = q / 32, nb = q % 32;
                    transpose_item(inp(a, 15) + (size_t)lf * DFF * 1024, DFF, 1024, (bf16_t*)(ws + WS_W2T) + (size_t)lf * 1024 * DFF, 64 * kb, 32 * nb, 32 * nb, scr, lane); }
            } else {
                int r = it - 33792;
                if (r < 2304) { const int e = r / 1152, q = r % 1152, kb = q / 72, nb = q % 72;
                    transpose_item(inp(a, 16) + (size_t)e * 1024 * NQ_E, 1024, NQ_E, (bf16_t*)(ws + WS_WINAB) + (size_t)e * NQ_E * 1024, 64 * kb, 32 * nb, qkv_drow(32 * nb), scr, lane); continue; }
                r -= 2304;
                if (r < 3072) { const int e = r / 1536, q = r % 1536, kb = q / 96, nb = q % 96;
                    transpose_item(inp(a, 21) + (size_t)e * 1024 * NQ_O, 1024, NQ_O, (bf16_t*)(ws + WS_WINC) + (size_t)e * NQ_O * 1024, 64 * kb, 32 * nb, qkv_drow(32 * nb), scr, lane); continue; }
                r -= 3072;
                if (r < 1024) { const int e = r / 512, q = r % 512, kb = q / 32, nb = q % 32;
                    transpose_item(inp(a, 17) + (size_t)e * 1024 * 1024, 1024, 1024, (bf16_t*)(ws + WS_WOUTAB) + (size_t)e * 1024 * 1024, 64 * kb, 32 * nb, 32 * nb, scr, lane); continue; }
                r -= 1024;
                { const int e = r / 512, q = r % 512, kb = q / 32, nb = q % 32;
                    transpose_item(inp(a, 22) + (size_t)e * 1024 * 1024, 1024, 1024, (bf16_t*)(ws + WS_WOUTC) + (size_t)e * 1024 * 1024, 64 * kb, 32 * nb, 32 * nb, scr, lane); }
            }
        }
    }
    {
        const int gt = blockIdx.x * 512 + tid, NT = G * 512;
        cvt_seg(inp(a, 2), (bf16_t*)(ws + WS_CAK), 1048576 / 4, gt, NT);
        cvt_seg(inp(a, 3), (bf16_t*)(ws + WS_CAV), 1048576 / 4, gt, NT);
        cvt_seg(inp(a, 4), (bf16_t*)(ws + WS_CBK), 4194304 / 4, gt, NT);
        cvt_seg(inp(a, 5), (bf16_t*)(ws + WS_CBV), 4194304 / 4, gt, NT);
        cvt_seg(inp(a, 6), (bf16_t*)(ws + WS_CCK), 8388608 / 4, gt, NT);
        cvt_seg(inp(a, 7), (bf16_t*)(ws + WS_CCV), 8388608 / 4, gt, NT);
        if (gt < 1024) { const int pos = gt >> 4, f = gt & 15;
            const float inv = exp2f(-(float)f * (13.287712379549449f / 16.f));
            const float rev = (float)pos * inv * 0.15915494309189535f;
            f32x2 cs; cs.x = __builtin_amdgcn_cosf(rev); cs.y = __builtin_amdgcn_sinf(rev);
            ((f32x2*)(ws + WS_ROPE))[gt] = cs; }
    }
}

__device__ __forceinline__ void norm_phase(const Args& a, bool first, const float* nw, const float* modl, int sub, int vcu, int G) {
    const int tid = opaque_tid(), lane = tid & 63, wave = tid >> 6;
    float* xb = (float*)(wsp(a) + WS_X); bf16_t* hb = (bf16_t*)(wsp(a) + WS_H);
    for (int row = vcu * 8 + wave; row < MROWS; row += G * 8) {
        const float* xr = first ? (row < NLAT ? inp(a, 1) + (size_t)row * DM : inp(a, 0) + (size_t)(row - NLAT) * DM) : xb + (size_t)row * DM;
        f32x4 v[4]; float ss = 0.f;
#pragma unroll
        for (int j = 0; j < 4; ++j) { v[j] = ((const f32x4*)xr)[lane + 64 * j]; ss += (v[j][0] * v[j][0] + v[j][1] * v[j][1]) + (v[j][2] * v[j][2] + v[j][3] * v[j][3]); }
        const float rstd = rsqrtf(wave_sum(ss) * (1.f / DM) + EPS);
        if (first) {
#pragma unroll
            for (int j = 0; j < 4; ++j) ((f32x4*)(xb + (size_t)row * DM))[lane + 64 * j] = v[j];
        }
        const int mi = row < NLAT ? (row >> 11) : 8;
        const float* sh = modl + (size_t)mi * 9216 + (3 * sub) * 1024; const float* sc = sh + 1024;
#pragma unroll
        for (int j = 0; j < 4; ++j) {
            const int c4 = lane + 64 * j;
            const f32x4 w = ((const f32x4*)nw)[c4], s4 = ((const f32x4*)sc)[c4], m4 = ((const f32x4*)sh)[c4];
            const f32x4 o = v[j] * rstd * w * (1.f + s4) + m4;
            u32x2 pw; pw.x = pk2(o[0], o[1]); pw.y = pk2(o[2], o[3]);
            ((u32x2*)(hb + (size_t)row * DM))[c4] = pw;
        }
    }
}
__device__ __forceinline__ void final_norm_phase(const Args& a, int vcu, int G) {
    const int tid = opaque_tid(), lane = tid & 63, wave = tid >> 6;
    const float* xb = (const float*)(wsp(a) + WS_X); const float* nw = inp(a, 25);
    for (int row = vcu * 8 + wave; row < MROWS; row += G * 8) {
        const float* xr = xb + (size_t)row * DM;
        float* orow = row < NLAT ? a.out + OUT_YS + (size_t)row * DM : a.out + OUT_YP + (size_t)(row - NLAT) * DM;
        f32x4 v[4]; float ss = 0.f;
#pragma unroll
        for (int j = 0; j < 4; ++j) { v[j] = ((const f32x4*)xr)[lane + 64 * j]; ss += (v[j][0] * v[j][0] + v[j][1] * v[j][1]) + (v[j][2] * v[j][2] + v[j][3] * v[j][3]); }
        const float rstd = rsqrtf(wave_sum(ss) * (1.f / DM) + EPS);
#pragma unroll
        for (int j = 0; j < 4; ++j) ((f32x4*)orow)[lane + 64 * j] = v[j] * rstd * ((const f32x4*)nw)[lane + 64 * j];
    }
}

struct KVSrc { const bf16_t* k; const bf16_t* v; int ks, vs; };
constexpr int AT_K = 0, AT_V = 16384, AT_BIAS = 49152;
__device__ __forceinline__ int crow(int r, int hi) { return (r & 3) + 8 * (r >> 2) + 4 * hi; }
typedef short v4i16_t __attribute__((ext_vector_type(4)));
__device__ __forceinline__ s16x4 vtr(const LAS unsigned char* p) { return __builtin_bit_cast(s16x4, __builtin_amdgcn_ds_read_tr16_b64_v4i16((LAS v4i16_t*)p)); }

template <int DV, bool NB>
__device__ __forceinline__ void attn_pass(LAS unsigned char* lds, const bf16x8 (&qr)[4], const KVSrc s0, const int nt0, const KVSrc s1, const int nt1,
                                          f32x16 (&OT)[DV / 32], float& m_run, float& l_run,
                                          const int R, const int c, const int kr0) {
    constexpr int NV = DV / 64;
    const int tid = opaque_tid(), lane = tid & 63, r32 = lane & 31, hi = lane >> 5;
    const int NT = nt0 + nt1;
    const int kkv = tid >> 3, kch = tid & 7;
    u32x4 kreg, vreg[NV];
#define AT_LOAD(t_) do { const int t__ = (t_); const bool f__ = t__ < nt0; const int tt__ = f__ ? t__ : t__ - nt0; \
        const bf16_t* kp__ = f__ ? s0.k : s1.k; const bf16_t* vp__ = f__ ? s0.v : s1.v; const int ks__ = f__ ? s0.ks : s1.ks, vs__ = f__ ? s0.vs : s1.vs; \
        kreg = *(const u32x4*)(kp__ + (size_t)(tt__ * 64 + kkv) * ks__ + kch * 8); \
        _Pragma("unroll") for (int i__ = 0; i__ < NV; ++i__) { const int cc__ = tid + 512 * i__; const int vkv__ = NV == 1 ? (cc__ >> 3) : (cc__ >> 4), vch__ = NV == 1 ? (cc__ & 7) : (cc__ & 15); \
            vreg[i__] = *(const u32x4*)(vp__ + (size_t)(tt__ * 64 + vkv__) * vs__ + vch__ * 8); } } while (0)
#define AT_STORE(b_) do { const int b__ = (b_); *(LAS u32x4*)(lds + AT_K + b__ * 8192 + kch * 1024 + kkv * 16) = kreg; \
        _Pragma("unroll") for (int i__ = 0; i__ < NV; ++i__) { const int cc__ = tid + 512 * i__; const int vkv__ = NV == 1 ? (cc__ >> 3) : (cc__ >> 4), vch__ = NV == 1 ? (cc__ & 7) : (cc__ & 15); \
            *(LAS u32x4*)(lds + AT_V + b__ * 16384 + (vch__ >> 2) * 4096 + vkv__ * 64 + (vch__ & 3) * 16) = vreg[i__]; } } while (0)
    AT_LOAD(0); AT_STORE(0);
    __syncthreads();
    const int rs = NB ? min(max(R - 4, 0), 24) : 0;
    const int cs = NB ? min(max(c - 8, 0), 48) : 0;
    const LAS float* biasL = (const LAS float*)(lds + AT_BIAS);
    const int vlane = ((lane >> 4) & 1) * 32 + (lane & 3) * 8 + (4 * hi + ((lane & 15) >> 2)) * 64;
    for (int t = 0; t < NT; ++t) {
        const int buf = t & 1;
        if (t + 1 < NT) AT_LOAD(t + 1);
        const int kr = kr0 + (t - nt0);
        const bool active = !NB || t < nt0 || (kr >= rs && kr < rs + 8);
        if (active) {
            const LAS unsigned char* Kb = lds + AT_K + buf * 8192 + hi * 1024 + r32 * 16;
            f32x16 p0 = {}, p1 = {};
#pragma unroll
            for (int d0 = 0; d0 < 4; ++d0) {
                const bf16x8 b0 = *(const LAS bf16x8*)(Kb + d0 * 2048), b1 = *(const LAS bf16x8*)(Kb + d0 * 2048 + 512);
                p0 = __builtin_amdgcn_mfma_f32_32x32x16_bf16(b0, qr[d0], p0, 0, 0, 0);
                p1 = __builtin_amdgcn_mfma_f32_32x32x16_bf16(b1, qr[d0], p1, 0, 0, 0);
            }
            if (NB && t >= nt0) {
                const LAS float* brow = biasL + (kr - R + 7) * 31;
#pragma unroll
                for (int r = 0; r < 16; ++r) {
                    const int kc0 = crow(r, hi), kc1 = kc0 + 32;
                    const int i0 = min(max(kc0 - c + 15, 0), 30), i1 = min(max(kc1 - c + 15, 0), 30);
                    const float b0 = brow[i0], b1 = brow[i1];
                    p0[r] = (kc0 >= cs && kc0 < cs + 16) ? p0[r] * SCL2 + b0 : -1e30f;
                    p1[r] = (kc1 >= cs && kc1 < cs + 16) ? p1[r] * SCL2 + b1 : -1e30f;
                }
            } else {
#pragma unroll
                for (int r = 0; r < 16; ++r) { p0[r] *= SCL2; p1[r] *= SCL2; }
            }
            float rm = fmaxf(p0[0], p1[0]);
#pragma unroll
            for (int r = 1; r < 16; ++r) rm = fmaxf(rm, fmaxf(p0[r], p1[r]));
            rm = fmaxf(rm, __shfl_xor(rm, 32));
            const float mn = fmaxf(m_run, rm);
            const float alpha = fast_exp2(m_run - mn);
            m_run = mn;
            float ls = 0.f;
#pragma unroll
            for (int r = 0; r < 16; ++r) { p0[r] = fast_exp2(p0[r] - mn); p1[r] = fast_exp2(p1[r] - mn); ls += p0[r] + p1[r]; }
            l_run = l_run * alpha + ls;
#pragma unroll
            for (int d = 0; d < DV / 32; ++d) OT[d] *= alpha;
            bf16x8 pa[4];
#pragma unroll
            for (int k = 0; k < 4; ++k) {
                u32x4 w;
                if (k < 2) { w.x = pk2(p0[8 * k + 0], p0[8 * k + 1]); w.y = pk2(p0[8 * k + 2], p0[8 * k + 3]); w.z = pk2(p0[8 * k + 4], p0[8 * k + 5]); w.w = pk2(p0[8 * k + 6], p0[8 * k + 7]); }
                else { const int kk = k - 2; w.x = pk2(p1[8 * kk + 0], p1[8 * kk + 1]); w.y = pk2(p1[8 * kk + 2], p1[8 * kk + 3]); w.z = pk2(p1[8 * kk + 4], p1[8 * kk + 5]); w.w = pk2(p1[8 * kk + 6], p1[8 * kk + 7]); }
                pa[k] = __builtin_bit_cast(bf16x8, w);
            }
            const LAS unsigned char* Vb = lds + AT_V + buf * 16384 + vlane;
#pragma unroll
            for (int d = 0; d < DV / 32; ++d)
#pragma unroll
                for (int k = 0; k < 4; ++k) {
                    const s16x4 lo = vtr(Vb + d * 4096 + k * 1024), hh = vtr(Vb + d * 4096 + k * 1024 + 512);
                    const bf16x8 vf = {lo[0], lo[1], lo[2], lo[3], hh[0], hh[1], hh[2], hh[3]};
                    OT[d] = __builtin_amdgcn_mfma_f32_32x32x16_bf16(vf, pa[k], OT[d], 0, 0, 0);
                }
        }
        if (t + 1 < NT) AT_STORE(buf ^ 1);
        __syncthreads();
    }
#undef AT_LOAD
#undef AT_STORE
}

__device__ __forceinline__ void load_q(bf16x8 (&qr)[4], const bf16_t* Q, int ldq) {
    const int tid = opaque_tid(), lane = tid & 63, r32 = lane & 31, hi = lane >> 5, wid = tid >> 6;
    const bf16_t* p = Q + (size_t)(wid * 32 + r32) * ldq + hi * 8;
#pragma unroll
    for (int d0 = 0; d0 < 4; ++d0) qr[d0] = *(const bf16x8*)(p + d0 * 16);
}
__device__ __forceinline__ void store_o64(const f32x16 (&OT)[2], float l_run, bf16_t* O  ) {
    const int tid = opaque_tid(), lane = tid & 63, r32 = lane & 31, hi = lane >> 5, wid = tid >> 6;
    const float inv = 1.f / (l_run + __shfl_xor(l_run, 32));
    bf16_t* op = O + (size_t)(wid * 32 + r32) * DM + 4 * hi;
#pragma unroll
    for (int d = 0; d < 2; ++d)
#pragma unroll
        for (int g = 0; g < 4; ++g) { u32x2 w; w.x = pk2(OT[d][4 * g] * inv, OT[d][4 * g + 1] * inv); w.y = pk2(OT[d][4 * g + 2] * inv, OT[d][4 * g + 3] * inv); *(u32x2*)(op + 32 * d + 8 * g) = w; }
}

__device__ __forceinline__ void attn_even_phase(const Args& a, LAS unsigned char* lds, int e, int vcu, int G) {
    const int tid = opaque_tid(), lane = tid & 63, r32 = lane & 31, wid = tid >> 6;
    unsigned char* ws = wsp(a);
    const bf16_t* QKV = (const bf16_t*)(ws + WS_U); bf16_t* OB = (bf16_t*)(ws + WS_O);
    for (int u = vcu; u < 1280; u += G) {
        bf16x8 qr[4]; f32x16 OT[2]; OT[0] = f32x16{}; OT[1] = f32x16{};
        float m_run = -1e30f, l_run = 0.f;
        if (u < 512) {
            const int b = u >> 6, h = (u >> 3) & 7, qb = u & 7, g = h >> 2;
            const size_t row0 = (size_t)b * 2048 + qb * 256;
            load_q(qr, QKV + row0 * NQ_E + 64 * h, NQ_E);
            const KVSrc s0{QKV + (size_t)b * 2048 * NQ_E + 512 + 64 * g, QKV + (size_t)b * 2048 * NQ_E + 640 + 64 * g, NQ_E, NQ_E};
            const size_t co = (size_t)(b * 2 + e) * 512 * 128 + 64 * g;
            const KVSrc s1{(const bf16_t*)(ws + WS_CAK) + co, (const bf16_t*)(ws + WS_CAV) + co, 128, 128};
            attn_pass<64, false>(lds, qr, s0, 32, s1, 8, OT, m_run, l_run, 0, 0, 0);
            store_o64(OT, l_run, OB + row0 * DM + 64 * h);
        } else if (u < 1024) {
            const int v = u - 512, b = v >> 6, h = (v >> 3) & 7, qb = v & 7;
            const size_t row0 = (size_t)b * 2048 + qb * 256;
            for (int i = tid; i < 465; i += 512) ((LAS float*)(lds + AT_BIAS))[i] = inp(a, 20)[(size_t)(e * 8 + h) * 465 + i] * LOG2E;
            load_q(qr, QKV + row0 * NQ_E + 768 + 64 * h, NQ_E);
            const size_t co = (size_t)(b * 2 + e) * 512 * 512 + 64 * h;
            const KVSrc s0{(const bf16_t*)(ws + WS_CBK) + co, (const bf16_t*)(ws + WS_CBV) + co, 512, 512};
            const int klo = min(max(4 * qb - 4, 0), 24), khi = min(max(4 * qb - 1, 0), 24) + 8;
            const size_t lo = ((size_t)b * 2048 + klo * 64) * NQ_E;
            const KVSrc s1{QKV + lo + 1280 + 64 * h, QKV + lo + 1792 + 64 * h, NQ_E, NQ_E};
            attn_pass<64, true>(lds, qr, s0, 8, s1, khi - klo, OT, m_run, l_run, 4 * qb + (wid >> 1), 32 * (wid & 1) + r32, klo);
            store_o64(OT, l_run, OB + row0 * DM + 512 + 64 * h);
        } else {
            const int v = u - 1024, isb = v >> 7, b = (v >> 3) & 15, h = v & 7;
            const size_t row0 = (size_t)NLAT + b * 256;
            const int qc = isb ? 768 + 64 * h : 64 * h, kc = isb ? 1280 + 64 * h : 512 + 64 * (h >> 2), vc = isb ? 1792 + 64 * h : 640 + 64 * (h >> 2);
            load_q(qr, QKV + row0 * NQ_E + qc, NQ_E);
            const KVSrc s0{QKV + row0 * NQ_E + kc, QKV + row0 * NQ_E + vc, NQ_E, NQ_E};
            attn_pass<64, false>(lds, qr, s0, 4, s0, 0, OT, m_run, l_run, 0, 0, 0);
            store_o64(OT, l_run, OB + row0 * DM + (isb ? 512 : 0) + 64 * h);
        }
    }
}

__device__ __forceinline__ void attn_odd_phase(const Args& a, LAS unsigned char* lds, int o, float lam_init, int vcu, int G) {
    const int tid = opaque_tid(), lane = tid & 63, r32 = lane & 31, hi = lane >> 5, wid = tid >> 6;
    unsigned char* ws = wsp(a);
    const bf16_t* QKV = (const bf16_t*)(ws + WS_U); bf16_t* OB = (bf16_t*)(ws + WS_O);
    const float* lp = inp(a, 23) + o * 256;
    const float lam = __expf(wave_sum(lp[lane] * lp[64 + lane])) - __expf(wave_sum(lp[128 + lane] * lp[192 + lane])) + lam_init;
    const float* sub = inp(a, 24) + o * 128;
    for (int u = vcu; u < 640; u += G) {
        int b, h, qb, nt0, nt1; size_t row0, krow0;
        if (u < 512) { b = u >> 6; h = (u >> 3) & 7; qb = u & 7; row0 = (size_t)b * 2048 + qb * 256; krow0 = (size_t)b * 2048; nt0 = 32; nt1 = 8; }
        else { const int v = u - 512; b = v >> 3; h = v & 7; qb = 0; row0 = (size_t)NLAT + b * 256; krow0 = row0; nt0 = 4; nt1 = 0; }
        unsigned O0p[4][8];
#pragma unroll
        for (int j = 0; j < 2; ++j) {
            bf16x8 qr[4]; f32x16 OT[4];
#pragma unroll
            for (int d = 0; d < 4; ++d) OT[d] = f32x16{};
            float m_run = -1e30f, l_run = 0.f;
            load_q(qr, QKV + row0 * NQ_O + 128 * h + 64 * j, NQ_O);
            const KVSrc s0{QKV + krow0 * NQ_O + 1024 + 128 * h + 64 * j, QKV + krow0 * NQ_O + 2048 + 128 * h, NQ_O, NQ_O};
            const size_t co = (size_t)((b & 7) * 2 + o) * 512 * 1024 + 128 * h;
            const KVSrc s1{(const bf16_t*)(ws + WS_CCK) + co + 64 * j, (const bf16_t*)(ws + WS_CCV) + co, 1024, 1024};
            attn_pass<128, false>(lds, qr, s0, nt0, s1, nt1, OT, m_run, l_run, 0, 0, 0);
            const float inv = 1.f / (l_run + __shfl_xor(l_run, 32));
            if (j == 0) {
#pragma unroll
                for (int d = 0; d < 4; ++d)
#pragma unroll
                    for (int r = 0; r < 8; ++r) O0p[d][r] = pk2(OT[d][2 * r] * inv, OT[d][2 * r + 1] * inv);
            } else {
                const float f1 = lam * inv; float ss = 0.f;
#pragma unroll
                for (int d = 0; d < 4; ++d)
#pragma unroll
                    for (int r = 0; r < 8; ++r) {
                        const float a0 = __uint_as_float(O0p[d][r] << 16), a1 = __uint_as_float(O0p[d][r] & 0xffff0000u);
                        OT[d][2 * r] = a0 - OT[d][2 * r] * f1; OT[d][2 * r + 1] = a1 - OT[d][2 * r + 1] * f1;
                        ss += OT[d][2 * r] * OT[d][2 * r] + OT[d][2 * r + 1] * OT[d][2 * r + 1];
                    }
                ss += __shfl_xor(ss, 32);
                const float rstd = rsqrtf(ss * (1.f / 128.f) + EPS) * (1.f - lam_init);
                bf16_t* op = OB + (row0 + wid * 32 + r32) * DM + 128 * h + 4 * hi;
#pragma unroll
                for (int d = 0; d < 4; ++d)
#pragma unroll
                    for (int g = 0; g < 4; ++g) {
                        const f32x4 sw = *(const f32x4*)(sub + 32 * d + 8 * g + 4 * hi);
                        u32x2 w; w.x = pk2(OT[d][4 * g] * rstd * sw[0], OT[d][4 * g + 1] * rstd * sw[1]); w.y = pk2(OT[d][4 * g + 2] * rstd * sw[2], OT[d][4 * g + 3] * rstd * sw[3]);
                        *(u32x2*)(op + 32 * d + 8 * g) = w;
                    }
            }
        }
    }
}

__global__ void __launch_bounds__(512, 2) mega_fwd(Args a) {
    extern __shared__ __attribute__((aligned(16))) unsigned char lds_raw[];
    LAS unsigned char* lds = (LAS unsigned char*)lds_raw;
    cg::grid_group grid = cg::this_grid();
    const int G = gridDim.x; const int bx = blockIdx.x;
    const int vcu = (G % 8 == 0) ? (bx % 8) * (G / 8) + bx / 8 : bx;
    unsigned char* ws = wsp(a);
    const float* MOD = (const float*)(ws + WS_MOD);
    bf16_t* HB = (bf16_t*)(ws + WS_H); bf16_t* UB = (bf16_t*)(ws + WS_U); bf16_t* OB = (bf16_t*)(ws + WS_O); float* XB = (float*)(ws + WS_X);
    int ph = 0;
#define RUN(...) do { if (ph >= a.ph_lo && ph < a.ph_hi) { __VA_ARGS__; if (ph + 1 < a.ph_hi) grid.sync(); } ++ph; } while (0)

#ifndef PH_MASK
#define PH_MASK 0xff
#endif
    RUN(if (PH_MASK & 1) prologue_phase(a, lds, vcu, G));
    for (int l = 0; l < 4; ++l) {
        const float* modl = MOD + (size_t)l * 9 * 9216;
        for (int half = 0; half < 2; ++half) {
            const int sub = half ? 2 : 0, lf = l * 2 + half;
            RUN(if (PH_MASK & 2) norm_phase(a, l == 0 && half == 0, inp(a, 12) + (l * 3 + sub) * DM, modl, sub, vcu, G));
            RUN(if (PH_MASK & 4) { pg8::Gemm g{HB, (const bf16_t*)(ws + WS_W13T) + (size_t)lf * 5632 * 1024, MROWS, 5632, 1024}; pg8::StaticOrder S; S.init(MROWS, 5632, G, bx);
                  EpiSwiGLU E{UB}; pg8::gemm_phase<EpiSwiGLU, pg8::StaticOrder, true, true>(lds, g, S, E); });
            RUN(if (PH_MASK & 8) { pg8::Gemm g{UB, (const bf16_t*)(ws + WS_W2T) + (size_t)lf * 1024 * DFF, MROWS, 1024, DFF}; pg8::StaticOrder S; S.init(MROWS, 1024, G, bx);
                  EpiResid E{XB, modl + (3 * sub + 2) * 1024, 0.5f}; pg8::gemm_phase<EpiResid, pg8::StaticOrder, true, true>(lds, g, S, E); });
            if (half == 0) {
                const int eo = l >> 1; const bool even = (l & 1) == 0;
                RUN(if (PH_MASK & 2) norm_phase(a, false, inp(a, 12) + (l * 3 + 1) * DM, modl, 1, vcu, G));
                RUN(if (PH_MASK & 16) { const int nq = even ? NQ_E : NQ_O;
                      pg8::Gemm g{HB, even ? (const bf16_t*)(ws + WS_WINAB) + (size_t)eo * NQ_E * 1024 : (const bf16_t*)(ws + WS_WINC) + (size_t)eo * NQ_O * 1024, MROWS, nq, 1024};
                      pg8::StaticOrder S; S.init(MROWS, nq, G, bx);
                      EpiQKV E{UB, nq, even ? 1 : 0, eo, inp(a, 18) + eo * 64, inp(a, 19) + eo * 64, (const f32x2*)(ws + WS_ROPE), a.out};
                      pg8::gemm_phase<EpiQKV, pg8::StaticOrder, true, true>(lds, g, S, E); });
                RUN({ if (even) { if (PH_MASK & 32) attn_even_phase(a, lds, eo, vcu, G); } else if (PH_MASK & 64) attn_odd_phase(a, lds, eo, l == 1 ? 0.35550906759096926f : 0.5560582041556405f, vcu, G); });
                RUN(if (PH_MASK & 8) { pg8::Gemm g{OB, even ? (const bf16_t*)(ws + WS_WOUTAB) + (size_t)eo * 1024 * 1024 : (const bf16_t*)(ws + WS_WOUTC) + (size_t)eo * 1024 * 1024, MROWS, 1024, 1024};
                      pg8::StaticOrder S; S.init(MROWS, 1024, G, bx);
                      EpiResid E{XB, modl + 5 * 1024, 1.0f}; pg8::gemm_phase<EpiResid, pg8::StaticOrder, true, true>(lds, g, S, E); });
            }
        }
    }
    RUN(if (PH_MASK & 2) final_norm_phase(a, vcu, G));
#undef RUN
}

extern "C" void kernel_launch(void* const* d_in, const int* in_sizes, int n_in, void* d_out, int out_size, void* d_ws, size_t ws_size, hipStream_t stream) {
    static int grid = 0;
    if (grid == 0) {
        int dev = 0, cus = 0, per_cu = 0;
        hipGetDevice(&dev);
        hipDeviceGetAttribute(&cus, hipDeviceAttributeMultiprocessorCount, dev);
        hipFuncSetAttribute((const void*)mega_fwd, hipFuncAttributeMaxDynamicSharedMemorySize, LDS_BYTES);
        hipOccupancyMaxActiveBlocksPerMultiprocessor(&per_cu, (const void*)mega_fwd, 512, LDS_BYTES);
        if (per_cu < 1) per_cu = 1;
        if (per_cu > 1) per_cu = 1;
        grid = cus * per_cu;
        if (n_in != 26 || ws_size < WS_END) { fprintf(stderr, "kernel_launch: unexpected n_in %d / ws %zu\n", n_in, ws_size); }
    }
    Args a{};
    for (int i = 0; i < 26; ++i) a.in[i] = (const float*)d_in[i];
    a.out = (float*)d_out; a.ws = (unsigned char*)d_ws; a.ph_lo = 0; a.ph_hi = 1000;
    void* args[] = {&a};
    hipError_t e = hipLaunchCooperativeKernel((const void*)mega_fwd, dim3(grid), dim3(512), args, LDS_BYTES, stream);
    if (e != hipSuccess) fprintf(stderr, "cooperative launch failed: %s (grid %d)\n", hipGetErrorString(e), grid);
}
```

```cpp
#define DUP_MASK 0
#define XSYNC 0
#include <hip/hip_runtime.h>
#include <hip/hip_cooperative_groups.h>
#include <cstdio>
#include <cstdint>
namespace cg = cooperative_groups;
__device__ __forceinline__ int opaque_tid() { int t = threadIdx.x; asm volatile("" : "+v"(t)); return t; }
namespace pg8 {
#define PG8_LAS __attribute__((address_space(3)))
typedef unsigned short bf16_t;
typedef short bf16x8 __attribute__((ext_vector_type(8)));
typedef float f32x4 __attribute__((ext_vector_type(4)));
typedef unsigned u32x4 __attribute__((ext_vector_type(4)));
constexpr int BM = 256, BK = 64, HALF = 128, HTB = HALF * BK * 2  , STAGE_BYTES = 8 * HTB, NXCD = 8, WGM = 8;

__host__ __device__ __forceinline__ int lds_byte(int r, int c) { const int st = (r >> 4) * 2 + (c >> 5), rr = r & 15, cc = c & 31, ob = rr * 64 + cc * 2; return st * 1024 + (ob ^ (((ob >> 9) & 1) << 5)); }
__host__ __device__ __forceinline__ void stage_rc(int b, int& R, int& C) { const int st = b / 1024, sb = b % 1024, swz = sb ^ (((sb >> 9) & 1) << 5); R = (st >> 1) * 16 + swz / 64; C = (st & 1) * 32 + (swz % 64) / 2; }
__host__ __device__ __forceinline__ int perm32(int rho) { const int n = rho >> 4, i = rho & 15; return 8 * (i >> 2) + 4 * n + (i & 3); }

struct Unit { int pm, pn; };
struct Gemm { const bf16_t* A; const bf16_t* Bt; int M, N, K; };

struct StaticOrder {
    int nM, nN, nwg, G, c;
    __host__ __device__ void init(int M, int N, int G_, int c_) { nM = M / BM; nN = N / BM; nwg = nM * nN; G = G_; c = c_; }
    __host__ __device__ bool next(int i, Unit& u) const {
        const long L = (long)i * G + c; if (L >= nwg) return false;
        int wgid = (int)L; { const int q = nwg / NXCD, r = nwg % NXCD, xcd = wgid % NXCD, off = wgid / NXCD; wgid = (xcd < r ? xcd * (q + 1) : r * (q + 1) + (xcd - r) * q) + off; }
        const int nig = WGM * nN, gid = wgid / nig, fm = gid * WGM, gsz = (nM - fm) < WGM ? (nM - fm) : WGM;
        u.pm = fm + ((wgid % nig) % gsz); u.pn = (wgid % nig) / gsz; return true;
    }
    __device__ __forceinline__ void a_ready(const Unit&) const {}
    __device__ __forceinline__ void done(const Unit&) const {}
};

template <class Epi, class Sched, bool ALIGN_EPI = false, bool SP2 = false>
__device__ __forceinline__ void gemm_phase(PG8_LAS unsigned char* lds, const Gemm g, const Sched& S, const Epi& E) {
    const int tid = opaque_tid(), wid = __builtin_amdgcn_readfirstlane(tid >> 6), lane = tid & 63, wr = wid >> 2, wc = wid & 3, fr = lane & 15, fq = lane >> 4;
    const int K = g.K, nt = K / BK;
    unsigned voffA[2], voffB[2];
#pragma unroll
    for (int i = 0; i < 2; ++i) { int R, C; stage_rc(tid * 16 + i * 8192, R, C); const int Rb = Epi::PERM ? ((R & ~31) + perm32(R & 31)) : R;
        voffA[i] = (unsigned)(R * K + C) * 2u; voffB[i] = (unsigned)(Rb * K + C) * 2u; }
    const size_t kstep = (size_t)(BK * 2);
    const size_t hstep = (size_t)HALF * K * 2;
    const size_t tstep = 2 * hstep;
    const unsigned ldsw = (unsigned)wid * 1024u;
    const int aoff = lds_byte(wr * 64 + fr, fq * 8), boff = lds_byte(wc * 32 + fr, fq * 8);
#define PG8_SA(b, h) (((b) * 2 + (h)) * HTB)
#define PG8_SB(b, h) ((4 + (b) * 2 + (h)) * HTB)
#define PG8_STAGE(bufoff, gbase, voff) do { _Pragma("unroll") for (int _i = 0; _i < 2; ++_i) \
        __builtin_amdgcn_global_load_lds((const unsigned*)((const char*)(gbase) + (voff)[_i]), (PG8_LAS unsigned*)(lds + (bufoff) + ldsw + _i * 8192), 16, 0, 0); } while (0)
#define PG8_LDA(dst, b, h) do { _Pragma("unroll") for (int m = 0; m < 4; ++m) _Pragma("unroll") for (int k = 0; k < 2; ++k) dst[m][k] = *(const PG8_LAS bf16x8*)(lds + PG8_SA(b, h) + aoff + m * 2048 + k * 1024); } while (0)
#define PG8_LDB(dst, b, h) do { _Pragma("unroll") for (int n = 0; n < 2; ++n) _Pragma("unroll") for (int k = 0; k < 2; ++k) dst[n][k] = *(const PG8_LAS bf16x8*)(lds + PG8_SB(b, h) + boff + n * 2048 + k * 1024); } while (0)
#define PG8_MMA(ai, bj, At, Bt) do { __builtin_amdgcn_s_setprio(1); _Pragma("unroll") for (int m = 0; m < 4; ++m) _Pragma("unroll") for (int n = 0; n < 2; ++n) _Pragma("unroll") for (int k = 0; k < 2; ++k) \
        acc[ai][bj][m][n] = __builtin_amdgcn_mfma_f32_16x16x32_bf16(Bt[n][k], At[m][k], acc[ai][bj][m][n], 0, 0, 0); __builtin_amdgcn_s_setprio(0); } while (0)
#define PG8_WAIT_V(n) asm volatile("s_waitcnt vmcnt(" #n ")" ::: "memory")
#define PG8_WAIT_L(n) asm volatile("s_waitcnt lgkmcnt(" #n ")" ::: "memory")
#define PG8_BAR __builtin_amdgcn_s_barrier()
#define PG8_SCHED __builtin_amdgcn_sched_barrier(0)
    Unit cur, nxt; int ui = 0;
    if (!S.next(0, cur)) return;
    f32x4 acc[2][2][4][2];
#pragma unroll
    for (int a = 0; a < 2; ++a)
#pragma unroll
        for (int b = 0; b < 2; ++b)
#pragma unroll
            for (int m = 0; m < 4; ++m)
#pragma unroll
                for (int n = 0; n < 2; ++n) acc[a][b][m][n] = (f32x4){0.f, 0.f, 0.f, 0.f};
    bf16x8 At[4][2], B0[2][2], B1[2][2];
    const char* cA = (const char*)g.A + (size_t)cur.pm * tstep; const char* cB = (const char*)g.Bt + (size_t)cur.pn * tstep;
    S.a_ready(cur);
    if constexpr (SP2) {
        PG8_STAGE(PG8_SB(0, 0), cB, voffB); PG8_STAGE(PG8_SB(0, 1), cB + hstep, voffB); PG8_STAGE(PG8_SA(0, 0), cA, voffA); PG8_STAGE(PG8_SA(0, 1), cA + hstep, voffA);
        if (wr == 1) PG8_BAR;
        PG8_WAIT_V(2); PG8_BAR;
        PG8_STAGE(PG8_SB(1, 0), cB + kstep, voffB); PG8_STAGE(PG8_SA(1, 0), cA + kstep, voffA); PG8_STAGE(PG8_SB(1, 1), cB + hstep + kstep, voffB);
        PG8_WAIT_V(6); PG8_BAR;
    } else {
        PG8_STAGE(PG8_SB(0, 0), cB, voffB); PG8_STAGE(PG8_SA(0, 0), cA, voffA); PG8_STAGE(PG8_SB(0, 1), cB + hstep, voffB); PG8_STAGE(PG8_SA(0, 1), cA + hstep, voffA);
        if (wr == 1) PG8_BAR;
        PG8_WAIT_V(4); PG8_BAR;
        PG8_STAGE(PG8_SB(1, 0), cB + kstep, voffB); PG8_STAGE(PG8_SA(1, 0), cA + kstep, voffA); PG8_STAGE(PG8_SB(1, 1), cB + hstep + kstep, voffB);
        PG8_WAIT_V(6); PG8_BAR;
    }
    for (;;) {
        const bool has_next = S.next(ui + 1, nxt);
        const char* nA = has_next ? (const char*)g.A + (size_t)nxt.pm * tstep : cA; const char* nB = has_next ? (const char*)g.Bt + (size_t)nxt.pn * tstep : cB;
        for (int t = 0; t < nt; t += 2) {
            const bool last = (t == nt - 2);
            const char* a1 = cA + (size_t)(t + 1) * kstep;
            const char* a2 = last ? nA : cA + (size_t)(t + 2) * kstep; const char* b2 = last ? nB : cB + (size_t)(t + 2) * kstep;
            const char* a3 = a2 + kstep; const char* b3 = b2 + kstep;
            if (last && has_next) S.a_ready(nxt);
            if constexpr (SP2) {
            PG8_LDB(B0, 0, 0); PG8_LDB(B1, 0, 1); PG8_SCHED; PG8_LDA(At, 0, 0); PG8_STAGE(PG8_SA(1, 1), a1 + hstep, voffA);
            PG8_WAIT_V(8); PG8_WAIT_L(0); PG8_BAR; PG8_MMA(0, 0, At, B0); PG8_MMA(0, 1, At, B1); PG8_BAR; PG8_SCHED;
            PG8_LDA(At, 0, 1); PG8_STAGE(PG8_SB(0, 0), b2, voffB); PG8_STAGE(PG8_SB(0, 1), b2 + hstep, voffB); PG8_STAGE(PG8_SA(0, 0), a2, voffA);
            PG8_WAIT_V(8); PG8_WAIT_L(0); PG8_BAR; PG8_MMA(1, 0, At, B0); PG8_MMA(1, 1, At, B1); PG8_BAR; PG8_SCHED;
            PG8_LDB(B0, 1, 0); PG8_LDB(B1, 1, 1); PG8_SCHED; PG8_LDA(At, 1, 0); PG8_STAGE(PG8_SA(0, 1), a2 + hstep, voffA);
            PG8_WAIT_V(8); PG8_WAIT_L(0); PG8_BAR; PG8_MMA(0, 0, At, B0); PG8_MMA(0, 1, At, B1); PG8_BAR; PG8_SCHED;
            PG8_LDA(At, 1, 1); PG8_STAGE(PG8_SB(1, 0), b3, voffB); PG8_STAGE(PG8_SB(1, 1), b3 + hstep, voffB); PG8_STAGE(PG8_SA(1, 0), a3, voffA);
            PG8_WAIT_V(8); PG8_WAIT_L(0); PG8_BAR; PG8_MMA(1, 0, At, B0); PG8_MMA(1, 1, At, B1); PG8_BAR; PG8_SCHED;
            } else {
            PG8_LDB(B0, 0, 0); PG8_SCHED; PG8_LDA(At, 0, 0); PG8_STAGE(PG8_SA(1, 1), a1 + hstep, voffA);
            PG8_WAIT_L(8); PG8_BAR; PG8_WAIT_L(0); PG8_MMA(0, 0, At, B0); PG8_BAR; PG8_SCHED;
            PG8_LDB(B1, 0, 1); PG8_STAGE(PG8_SB(0, 0), b2, voffB);
            PG8_BAR; PG8_WAIT_L(0); PG8_MMA(0, 1, At, B1); PG8_BAR;
            PG8_LDA(At, 0, 1); PG8_STAGE(PG8_SA(0, 0), a2, voffA);
            PG8_BAR; PG8_WAIT_L(0); PG8_MMA(1, 0, At, B0); PG8_BAR; PG8_SCHED;
            PG8_STAGE(PG8_SB(0, 1), b2 + hstep, voffB);
            PG8_WAIT_V(6); PG8_BAR; PG8_MMA(1, 1, At, B1); PG8_BAR;
            PG8_LDB(B0, 1, 0); PG8_SCHED; PG8_LDA(At, 1, 0); PG8_STAGE(PG8_SA(0, 1), a2 + hstep, voffA);
            PG8_WAIT_L(8); PG8_BAR; PG8_WAIT_L(0); PG8_MMA(0, 0, At, B0); PG8_BAR; PG8_SCHED;
            PG8_LDB(B1, 1, 1); PG8_STAGE(PG8_SB(1, 0), b3, voffB);
            PG8_BAR; PG8_WAIT_L(0); PG8_MMA(0, 1, At, B1); PG8_BAR;
            PG8_LDA(At, 1, 1); PG8_STAGE(PG8_SA(1, 0), a3, voffA);
            PG8_BAR; PG8_WAIT_L(0); PG8_MMA(1, 0, At, B0); PG8_BAR; PG8_SCHED;
            PG8_STAGE(PG8_SB(1, 1), b3 + hstep, voffB);
            PG8_WAIT_V(6); PG8_BAR; PG8_MMA(1, 1, At, B1); PG8_BAR;
            }
        }
        if constexpr (ALIGN_EPI) { if (wr == 0) PG8_BAR; }
        if constexpr (!Epi::AFTER_DRAIN) { E(acc, cur, wr, wc, fr, fq); S.done(cur); }
        if (!has_next) break;
#pragma unroll
        for (int a = 0; a < 2; ++a)
#pragma unroll
            for (int b = 0; b < 2; ++b)
#pragma unroll
                for (int m = 0; m < 4; ++m)
#pragma unroll
                    for (int n = 0; n < 2; ++n) acc[a][b][m][n] = (f32x4){0.f, 0.f, 0.f, 0.f};
        cur = nxt; cA = nA; cB = nB; ++ui;
        if constexpr (ALIGN_EPI) { if (wr == 1) PG8_BAR; }
    }
    PG8_WAIT_V(0);
    if constexpr (!ALIGN_EPI) { if (wr == 0) PG8_BAR; }
    PG8_BAR;
    if constexpr (Epi::AFTER_DRAIN) { E.fused(acc, cur, wr, wc, fr, fq, lds, wid, lane); S.done(cur); }
#undef PG8_SA
#undef PG8_SB
#undef PG8_STAGE
#undef PG8_LDA
#undef PG8_LDB
#undef PG8_MMA
#undef PG8_WAIT_V
#undef PG8_WAIT_L
#undef PG8_BAR
#undef PG8_SCHED
}
}

#define LAS __attribute__((address_space(3)))
typedef unsigned short bf16_t;
typedef short bf16x8 __attribute__((ext_vector_type(8)));
typedef short s16x4 __attribute__((ext_vector_type(4)));
typedef float f32x4 __attribute__((ext_vector_type(4)));
typedef float f32x2 __attribute__((ext_vector_type(2)));
typedef float f32x16 __attribute__((ext_vector_type(16)));
typedef unsigned u32x4 __attribute__((ext_vector_type(4)));
typedef unsigned u32x2 __attribute__((ext_vector_type(2)));
typedef __bf16 bf16x2_t __attribute__((ext_vector_type(2)));

constexpr int DM = 1024, NLAT = 16384, NCTX = 4096, MROWS = 20480, DFF = 2816;
constexpr int NQ_E = 2304, NQ_O = 3072;
constexpr float EPS = 1e-6f;
constexpr float LOG2E = 1.4426950408889634f;
constexpr float SCL2 = 0.125f * LOG2E;

constexpr size_t MiB = 1u << 20;
constexpr size_t WS_BAR = 65536, WS_BAR_BYTES = 16384;
constexpr size_t WS_ROPE = 4096;
constexpr size_t WS_MOD = 1 * MiB;
constexpr size_t WS_W13T = 4 * MiB;
constexpr size_t WS_W2T = 92 * MiB;
constexpr size_t WS_WINAB = 136 * MiB;
constexpr size_t WS_WOUTAB = 145 * MiB;
constexpr size_t WS_WINC = 149 * MiB;
constexpr size_t WS_WOUTC = 161 * MiB;
constexpr size_t WS_CAK = 165 * MiB, WS_CAV = 167 * MiB, WS_CBK = 169 * MiB, WS_CBV = 177 * MiB, WS_CCK = 185 * MiB, WS_CCV = 201 * MiB;
constexpr size_t WS_X = 217 * MiB;
constexpr size_t WS_H = 297 * MiB;
constexpr size_t WS_O = 337 * MiB;
constexpr size_t WS_U = 377 * MiB;
constexpr size_t WS_END = 497 * MiB;

constexpr size_t OUT_YP = 0, OUT_YS = 4194304, OUT_AK = 20971520, OUT_AV = 22020096, OUT_BK = 23068672, OUT_BV = 27262976, OUT_CK = 31457280, OUT_CV = 39845888;

constexpr int LDS_BYTES = 131072 + 1024;

__device__ __forceinline__ unsigned pk2(float lo, float hi) { f32x2 v = {lo, hi}; bf16x2_t b = __builtin_convertvector(v, bf16x2_t); return __builtin_bit_cast(unsigned, b); }
__device__ __forceinline__ float wave_sum(float v) {
#pragma unroll
    for (int o = 1; o < 64; o <<= 1) v += __shfl_xor(v, o);
    return v;
}
__device__ __forceinline__ float fast_exp2(float x) { return __builtin_amdgcn_exp2f(x); }
__device__ __forceinline__ float fast_rcp(float x) { return __builtin_amdgcn_rcpf(x); }

struct Args { const float* in[26]; float* out; unsigned char* ws; int ph_lo, ph_hi; };
__device__ __forceinline__ const float* inp(const Args& a, int i) { asm volatile("" : "+s"(i)); return a.in[i]; }
__device__ __forceinline__ unsigned char* wsp(const Args& a) { unsigned char* p = a.ws; asm volatile("" : "+s"(p)); return p; }

struct EpiSwiGLU {
    static constexpr bool PERM = true, AFTER_DRAIN = false;
    bf16_t* U;
    __device__ __forceinline__ void operator()(const f32x4 (&acc)[2][2][4][2], const pg8::Unit& u, int wr, int wc, int fr, int fq) const {
        const int row0 = u.pm * 256 + wr * 64 + fr, col0 = u.pn * 128 + wc * 32 + 8 * fq;
#pragma unroll
        for (int ai = 0; ai < 2; ++ai)
#pragma unroll
            for (int m = 0; m < 4; ++m) {
                bf16_t* rowp = U + (size_t)(row0 + ai * 128 + m * 16) * DFF + col0;
                float o[8];
#pragma unroll
                for (int n = 0; n < 2; ++n)
#pragma unroll
                    for (int i = 0; i < 4; ++i) { const float a = acc[ai][0][m][n][i], b = acc[ai][1][m][n][i];
                        o[n * 4 + i] = a * fast_rcp(1.f + fast_exp2(-a * LOG2E)) * b; }
                u32x4 w; w.x = pk2(o[0], o[1]); w.y = pk2(o[2], o[3]); w.z = pk2(o[4], o[5]); w.w = pk2(o[6], o[7]);
                *(u32x4*)rowp = w;
            }
    }
};
struct EpiResid {
    static constexpr bool PERM = false, AFTER_DRAIN = false;
    float* x; const float* gate; float coef;
    __device__ __forceinline__ void operator()(const f32x4 (&acc)[2][2][4][2], const pg8::Unit& u, int wr, int wc, int fr, int fq) const {
        const int mi = u.pm < 64 ? (u.pm >> 3) : 8;
        const float* g = gate + (size_t)mi * 9216;
        const int col0 = u.pn * 256 + wc * 32 + 4 * fq;
        f32x4 g4[2][2];
#pragma unroll
        for (int bj = 0; bj < 2; ++bj)
#pragma unroll
            for (int n = 0; n < 2; ++n) g4[bj][n] = *(const f32x4*)(g + col0 + bj * 128 + n * 16) * coef;
#pragma unroll
        for (int ai = 0; ai < 2; ++ai)
#pragma unroll
            for (int m = 0; m < 4; ++m) {
                float* p = x + (size_t)(u.pm * 256 + ai * 128 + wr * 64 + m * 16 + fr) * DM + col0;
#pragma unroll
                for (int bj = 0; bj < 2; ++bj)
#pragma unroll
                    for (int n = 0; n < 2; ++n) { float* q = p + bj * 128 + n * 16; *(f32x4*)q = *(const f32x4*)q + g4[bj][n] * acc[ai][bj][m][n]; }
                asm volatile("" ::: "memory");
            }
    }
};
struct EpiQKV {
    static constexpr bool PERM = false, AFTER_DRAIN = false;
    bf16_t* Q; int ldq; int even; int e; const float* qn; const float* kn; const f32x2* rope; float* out;
    __device__ __forceinline__ void operator()(const f32x4 (&acc)[2][2][4][2], const pg8::Unit& u, int wr, int wc, int fr, int fq) const {
        const int hu = 4 * u.pn + wc;
        const bool lat = u.pm < 64;
        bool do_rope; const float* nw = nullptr; float* ob = nullptr; int ow = 0;
        if (even) {
            do_rope = hu < 10;
            if (hu < 8) nw = qn; else if (hu < 10) { nw = kn; ob = out + OUT_AK + 64 * (hu - 8); ow = 128; }
            else if (hu < 12) { ob = out + OUT_AV + 64 * (hu - 10); ow = 128; }
            else if (hu < 20) {}
            else if (hu < 28) { ob = out + OUT_BK + 64 * (hu - 20); ow = 512; }
            else { ob = out + OUT_BV + 64 * (hu - 28); ow = 512; }
        } else {
            do_rope = hu < 32;
            if (hu < 16) {} else if (hu < 32) { ob = out + OUT_CK + 64 * (hu - 16); ow = 1024; }
            else { ob = out + OUT_CV + 64 * (hu - 32); ow = 1024; }
        }
        f32x4 w4[2][2];
        if (nw) {
#pragma unroll
            for (int bj = 0; bj < 2; ++bj)
#pragma unroll
                for (int n = 0; n < 2; ++n) w4[bj][n] = *(const f32x4*)(nw + 32 * bj + 16 * n + 4 * fq);
        }
#pragma unroll
        for (int ai = 0; ai < 2; ++ai)
#pragma unroll
            for (int m = 0; m < 4; ++m) {
                const int row = u.pm * 256 + ai * 128 + wr * 64 + m * 16 + fr;
                f32x4 v[2][2];
#pragma unroll
                for (int bj = 0; bj < 2; ++bj)
#pragma unroll
                    for (int n = 0; n < 2; ++n) v[bj][n] = acc[ai][bj][m][n];
                if (nw) {
                    float ss = 0.f;
#pragma unroll
                    for (int bj = 0; bj < 2; ++bj)
#pragma unroll
                        for (int n = 0; n < 2; ++n) ss += (v[bj][n][0] * v[bj][n][0] + v[bj][n][1] * v[bj][n][1]) + (v[bj][n][2] * v[bj][n][2] + v[bj][n][3] * v[bj][n][3]);
                    ss += __shfl_xor(ss, 16); ss += __shfl_xor(ss, 32);
                    const float rstd = rsqrtf(ss * (1.f / 64.f) + EPS);
#pragma unroll
                    for (int bj = 0; bj < 2; ++bj)
#pragma unroll
                        for (int n = 0; n < 2; ++n) v[bj][n] = v[bj][n] * rstd * w4[bj][n];
                }
                if (do_rope && lat) {
                    const int t = row & 2047;
#pragma unroll
                    for (int bj = 0; bj < 2; ++bj) {
                        const int pos = bj ? (t & 63) : (t >> 6);
                        const f32x2* rp = rope + pos * 16 + 4 * fq;
#pragma unroll
                        for (int i = 0; i < 4; ++i) { const f32x2 cs = rp[i]; const float x1 = v[bj][0][i], x2 = v[bj][1][i];
                            v[bj][0][i] = x1 * cs.x - x2 * cs.y; v[bj][1][i] = x2 * cs.x + x1 * cs.y; }
                    }
                }
                bf16_t* qp = Q + (size_t)row * ldq + 64 * hu + 4 * fq;
#pragma unroll
                for (int bj = 0; bj < 2; ++bj)
#pragma unroll
                    for (int n = 0; n < 2; ++n) { u32x2 w; w.x = pk2(v[bj][n][0], v[bj][n][1]); w.y = pk2(v[bj][n][2], v[bj][n][3]); *(u32x2*)(qp + 32 * bj + 16 * n) = w; }
                if (ob && !lat) {
                    const int cr = row - NLAT, b = cr >> 8, s = cr & 255;
                    float* op = ob + (size_t)((b * 2 + e) * 256 + s) * ow + 4 * fq;
#pragma unroll
                    for (int bj = 0; bj < 2; ++bj)
#pragma unroll
                        for (int n = 0; n < 2; ++n) *(f32x4*)(op + 32 * bj + 16 * n) = v[bj][n];
                }
            }
    }
};

__device__ __forceinline__ void transpose_item(const float* W, int K, int N, bf16_t* WT, int k0, int n0, int drow, LAS float* scr, int lane) {
#pragma unroll 8
    for (int i = 0; i < 32; ++i) { const int kk = 2 * i + (lane >> 5); scr[kk * 33 + (lane & 31)] = W[(size_t)(k0 + kk) * N + n0 + (lane & 31)]; }
    asm volatile("s_waitcnt lgkmcnt(0)" ::: "memory");
    const int c = lane & 7;
#pragma unroll
    for (int j = 0; j < 4; ++j) { const int n = (lane >> 3) + 8 * j; const LAS float* s = scr + (8 * c) * 33 + n;
        u32x4 o; o.x = pk2(s[0 * 33], s[1 * 33]); o.y = pk2(s[2 * 33], s[3 * 33]); o.z = pk2(s[4 * 33], s[5 * 33]); o.w = pk2(s[6 * 33], s[7 * 33]);
        *(u32x4*)(WT + (size_t)(drow + n) * K + k0 + 8 * c) = o; }
    asm volatile("s_waitcnt lgkmcnt(0)" ::: "memory");
}
__device__ __forceinline__ int qkv_drow(int n0) { const int hu = n0 >> 6, bj = (n0 >> 5) & 1; return 256 * (hu >> 2) + 128 * bj + 32 * (hu & 3); }

__device__ __forceinline__ void cvt_seg(const float* src, bf16_t* dst, int n4, int gt, int NT) {
    for (int i = gt; i < n4; i += NT) { const f32x4 v = ((const f32x4*)src)[i]; u32x2 w; w.x = pk2(v[0], v[1]); w.y = pk2(v[2], v[3]); ((u32x2*)dst)[i] = w; }
}

__device__ __forceinline__ void prologue_phase(const Args& a, LAS unsigned char* lds, int vcu, int G) {
    const int tid = opaque_tid(), lane = tid & 63, wave = __builtin_amdgcn_readfirstlane(tid >> 6);
    unsigned char* ws = wsp(a);
    {
        LAS float* sc = (LAS float*)lds;
        LAS f32x4* red = (LAS f32x4*)(lds + 36864);
        const int first = G - 1 - (int)blockIdx.x;
        if (first < 144) {
            for (int i = tid; i < 9 * 1024; i += 512) { const int r = i >> 10, k = i & 1023; const float cv = r < 8 ? inp(a, 8)[r * 1024 + k] : inp(a, 9)[k]; sc[i] = cv / (1.f + __expf(-cv)); }
            __syncthreads();
            for (int item = first; item < 144; item += G) {
                const int l = item / 36, cb = item % 36, col = cb * 256 + lane * 4;
                const float* wp = inp(a, 10) + ((size_t)l * 1024 + wave * 128) * 9216 + col;
                f32x4 acc[9];
#pragma unroll
                for (int r = 0; r < 9; ++r) acc[r] = (f32x4){0.f, 0.f, 0.f, 0.f};
#pragma unroll 4
                for (int k = 0; k < 128; ++k) {
                    const f32x4 wv = *(const f32x4*)(wp + (size_t)k * 9216);
#pragma unroll
                    for (int r = 0; r < 9; ++r) acc[r] += wv * sc[r * 1024 + wave * 128 + k];
                }
#pragma unroll
                for (int r = 0; r < 9; ++r) red[(wave * 9 + r) * 64 + lane] = acc[r];
                __syncthreads();
                for (int o = tid; o < 9 * 64; o += 512) {
                    const int r = o >> 6, ln = o & 63;
                    f32x4 s = *(const f32x4*)(inp(a, 11) + l * 9216 + cb * 256 + ln * 4);
#pragma unroll
                    for (int w = 0; w < 8; ++w) s += red[(w * 9 + r) * 64 + ln];
                    *(f32x4*)((float*)(ws + WS_MOD) + ((size_t)l * 9 + r) * 9216 + cb * 256 + ln * 4) = s;
                }
                __syncthreads();
            }
        }
        __syncthreads();
    }
    {
        LAS float* scr = (LAS float*)(lds + wave * 8704);
        const int gw = vcu * 8 + wave, NGW = G * 8;
        for (int it = gw; it < 41216; it += NGW) {
            if (it < 33792) {
                const int lf = it / 4224, r = it % 4224, which = r / 1408, q = r % 1408;
                if (which < 2) { const int kb = q / 88, nb = q % 88, n0 = 32 * nb; const int drow = 256 * (n0 >> 7) + (n0 & 127) + 128 * which;
                    transpose_item(inp(a, which == 0 ? 13 : 14) + (size_t)lf * 1024 * DFF, 1024, DFF, (bf16_t*)(ws + WS_W13T) + (size_t)lf * 5632 * 1024, 64 * kb, n0, drow, scr, lane); }
                else { const int kb = q / 32, nb = q % 32;
                    transpose_item(inp(a, 15) + (size_t)lf * DFF * 1024, DFF, 1024, (bf16_t*)(ws + WS_W2T) + (size_t)lf * 1024 * DFF, 64 * kb, 32 * nb, 32 * nb, scr, lane); }
            } else {
                int r = it - 33792;
                if (r < 2304) { const int e = r / 1152, q = r % 1152, kb = q / 72, nb = q % 72;
                    transpose_item(inp(a, 16) + (size_t)e * 1024 * NQ_E, 1024, NQ_E, (bf16_t*)(ws + WS_WINAB) + (size_t)e * NQ_E * 1024, 64 * kb, 32 * nb, qkv_drow(32 * nb), scr, lane); continue; }
                r -= 2304;
                if (r < 3072) { const int e = r / 1536, q = r % 1536, kb = q / 96, nb = q % 96;
                    transpose_item(inp(a, 21) + (size_t)e * 1024 * NQ_O, 1024, NQ_O, (bf16_t*)(ws + WS_WINC) + (size_t)e * NQ_O * 1024, 64 * kb, 32 * nb, qkv_drow(32 * nb), scr, lane); continue; }
                r -= 3072;
                if (r < 1024) { const int e = r / 512, q = r % 512, kb = q / 32, nb = q % 32;
                    transpose_item(inp(a, 17) + (size_t)e * 1024 * 1024, 1024, 1024, (bf16_t*)(ws + WS_WOUTAB) + (size_t)e * 1024 * 1024, 64 * kb, 32 * nb, 32 * nb, scr, lane); continue; }
                r -= 1024;
                { const int e = r / 512, q = r % 512, kb = q / 32, nb = q % 32;
                    transpose_item(inp(a, 22) + (size_t)e * 1024 * 1024, 1024, 1024, (bf16_t*)(ws + WS_WOUTC) + (size_t)e * 1024 * 1024, 64 * kb, 32 * nb, 32 * nb, scr, lane); }
            }
        }
    }
    {
        const int gt = blockIdx.x * 512 + tid, NT = G * 512;
        cvt_seg(inp(a, 2), (bf16_t*)(ws + WS_CAK), 1048576 / 4, gt, NT);
        cvt_seg(inp(a, 3), (bf16_t*)(ws + WS_CAV), 1048576 / 4, gt, NT);
        cvt_seg(inp(a, 4), (bf16_t*)(ws + WS_CBK), 4194304 / 4, gt, NT);
        cvt_seg(inp(a, 5), (bf16_t*)(ws + WS_CBV), 4194304 / 4, gt, NT);
        cvt_seg(inp(a, 6), (bf16_t*)(ws + WS_CCK), 8388608 / 4, gt, NT);
        cvt_seg(inp(a, 7), (bf16_t*)(ws + WS_CCV), 8388608 / 4, gt, NT);
        if (gt < 1024) { const int pos = gt >> 4, f = gt & 15;
            const float inv = exp2f(-(float)f * (13.287712379549449f / 16.f));
            const float rev = (float)pos * inv * 0.15915494309189535f;
            f32x2 cs; cs.x = __builtin_amdgcn_cosf(rev); cs.y = __builtin_amdgcn_sinf(rev);
            ((f32x2*)(ws + WS_ROPE))[gt] = cs; }
    }
}

__device__ __forceinline__ void norm_phase(const Args& a, bool first, const float* nw, const float* modl, int sub, int vcu, int G) {
    const int tid = opaque_tid(), lane = tid & 63, wave = tid >> 6;
    float* xb = (float*)(wsp(a) + WS_X); bf16_t* hb = (bf16_t*)(wsp(a) + WS_H);
    for (int row = vcu * 8 + wave; row < MROWS; row += G * 8) {
        const float* xr = first ? (row < NLAT ? inp(a, 1) + (size_t)row * DM : inp(a, 0) + (size_t)(row - NLAT) * DM) : xb + (size_t)row * DM;
        f32x4 v[4]; float ss = 0.f;
#pragma unroll
        for (int j = 0; j < 4; ++j) { v[j] = ((const f32x4*)xr)[lane + 64 * j]; ss += (v[j][0] * v[j][0] + v[j][1] * v[j][1]) + (v[j][2] * v[j][2] + v[j][3] * v[j][3]); }
        const float rstd = rsqrtf(wave_sum(ss) * (1.f / DM) + EPS);
        if (first) {
#pragma unroll
            for (int j = 0; j < 4; ++j) ((f32x4*)(xb + (size_t)row * DM))[lane + 64 * j] = v[j];
        }
        const int mi = row < NLAT ? (row >> 11) : 8;
        const float* sh = modl + (size_t)mi * 9216 + (3 * sub) * 1024; const float* sc = sh + 1024;
#pragma unroll
        for (int j = 0; j < 4; ++j) {
            const int c4 = lane + 64 * j;
            const f32x4 w = ((const f32x4*)nw)[c4], s4 = ((const f32x4*)sc)[c4], m4 = ((const f32x4*)sh)[c4];
            const f32x4 o = v[j] * rstd * w * (1.f + s4) + m4;
            u32x2 pw; pw.x = pk2(o[0], o[1]); pw.y = pk2(o[2], o[3]);
            ((u32x2*)(hb + (size_t)row * DM))[c4] = pw;
        }
    }
}
__device__ __forceinline__ void final_norm_phase(const Args& a, int vcu, int G) {
    const int tid = opaque_tid(), lane = tid & 63, wave = tid >> 6;
    const float* xb = (const float*)(wsp(a) + WS_X); const float* nw = inp(a, 25);
    for (int row = vcu * 8 + wave; row < MROWS; row += G * 8) {
        const float* xr = xb + (size_t)row * DM;
        float* orow = row < NLAT ? a.out + OUT_YS + (size_t)row * DM : a.out + OUT_YP + (size_t)(row - NLAT) * DM;
        f32x4 v[4]; float ss = 0.f;
#pragma unroll
        for (int j = 0; j < 4; ++j) { v[j] = ((const f32x4*)xr)[lane + 64 * j]; ss += (v[j][0] * v[j][0] + v[j][1] * v[j][1]) + (v[j][2] * v[j][2] + v[j][3] * v[j][3]); }
        const float rstd = rsqrtf(wave_sum(ss) * (1.f / DM) + EPS);
#pragma unroll
        for (int j = 0; j < 4; ++j) ((f32x4*)orow)[lane + 64 * j] = v[j] * rstd * ((const f32x4*)nw)[lane + 64 * j];
    }
}

struct KVSrc { const bf16_t* k; const bf16_t* v; int ks, vs; };
constexpr int AT_K = 0, AT_V = 16384, AT_BIAS = 49152;
__device__ __forceinline__ int crow(int r, int hi) { return (r & 3) + 8 * (r >> 2) + 4 * hi; }
typedef short v4i16_t __attribute__((ext_vector_type(4)));
__device__ __forceinline__ s16x4 vtr(const LAS unsigned char* p) { return __builtin_bit_cast(s16x4, __builtin_amdgcn_ds_read_tr16_b64_v4i16((LAS v4i16_t*)p)); }

template <int DV, bool NB>
__device__ __forceinline__ void attn_pass(LAS unsigned char* lds, const bf16x8 (&qr)[4], const KVSrc s0, const int nt0, const KVSrc s1, const int nt1,
                                          f32x16 (&OT)[DV / 32], float& m_run, float& l_run,
                                          const int R, const int c, const int kr0) {
    constexpr int NV = DV / 64;
    const int tid = opaque_tid(), lane = tid & 63, r32 = lane & 31, hi = lane >> 5;
    const int NT = nt0 + nt1;
    const int kkv = tid >> 3, kch = tid & 7;
    u32x4 kreg, vreg[NV];
#define AT_LOAD(t_) do { const int t__ = (t_); const bool f__ = t__ < nt0; const int tt__ = f__ ? t__ : t__ - nt0; \
        const bf16_t* kp__ = f__ ? s0.k : s1.k; const bf16_t* vp__ = f__ ? s0.v : s1.v; const int ks__ = f__ ? s0.ks : s1.ks, vs__ = f__ ? s0.vs : s1.vs; \
        kreg = *(const u32x4*)(kp__ + (size_t)(tt__ * 64 + kkv) * ks__ + kch * 8); \
        _Pragma("unroll") for (int i__ = 0; i__ < NV; ++i__) { const int cc__ = tid + 512 * i__; const int vkv__ = NV == 1 ? (cc__ >> 3) : (cc__ >> 4), vch__ = NV == 1 ? (cc__ & 7) : (cc__ & 15); \
            vreg[i__] = *(const u32x4*)(vp__ + (size_t)(tt__ * 64 + vkv__) * vs__ + vch__ * 8); } } while (0)
#define AT_STORE(b_) do { const int b__ = (b_); *(LAS u32x4*)(lds + AT_K + b__ * 8192 + kch * 1024 + kkv * 16) = kreg; \
        _Pragma("unroll") for (int i__ = 0; i__ < NV; ++i__) { const int cc__ = tid + 512 * i__; const int vkv__ = NV == 1 ? (cc__ >> 3) : (cc__ >> 4), vch__ = NV == 1 ? (cc__ & 7) : (cc__ & 15); \
            *(LAS u32x4*)(lds + AT_V + b__ * 16384 + (vch__ >> 2) * 4096 + vkv__ * 64 + (vch__ & 3) * 16) = vreg[i__]; } } while (0)
    AT_LOAD(0); AT_STORE(0);
    __syncthreads();
    const int rs = NB ? min(max(R - 4, 0), 24) : 0;
    const int cs = NB ? min(max(c - 8, 0), 48) : 0;
    const LAS float* biasL = (const LAS float*)(lds + AT_BIAS);
    const int vlane = ((lane >> 4) & 1) * 32 + (lane & 3) * 8 + (4 * hi + ((lane & 15) >> 2)) * 64;
    for (int t = 0; t < NT; ++t) {
        const int buf = t & 1;
        if (t + 1 < NT) AT_LOAD(t + 1);
        const int kr = kr0 + (t - nt0);
        const bool active = !NB || t < nt0 || (kr >= rs && kr < rs + 8);
        if (active) {
            const LAS unsigned char* Kb = lds + AT_K + buf * 8192 + hi * 1024 + r32 * 16;
            f32x16 p0 = {}, p1 = {};
#pragma unroll
            for (int d0 = 0; d0 < 4; ++d0) {
                const bf16x8 b0 = *(const LAS bf16x8*)(Kb + d0 * 2048), b1 = *(const LAS bf16x8*)(Kb + d0 * 2048 + 512);
                p0 = __builtin_amdgcn_mfma_f32_32x32x16_bf16(b0, qr[d0], p0, 0, 0, 0);
                p1 = __builtin_amdgcn_mfma_f32_32x32x16_bf16(b1, qr[d0], p1, 0, 0, 0);
            }
            if (NB && t >= nt0) {
                const LAS float* brow = biasL + (kr - R + 7) * 31;
#pragma unroll
                for (int r = 0; r < 16; ++r) {
                    const int kc0 = crow(r, hi), kc1 = kc0 + 32;
                    const int i0 = min(max(kc0 - c + 15, 0), 30), i1 = min(max(kc1 - c + 15, 0), 30);
                    const float b0 = brow[i0], b1 = brow[i1];
                    p0[r] = (kc0 >= cs && kc0 < cs + 16) ? p0[r] * SCL2 + b0 : -1e30f;
                    p1[r] = (kc1 >= cs && kc1 < cs + 16) ? p1[r] * SCL2 + b1 : -1e30f;
                }
            } else {
#pragma unroll
                for (int r = 0; r < 16; ++r) { p0[r] *= SCL2; p1[r] *= SCL2; }
            }
            float rm = fmaxf(p0[0], p1[0]);
#pragma unroll
            for (int r = 1; r < 16; ++r) rm = fmaxf(rm, fmaxf(p0[r], p1[r]));
            rm = fmaxf(rm, __shfl_xor(rm, 32));
            const float mn = fmaxf(m_run, rm);
            const float alpha = fast_exp2(m_run - mn);
            m_run = mn;
            float ls = 0.f;
#pragma unroll
            for (int r = 0; r < 16; ++r) { p0[r] = fast_exp2(p0[r] - mn); p1[r] = fast_exp2(p1[r] - mn); ls += p0[r] + p1[r]; }
            l_run = l_run * alpha + ls;
#pragma unroll
            for (int d = 0; d < DV / 32; ++d) OT[d] *= alpha;
            bf16x8 pa[4];
#pragma unroll
            for (int k = 0; k < 4; ++k) {
                u32x4 w;
                if (k < 2) { w.x = pk2(p0[8 * k + 0], p0[8 * k + 1]); w.y = pk2(p0[8 * k + 2], p0[8 * k + 3]); w.z = pk2(p0[8 * k + 4], p0[8 * k + 5]); w.w = pk2(p0[8 * k + 6], p0[8 * k + 7]); }
                else { const int kk = k - 2; w.x = pk2(p1[8 * kk + 0], p1[8 * kk + 1]); w.y = pk2(p1[8 * kk + 2], p1[8 * kk + 3]); w.z = pk2(p1[8 * kk + 4], p1[8 * kk + 5]); w.w = pk2(p1[8 * kk + 6], p1[8 * kk + 7]); }
                pa[k] = __builtin_bit_cast(bf16x8, w);
            }
            const LAS unsigned char* Vb = lds + AT_V + buf * 16384 + vlane;
#pragma unroll
            for (int d = 0; d < DV / 32; ++d)
#pragma unroll
                for (int k = 0; k < 4; ++k) {
                    const s16x4 lo = vtr(Vb + d * 4096 + k * 1024), hh = vtr(Vb + d * 4096 + k * 1024 + 512);
                    const bf16x8 vf = {lo[0], lo[1], lo[2], lo[3], hh[0], hh[1], hh[2], hh[3]};
                    OT[d] = __builtin_amdgcn_mfma_f32_32x32x16_bf16(vf, pa[k], OT[d], 0, 0, 0);
                }
        }
        if (t + 1 < NT) AT_STORE(buf ^ 1);
        __syncthreads();
    }
#undef AT_LOAD
#undef AT_STORE
}

__device__ __forceinline__ void load_q(bf16x8 (&qr)[4], const bf16_t* Q, int ldq) {
    const int tid = opaque_tid(), lane = tid & 63, r32 = lane & 31, hi = lane >> 5, wid = tid >> 6;
    const bf16_t* p = Q + (size_t)(wid * 32 + r32) * ldq + hi * 8;
#pragma unroll
    for (int d0 = 0; d0 < 4; ++d0) qr[d0] = *(const bf16x8*)(p + d0 * 16);
}
__device__ __forceinline__ void store_o64(const f32x16 (&OT)[2], float l_run, bf16_t* O  ) {
    const int tid = opaque_tid(), lane = tid & 63, r32 = lane & 31, hi = lane >> 5, wid = tid >> 6;
    const float inv = 1.f / (l_run + __shfl_xor(l_run, 32));
    bf16_t* op = O + (size_t)(wid * 32 + r32) * DM + 4 * hi;
#pragma unroll
    for (int d = 0; d < 2; ++d)
#pragma unroll
        for (int g = 0; g < 4; ++g) { u32x2 w; w.x = pk2(OT[d][4 * g] * inv, OT[d][4 * g + 1] * inv); w.y = pk2(OT[d][4 * g + 2] * inv, OT[d][4 * g + 3] * inv); *(u32x2*)(op + 32 * d + 8 * g) = w; }
}

__device__ __forceinline__ void attn_even_phase(const Args& a, LAS unsigned char* lds, int e, int vcu, int G) {
    const int tid = opaque_tid(), lane = tid & 63, r32 = lane & 31, wid = tid >> 6;
    unsigned char* ws = wsp(a);
    const bf16_t* QKV = (const bf16_t*)(ws + WS_U); bf16_t* OB = (bf16_t*)(ws + WS_O);
    for (int u = vcu; u < 1280; u += G) {
        bf16x8 qr[4]; f32x16 OT[2]; OT[0] = f32x16{}; OT[1] = f32x16{};
        float m_run = -1e30f, l_run = 0.f;
        if (u < 512) {
            const int b = u >> 6, h = (u >> 3) & 7, qb = u & 7, g = h >> 2;
            const size_t row0 = (size_t)b * 2048 + qb * 256;
            load_q(qr, QKV + row0 * NQ_E + 64 * h, NQ_E);
            const KVSrc s0{QKV + (size_t)b * 2048 * NQ_E + 512 + 64 * g, QKV + (size_t)b * 2048 * NQ_E + 640 + 64 * g, NQ_E, NQ_E};
            const size_t co = (size_t)(b * 2 + e) * 512 * 128 + 64 * g;
            const KVSrc s1{(const bf16_t*)(ws + WS_CAK) + co, (const bf16_t*)(ws + WS_CAV) + co, 128, 128};
            attn_pass<64, false>(lds, qr, s0, 32, s1, 8, OT, m_run, l_run, 0, 0, 0);
            store_o64(OT, l_run, OB + row0 * DM + 64 * h);
        } else if (u < 1024) {
            const int v = u - 512, b = v >> 6, h = (v >> 3) & 7, qb = v & 7;
            const size_t row0 = (size_t)b * 2048 + qb * 256;
            for (int i = tid; i < 465; i += 512) ((LAS float*)(lds + AT_BIAS))[i] = inp(a, 20)[(size_t)(e * 8 + h) * 465 + i] * LOG2E;
            load_q(qr, QKV + row0 * NQ_E + 768 + 64 * h, NQ_E);
            const size_t co = (size_t)(b * 2 + e) * 512 * 512 + 64 * h;
            const KVSrc s0{(const bf16_t*)(ws + WS_CBK) + co, (const bf16_t*)(ws + WS_CBV) + co, 512, 512};
            const int klo = min(max(4 * qb - 4, 0), 24), khi = min(max(4 * qb - 1, 0), 24) + 8;
            const size_t lo = ((size_t)b * 2048 + klo * 64) * NQ_E;
            const KVSrc s1{QKV + lo + 1280 + 64 * h, QKV + lo + 1792 + 64 * h, NQ_E, NQ_E};
            attn_pass<64, true>(lds, qr, s0, 8, s1, khi - klo, OT, m_run, l_run, 4 * qb + (wid >> 1), 32 * (wid & 1) + r32, klo);
            store_o64(OT, l_run, OB + row0 * DM + 512 + 64 * h);
        } else {
            const int v = u - 1024, isb = v >> 7, b = (v >> 3) & 15, h = v & 7;
            const size_t row0 = (size_t)NLAT + b * 256;
            const int qc = isb ? 768 + 64 * h : 64 * h, kc = isb ? 1280 + 64 * h : 512 + 64 * (h >> 2), vc = isb ? 1792 + 64 * h : 640 + 64 * (h >> 2);
            load_q(qr, QKV + row0 * NQ_E + qc, NQ_E);
            const KVSrc s0{QKV + row0 * NQ_E + kc, QKV + row0 * NQ_E + vc, NQ_E, NQ_E};
            attn_pass<64, false>(lds, qr, s0, 4, s0, 0, OT, m_run, l_run, 0, 0, 0);
            store_o64(OT, l_run, OB + row0 * DM + (isb ? 512 : 0) + 64 * h);
        }
    }
}

__device__ __forceinline__ void attn_odd_phase(const Args& a, LAS unsigned char* lds, int o, float lam_init, int vcu, int G) {
    const int tid = opaque_tid(), lane = tid & 63, r32 = lane & 31, hi = lane >> 5, wid = tid >> 6;
    unsigned char* ws = wsp(a);
    const bf16_t* QKV = (const bf16_t*)(ws + WS_U); bf16_t* OB = (bf16_t*)(ws + WS_O);
    const float* lp = inp(a, 23) + o * 256;
    const float lam = __expf(wave_sum(lp[lane] * lp[64 + lane])) - __expf(wave_sum(lp[128 + lane] * lp[192 + lane])) + lam_init;
    const float* sub = inp(a, 24) + o * 128;
    for (int u = vcu; u < 640; u += G) {
        int b, h, qb, nt0, nt1; size_t row0, krow0;
        if (u < 512) { b = u >> 6; h = (u >> 3) & 7; qb = u & 7; row0 = (size_t)b * 2048 + qb * 256; krow0 = (size_t)b * 2048; nt0 = 32; nt1 = 8; }
        else { const int v = u - 512; b = v >> 3; h = v & 7; qb = 0; row0 = (size_t)NLAT + b * 256; krow0 = row0; nt0 = 4; nt1 = 0; }
        unsigned O0p[4][8];
#pragma unroll
        for (int j = 0; j < 2; ++j) {
            bf16x8 qr[4]; f32x16 OT[4];
#pragma unroll
            for (int d = 0; d < 4; ++d) OT[d] = f32x16{};
            float m_run = -1e30f, l_run = 0.f;
            load_q(qr, QKV + row0 * NQ_O + 128 * h + 64 * j, NQ_O);
            const KVSrc s0{QKV + krow0 * NQ_O + 1024 + 128 * h + 64 * j, QKV + krow0 * NQ_O + 2048 + 128 * h, NQ_O, NQ_O};
            const size_t co = (size_t)((b & 7) * 2 + o) * 512 * 1024 + 128 * h;
            const KVSrc s1{(const bf16_t*)(ws + WS_CCK) + co + 64 * j, (const bf16_t*)(ws + WS_CCV) + co, 1024, 1024};
            attn_pass<128, false>(lds, qr, s0, nt0, s1, nt1, OT, m_run, l_run, 0, 0, 0);
            const float inv = 1.f / (l_run + __shfl_xor(l_run, 32));
            if (j == 0) {
#pragma unroll
                for (int d = 0; d < 4; ++d)
#pragma unroll
                    for (int r = 0; r < 8; ++r) O0p[d][r] = pk2(OT[d][2 * r] * inv, OT[d][2 * r + 1] * inv);
            } else {
                const float f1 = lam * inv; float ss = 0.f;
#pragma unroll
                for (int d = 0; d < 4; ++d)
#pragma unroll
                    for (int r = 0; r < 8; ++r) {
                        const float a0 = __uint_as_float(O0p[d][r] << 16), a1 = __uint_as_float(O0p[d][r] & 0xffff0000u);
                        OT[d][2 * r] = a0 - OT[d][2 * r] * f1; OT[d][2 * r + 1] = a1 - OT[d][2 * r + 1] * f1;
                        ss += OT[d][2 * r] * OT[d][2 * r] + OT[d][2 * r + 1] * OT[d][2 * r + 1];
                    }
                ss += __shfl_xor(ss, 32);
                const float rstd = rsqrtf(ss * (1.f / 128.f) + EPS) * (1.f - lam_init);
                bf16_t* op = OB + (row0 + wid * 32 + r32) * DM + 128 * h + 4 * hi;
#pragma unroll
                for (int d = 0; d < 4; ++d)
#pragma unroll
                    for (int g = 0; g < 4; ++g) {
                        const f32x4 sw = *(const f32x4*)(sub + 32 * d + 8 * g + 4 * hi);
                        u32x2 w; w.x = pk2(OT[d][4 * g] * rstd * sw[0], OT[d][4 * g + 1] * rstd * sw[1]); w.y = pk2(OT[d][4 * g + 2] * rstd * sw[2], OT[d][4 * g + 3] * rstd * sw[3]);
                        *(u32x2*)(op + 32 * d + 8 * g) = w;
                    }
            }
        }
    }
}

#define XB_TMO      128
#define XB_XCNT(j)  (256  + 64 * (j))
#define XB_XSUB(j)  (1280 + 64 * (j))
#define XB_XGEN(j)  (2304 + 64 * (j))
#define XB_TOP      3328
#define XB_TOPGEN   3392
#define XCD_BAR_WORDS 3456
#define XB_SPIN_CAP (1u << 18)

__device__ __forceinline__ unsigned xb_ld(unsigned* p)              { return __hip_atomic_load(p, __ATOMIC_RELAXED, __HIP_MEMORY_SCOPE_AGENT); }
__device__ __forceinline__ unsigned xb_add(unsigned* p, unsigned v) { return __hip_atomic_fetch_add(p, v, __ATOMIC_RELAXED, __HIP_MEMORY_SCOPE_AGENT); }
__device__ __forceinline__ unsigned xb_xcc_id() { return (unsigned)__builtin_amdgcn_s_getreg((3 << 11) | 20) & 0xFu; }
#define XB_SPIN(cond, bar) do { unsigned _sp = 0; while (cond) { __builtin_amdgcn_s_sleep(1); \
    if ((++_sp & 255u) == 0u) { if (xb_ld(&(bar)[XB_TMO])) break; if (_sp > XB_SPIN_CAP) { atomicAdd(&(bar)[XB_TMO], 1u); break; } } } } while (0)

struct XcdBarrier {
    unsigned* bar; unsigned x;
    volatile LAS unsigned* st;
};

__device__ __forceinline__ XcdBarrier xcd_barrier_post(unsigned* bar, volatile LAS unsigned* st) {
    XcdBarrier b; b.bar = bar; b.x = xb_xcc_id(); b.st = st;
    if (threadIdx.x == 0) (void)xb_add(&bar[XB_XCNT(b.x)], 1u);
    return b;
}
__device__ __forceinline__ void xcd_barrier_complete(unsigned* bar, unsigned x, unsigned& nloc, unsigned& nx) {
    const unsigned G = gridDim.x * gridDim.y * gridDim.z;
    unsigned sum, cnt, mine, sp = 0u;
    for (;;) {
        sum = 0u; cnt = 0u; mine = 0u;
#pragma unroll
        for (unsigned j = 0; j < 16; ++j) { const unsigned c = xb_ld(&bar[XB_XCNT(j)]); sum += c; cnt += (c > 0u) ? 1u : 0u; mine = (j == x) ? c : mine; }
        if (sum == G) break;
        __builtin_amdgcn_s_sleep(1);
        if ((++sp & 255u) == 0u) { if (xb_ld(&bar[XB_TMO])) break; if (sp > XB_SPIN_CAP) { atomicAdd(&bar[XB_TMO], 1u); break; } }
    }
    nloc = mine > 0u ? mine : 1u; nx = cnt > 0u ? cnt : 1u;
}

__device__ __forceinline__ void xcd_barrier(const XcdBarrier& b) {
    asm volatile("s_waitcnt vmcnt(0)" ::: "memory");
    __syncthreads();
    if (threadIdx.x == 0) {
        unsigned* bar = b.bar;
        __builtin_amdgcn_s_waitcnt(0);
        unsigned nloc = b.st[0], nx = b.st[1];
        if (nloc == 0u) { xcd_barrier_complete(bar, b.x, nloc, nx); b.st[0] = nloc; b.st[1] = nx; }
        const unsigned old = xb_add(&bar[XB_XSUB(b.x)], 1u);
        const unsigned gen = old / nloc;
        if (old + 1u == (gen + 1u) * nloc) {
            __builtin_amdgcn_fence(__ATOMIC_RELEASE, "agent");
            asm volatile("s_waitcnt vmcnt(0)" ::: "memory");
            const unsigned og = xb_add(&bar[XB_TOP], 1u);
            const unsigned tg = og / nx;
            if (og + 1u == (tg + 1u) * nx) xb_add(&bar[XB_TOPGEN], 1u);
            else XB_SPIN(xb_ld(&bar[XB_TOPGEN]) == tg, bar);
            __builtin_amdgcn_fence(__ATOMIC_ACQUIRE, "agent");
            xb_add(&bar[XB_XGEN(b.x)], 1u);
            asm volatile("s_waitcnt vmcnt(0)" ::: "memory");
        } else {
            XB_SPIN(xb_ld(&bar[XB_XGEN(b.x)]) == gen, bar);
            __builtin_amdgcn_fence(__ATOMIC_ACQUIRE, "agent");
            asm volatile("s_waitcnt vmcnt(0)" ::: "memory");
        }
    }
    __syncthreads();
}

__global__ void __launch_bounds__(512, 2) mega_fwd(Args a) {
    extern __shared__ __attribute__((aligned(16))) unsigned char lds_raw[];
    LAS unsigned char* lds = (LAS unsigned char*)lds_raw;
    cg::grid_group grid = cg::this_grid();
    const int G = gridDim.x; const int bx = blockIdx.x;
    const int vcu = (G % 8 == 0) ? (bx % 8) * (G / 8) + bx / 8 : bx;
    unsigned char* ws = wsp(a);
    const float* MOD = (const float*)(ws + WS_MOD);
    bf16_t* HB = (bf16_t*)(ws + WS_H); bf16_t* UB = (bf16_t*)(ws + WS_U); bf16_t* OB = (bf16_t*)(ws + WS_O); float* XB = (float*)(ws + WS_X);
    volatile LAS unsigned* bst = (volatile LAS unsigned*)(lds + 131072);
    if (threadIdx.x < 2) bst[threadIdx.x] = 0u;
    __syncthreads();
    const XcdBarrier xbar = xcd_barrier_post((unsigned*)(a.ws + WS_BAR), bst);
    int ph = 0;
#define GSYNC() do { if (ph == 0) grid.sync(); else xcd_barrier(xbar); } while (0)
#ifndef DUP_MASK
#define DUP_MASK 0
#endif
#ifndef XSYNC
#define XSYNC 0
#endif
#define RUN(...) do { if (ph >= a.ph_lo && ph < a.ph_hi) { __VA_ARGS__; if (ph + 1 < a.ph_hi) GSYNC(); } ++ph; } while (0)
#define RUND(bit, ...) do { if (ph >= a.ph_lo && ph < a.ph_hi) { int nrep_ = (DUP_MASK & (bit)) ? 2 : 1; asm volatile("" : "+s"(nrep_)); for (int rep_ = 0; rep_ < nrep_; ++rep_) { __VA_ARGS__; if (rep_ + 1 < nrep_ || ph + 1 < a.ph_hi) { GSYNC(); if (XSYNC) { xcd_barrier(xbar); xcd_barrier(xbar); } } } } ++ph; } while (0)

#ifndef PH_MASK
#define PH_MASK 0xff
#endif
    RUND(1, if (PH_MASK & 1) prologue_phase(a, lds, vcu, G));
    for (int l = 0; l < 4; ++l) {
        const float* modl = MOD + (size_t)l * 9 * 9216;
        for (int half = 0; half < 2; ++half) {
            const int sub = half ? 2 : 0, lf = l * 2 + half;
            RUND(2, if (PH_MASK & 2) norm_phase(a, l == 0 && half == 0, inp(a, 12) + (l * 3 + sub) * DM, modl, sub, vcu, G));
            RUND(4, if (PH_MASK & 4) { pg8::Gemm g{HB, (const bf16_t*)(ws + WS_W13T) + (size_t)lf * 5632 * 1024, MROWS, 5632, 1024}; pg8::StaticOrder S; S.init(MROWS, 5632, G, bx);
                  EpiSwiGLU E{UB}; pg8::gemm_phase<EpiSwiGLU, pg8::StaticOrder, true, true>(lds, g, S, E); });
            RUN(if (PH_MASK & 8) { pg8::Gemm g{UB, (const bf16_t*)(ws + WS_W2T) + (size_t)lf * 1024 * DFF, MROWS, 1024, DFF}; pg8::StaticOrder S; S.init(MROWS, 1024, G, bx);
                  EpiResid E{XB, modl + (3 * sub + 2) * 1024, 0.5f}; pg8::gemm_phase<EpiResid, pg8::StaticOrder, true, true>(lds, g, S, E); });
            if (half == 0) {
                const int eo = l >> 1; const bool even = (l & 1) == 0;
                RUND(2, if (PH_MASK & 2) norm_phase(a, false, inp(a, 12) + (l * 3 + 1) * DM, modl, 1, vcu, G));
                RUND(16, if (PH_MASK & 16) { const int nq = even ? NQ_E : NQ_O;
                      pg8::Gemm g{HB, even ? (const bf16_t*)(ws + WS_WINAB) + (size_t)eo * NQ_E * 1024 : (const bf16_t*)(ws + WS_WINC) + (size_t)eo * NQ_O * 1024, MROWS, nq, 1024};
                      pg8::StaticOrder S; S.init(MROWS, nq, G, bx);
                      EpiQKV E{UB, nq, even ? 1 : 0, eo, inp(a, 18) + eo * 64, inp(a, 19) + eo * 64, (const f32x2*)(ws + WS_ROPE), a.out};
                      pg8::gemm_phase<EpiQKV, pg8::StaticOrder, true, true>(lds, g, S, E); });
                RUND(32, { if (even) { if (PH_MASK & 32) attn_even_phase(a, lds, eo, vcu, G); } else if (PH_MASK & 64) attn_odd_phase(a, lds, eo, l == 1 ? 0.35550906759096926f : 0.5560582041556405f, vcu, G); });
                RUN(if (PH_MASK & 8) { pg8::Gemm g{OB, even ? (const bf16_t*)(ws + WS_WOUTAB) + (size_t)eo * 1024 * 1024 : (const bf16_t*)(ws + WS_WOUTC) + (size_t)eo * 1024 * 1024, MROWS, 1024, 1024};
                      pg8::StaticOrder S; S.init(MROWS, 1024, G, bx);
                      EpiResid E{XB, modl + 5 * 1024, 1.0f}; pg8::gemm_phase<EpiResid, pg8::StaticOrder, true, true>(lds, g, S, E); });
            }
        }
    }
    RUN(if (PH_MASK & 2) final_norm_phase(a, vcu, G));
#undef RUN
#undef RUND
}

extern "C" void kernel_launch(void* const* d_in, const int* in_sizes, int n_in, void* d_out, int out_size, void* d_ws, size_t ws_size, hipStream_t stream) {
    static int grid = 0;
    if (grid == 0) {
        int dev = 0, cus = 0, per_cu = 0;
        hipGetDevice(&dev);
        hipDeviceGetAttribute(&cus, hipDeviceAttributeMultiprocessorCount, dev);
        hipFuncSetAttribute((const void*)mega_fwd, hipFuncAttributeMaxDynamicSharedMemorySize, LDS_BYTES);
        hipOccupancyMaxActiveBlocksPerMultiprocessor(&per_cu, (const void*)mega_fwd, 512, LDS_BYTES);
        if (per_cu < 1) per_cu = 1;
        if (per_cu > 1) per_cu = 1;
        grid = cus * per_cu;
        if (n_in != 26 || ws_size < WS_END) { fprintf(stderr, "kernel_launch: unexpected n_in %d / ws %zu\n", n_in, ws_size); }
    }
    hipMemsetAsync((unsigned char*)d_ws + WS_BAR, 0, WS_BAR_BYTES, stream);
    Args a{};
    for (int i = 0; i < 26; ++i) a.in[i] = (const float*)d_in[i];
    a.out = (float*)d_out; a.ws = (unsigned char*)d_ws; a.ph_lo = 0; a.ph_hi = 1000;
    void* args[] = {&a};
    hipError_t e = hipLaunchCooperativeKernel((const void*)mega_fwd, dim3(grid), dim3(512), args, LDS_BYTES, stream);
    if (e != hipSuccess) fprintf(stderr, "cooperative launch failed: %s (grid %d)\n", hipGetErrorString(e), grid);
}
```

```cpp
#define DUP_MASK 0
#define XSYNC 0
#include <hip/hip_runtime.h>
#include <hip/hip_cooperative_groups.h>
#include <cstdio>
#include <cstdint>
namespace cg = cooperative_groups;
__device__ __forceinline__ int opaque_tid() { int t = threadIdx.x; asm volatile("" : "+v"(t)); return t; }
namespace pg8 {
#define PG8_LAS __attribute__((address_space(3)))
typedef unsigned short bf16_t;
typedef short bf16x8 __attribute__((ext_vector_type(8)));
typedef float f32x4 __attribute__((ext_vector_type(4)));
typedef unsigned u32x4 __attribute__((ext_vector_type(4)));
constexpr int BM = 256, BK = 64, HALF = 128, HTB = HALF * BK * 2  , STAGE_BYTES = 8 * HTB, NXCD = 8, WGM = 8;

__host__ __device__ __forceinline__ int lds_byte(int r, int c) { const int st = (r >> 4) * 2 + (c >> 5), rr = r & 15, cc = c & 31, ob = rr * 64 + cc * 2; return st * 1024 + (ob ^ (((ob >> 9) & 1) << 5)); }
__host__ __device__ __forceinline__ void stage_rc(int b, int& R, int& C) { const int st = b / 1024, sb = b % 1024, swz = sb ^ (((sb >> 9) & 1) << 5); R = (st >> 1) * 16 + swz / 64; C = (st & 1) * 32 + (swz % 64) / 2; }
__host__ __device__ __forceinline__ int perm32(int rho) { const int n = rho >> 4, i = rho & 15; return 8 * (i >> 2) + 4 * n + (i & 3); }

struct Unit { int pm, pn; };
struct Gemm { const bf16_t* A; const bf16_t* Bt; int M, N, K; };

struct StaticOrder {
    int nM, nN, nwg, G, c;
    __host__ __device__ void init(int M, int N, int G_, int c_) { nM = M / BM; nN = N / BM; nwg = nM * nN; G = G_; c = c_; }
    __host__ __device__ bool next(int i, Unit& u) const {
        const long L = (long)i * G + c; if (L >= nwg) return false;
        int wgid = (int)L; { const int q = nwg / NXCD, r = nwg % NXCD, xcd = wgid % NXCD, off = wgid / NXCD; wgid = (xcd < r ? xcd * (q + 1) : r * (q + 1) + (xcd - r) * q) + off; }
        const int nig = WGM * nN, gid = wgid / nig, fm = gid * WGM, gsz = (nM - fm) < WGM ? (nM - fm) : WGM;
        u.pm = fm + ((wgid % nig) % gsz); u.pn = (wgid % nig) / gsz; return true;
    }
    __device__ __forceinline__ void a_ready(const Unit&) const {}
    __device__ __forceinline__ void done(const Unit&) const {}
};

template <class Epi, class Sched, bool ALIGN_EPI = false, bool SP2 = false>
__device__ __forceinline__ void gemm_phase(PG8_LAS unsigned char* lds, const Gemm g, const Sched& S, const Epi& E) {
    const int tid = opaque_tid(), wid = __builtin_amdgcn_readfirstlane(tid >> 6), lane = tid & 63, wr = wid >> 2, wc = wid & 3, fr = lane & 15, fq = lane >> 4;
    const int K = g.K, nt = K / BK;
    unsigned voffA[2], voffB[2];
#pragma unroll
    for (int i = 0; i < 2; ++i) { int R, C; stage_rc(tid * 16 + i * 8192, R, C); const int Rb = Epi::PERM ? ((R & ~31) + perm32(R & 31)) : R;
        voffA[i] = (unsigned)(R * K + C) * 2u; voffB[i] = (unsigned)(Rb * K + C) * 2u; }
    const size_t kstep = (size_t)(BK * 2);
    const size_t hstep = (size_t)HALF * K * 2;
    const size_t tstep = 2 * hstep;
    const unsigned ldsw = (unsigned)wid * 1024u;
    const int aoff = lds_byte(wr * 64 + fr, fq * 8), boff = lds_byte(wc * 32 + fr, fq * 8);
#define PG8_SA(b, h) (((b) * 2 + (h)) * HTB)
#define PG8_SB(b, h) ((4 + (b) * 2 + (h)) * HTB)
#define PG8_STAGE(bufoff, gbase, voff) do { _Pragma("unroll") for (int _i = 0; _i < 2; ++_i) \
        __builtin_amdgcn_global_load_lds((const unsigned*)((const char*)(gbase) + (voff)[_i]), (PG8_LAS unsigned*)(lds + (bufoff) + ldsw + _i * 8192), 16, 0, 0); } while (0)
#define PG8_LDA(dst, b, h) do { _Pragma("unroll") for (int m = 0; m < 4; ++m) _Pragma("unroll") for (int k = 0; k < 2; ++k) dst[m][k] = *(const PG8_LAS bf16x8*)(lds + PG8_SA(b, h) + aoff + m * 2048 + k * 1024); } while (0)
#define PG8_LDB(dst, b, h) do { _Pragma("unroll") for (int n = 0; n < 2; ++n) _Pragma("unroll") for (int k = 0; k < 2; ++k) dst[n][k] = *(const PG8_LAS bf16x8*)(lds + PG8_SB(b, h) + boff + n * 2048 + k * 1024); } while (0)
#define PG8_MMA(ai, bj, At, Bt) do { __builtin_amdgcn_s_setprio(1); _Pragma("unroll") for (int m = 0; m < 4; ++m) _Pragma("unroll") for (int n = 0; n < 2; ++n) _Pragma("unroll") for (int k = 0; k < 2; ++k) \
        acc[ai][bj][m][n] = __builtin_amdgcn_mfma_f32_16x16x32_bf16(Bt[n][k], At[m][k], acc[ai][bj][m][n], 0, 0, 0); __builtin_amdgcn_s_setprio(0); } while (0)
#define PG8_WAIT_V(n) asm volatile("s_waitcnt vmcnt(" #n ")" ::: "memory")
#define PG8_WAIT_L(n) asm volatile("s_waitcnt lgkmcnt(" #n ")" ::: "memory")
#define PG8_BAR __builtin_amdgcn_s_barrier()
#define PG8_SCHED __builtin_amdgcn_sched_barrier(0)
    Unit cur, nxt; int ui = 0;
    if (!S.next(0, cur)) return;
    f32x4 acc[2][2][4][2];
#pragma unroll
    for (int a = 0; a < 2; ++a)
#pragma unroll
        for (int b = 0; b < 2; ++b)
#pragma unroll
            for (int m = 0; m < 4; ++m)
#pragma unroll
                for (int n = 0; n < 2; ++n) acc[a][b][m][n] = (f32x4){0.f, 0.f, 0.f, 0.f};
    bf16x8 At[4][2], B0[2][2], B1[2][2];
    const char* cA = (const char*)g.A + (size_t)cur.pm * tstep; const char* cB = (const char*)g.Bt + (size_t)cur.pn * tstep;
    S.a_ready(cur);
    if constexpr (SP2) {
        PG8_STAGE(PG8_SB(0, 0), cB, voffB); PG8_STAGE(PG8_SB(0, 1), cB + hstep, voffB); PG8_STAGE(PG8_SA(0, 0), cA, voffA); PG8_STAGE(PG8_SA(0, 1), cA + hstep, voffA);
        if (wr == 1) PG8_BAR;
        PG8_WAIT_V(2); PG8_BAR;
        PG8_STAGE(PG8_SB(1, 0), cB + kstep, voffB); PG8_STAGE(PG8_SA(1, 0), cA + kstep, voffA); PG8_STAGE(PG8_SB(1, 1), cB + hstep + kstep, voffB);
        PG8_WAIT_V(6); PG8_BAR;
    } else {
        PG8_STAGE(PG8_SB(0, 0), cB, voffB); PG8_STAGE(PG8_SA(0, 0), cA, voffA); PG8_STAGE(PG8_SB(0, 1), cB + hstep, voffB); PG8_STAGE(PG8_SA(0, 1), cA + hstep, voffA);
        if (wr == 1) PG8_BAR;
        PG8_WAIT_V(4); PG8_BAR;
        PG8_STAGE(PG8_SB(1, 0), cB + kstep, voffB); PG8_STAGE(PG8_SA(1, 0), cA + kstep, voffA); PG8_STAGE(PG8_SB(1, 1), cB + hstep + kstep, voffB);
        PG8_WAIT_V(6); PG8_BAR;
    }
    for (;;) {
        const bool has_next = S.next(ui + 1, nxt);
        const char* nA = has_next ? (const char*)g.A + (size_t)nxt.pm * tstep : cA; const char* nB = has_next ? (const char*)g.Bt + (size_t)nxt.pn * tstep : cB;
        for (int t = 0; t < nt; t += 2) {
            const bool last = (t == nt - 2);
            const char* a1 = cA + (size_t)(t + 1) * kstep;
            const char* a2 = last ? nA : cA + (size_t)(t + 2) * kstep; const char* b2 = last ? nB : cB + (size_t)(t + 2) * kstep;
            const char* a3 = a2 + kstep; const char* b3 = b2 + kstep;
            if (last && has_next) S.a_ready(nxt);
            if constexpr (SP2) {
            PG8_LDB(B0, 0, 0); PG8_LDB(B1, 0, 1); PG8_SCHED; PG8_LDA(At, 0, 0); PG8_STAGE(PG8_SA(1, 1), a1 + hstep, voffA);
            PG8_WAIT_V(8); PG8_WAIT_L(0); PG8_BAR; PG8_MMA(0, 0, At, B0); PG8_MMA(0, 1, At, B1); PG8_BAR; PG8_SCHED;
            PG8_LDA(At, 0, 1); PG8_STAGE(PG8_SB(0, 0), b2, voffB); PG8_STAGE(PG8_SB(0, 1), b2 + hstep, voffB); PG8_STAGE(PG8_SA(0, 0), a2, voffA);
            PG8_WAIT_V(8); PG8_WAIT_L(0); PG8_BAR; PG8_MMA(1, 0, At, B0); PG8_MMA(1, 1, At, B1); PG8_BAR; PG8_SCHED;
            PG8_LDB(B0, 1, 0); PG8_LDB(B1, 1, 1); PG8_SCHED; PG8_LDA(At, 1, 0); PG8_STAGE(PG8_SA(0, 1), a2 + hstep, voffA);
            PG8_WAIT_V(8); PG8_WAIT_L(0); PG8_BAR; PG8_MMA(0, 0, At, B0); PG8_MMA(0, 1, At, B1); PG8_BAR; PG8_SCHED;
            PG8_LDA(At, 1, 1); PG8_STAGE(PG8_SB(1, 0), b3, voffB); PG8_STAGE(PG8_SB(1, 1), b3 + hstep, voffB); PG8_STAGE(PG8_SA(1, 0), a3, voffA);
            PG8_WAIT_V(8); PG8_WAIT_L(0); PG8_BAR; PG8_MMA(1, 0, At, B0); PG8_MMA(1, 1, At, B1); PG8_BAR; PG8_SCHED;
            } else {
            PG8_LDB(B0, 0, 0); PG8_SCHED; PG8_LDA(At, 0, 0); PG8_STAGE(PG8_SA(1, 1), a1 + hstep, voffA);
            PG8_WAIT_L(8); PG8_BAR; PG8_WAIT_L(0); PG8_MMA(0, 0, At, B0); PG8_BAR; PG8_SCHED;
            PG8_LDB(B1, 0, 1); PG8_STAGE(PG8_SB(0, 0), b2, voffB);
            PG8_BAR; PG8_WAIT_L(0); PG8_MMA(0, 1, At, B1); PG8_BAR;
            PG8_LDA(At, 0, 1); PG8_STAGE(PG8_SA(0, 0), a2, voffA);
            PG8_BAR; PG8_WAIT_L(0); PG8_MMA(1, 0, At, B0); PG8_BAR; PG8_SCHED;
            PG8_STAGE(PG8_SB(0, 1), b2 + hstep, voffB);
            PG8_WAIT_V(6); PG8_BAR; PG8_MMA(1, 1, At, B1); PG8_BAR;
            PG8_LDB(B0, 1, 0); PG8_SCHED; PG8_LDA(At, 1, 0); PG8_STAGE(PG8_SA(0, 1), a2 + hstep, voffA);
            PG8_WAIT_L(8); PG8_BAR; PG8_WAIT_L(0); PG8_MMA(0, 0, At, B0); PG8_BAR; PG8_SCHED;
            PG8_LDB(B1, 1, 1); PG8_STAGE(PG8_SB(1, 0), b3, voffB);
            PG8_BAR; PG8_WAIT_L(0); PG8_MMA(0, 1, At, B1); PG8_BAR;
            PG8_LDA(At, 1, 1); PG8_STAGE(PG8_SA(1, 0), a3, voffA);
            PG8_BAR; PG8_WAIT_L(0); PG8_MMA(1, 0, At, B0); PG8_BAR; PG8_SCHED;
            PG8_STAGE(PG8_SB(1, 1), b3 + hstep, voffB);
            PG8_WAIT_V(6); PG8_BAR; PG8_MMA(1, 1, At, B1); PG8_BAR;
            }
        }
        if constexpr (ALIGN_EPI) { if (wr == 0) PG8_BAR; }
        if constexpr (!Epi::AFTER_DRAIN) { E(acc, cur, wr, wc, fr, fq); S.done(cur); }
        if (!has_next) break;
#pragma unroll
        for (int a = 0; a < 2; ++a)
#pragma unroll
            for (int b = 0; b < 2; ++b)
#pragma unroll
                for (int m = 0; m < 4; ++m)
#pragma unroll
                    for (int n = 0; n < 2; ++n) acc[a][b][m][n] = (f32x4){0.f, 0.f, 0.f, 0.f};
        cur = nxt; cA = nA; cB = nB; ++ui;
        if constexpr (ALIGN_EPI) { if (wr == 1) PG8_BAR; }
    }
    PG8_WAIT_V(0);
    if constexpr (!ALIGN_EPI) { if (wr == 0) PG8_BAR; }
    PG8_BAR;
    if constexpr (Epi::AFTER_DRAIN) { E.fused(acc, cur, wr, wc, fr, fq, lds, wid, lane); S.done(cur); }
#undef PG8_SA
#undef PG8_SB
#undef PG8_STAGE
#undef PG8_LDA
#undef PG8_LDB
#undef PG8_MMA
#undef PG8_WAIT_V
#undef PG8_WAIT_L
#undef PG8_BAR
#undef PG8_SCHED
}
}

#define LAS __attribute__((address_space(3)))
typedef unsigned short bf16_t;
typedef short bf16x8 __attribute__((ext_vector_type(8)));
typedef short s16x4 __attribute__((ext_vector_type(4)));
typedef float f32x4 __attribute__((ext_vector_type(4)));
typedef float f32x2 __attribute__((ext_vector_type(2)));
typedef float f32x16 __attribute__((ext_vector_type(16)));
typedef unsigned u32x4 __attribute__((ext_vector_type(4)));
typedef unsigned u32x2 __attribute__((ext_vector_type(2)));
typedef __bf16 bf16x2_t __attribute__((ext_vector_type(2)));

constexpr int DM = 1024, NLAT = 16384, NCTX = 4096, MROWS = 20480, DFF = 2816;
constexpr int NQ_E = 2304, NQ_O = 3072;
constexpr float EPS = 1e-6f;
constexpr float LOG2E = 1.4426950408889634f;
constexpr float SCL2 = 0.125f * LOG2E;

constexpr size_t MiB = 1u << 20;
constexpr size_t WS_BAR = 65536, WS_BAR_BYTES = 16384;
constexpr size_t WS_ROPE = 4096;
constexpr size_t WS_MOD = 1 * MiB;
constexpr size_t WS_W13T = 4 * MiB;
constexpr size_t WS_W2T = 92 * MiB;
constexpr size_t WS_WINAB = 136 * MiB;
constexpr size_t WS_WOUTAB = 145 * MiB;
constexpr size_t WS_WINC = 149 * MiB;
constexpr size_t WS_WOUTC = 161 * MiB;
constexpr size_t WS_CAK = 165 * MiB, WS_CAV = 167 * MiB, WS_CBK = 169 * MiB, WS_CBV = 177 * MiB, WS_CCK = 185 * MiB, WS_CCV = 201 * MiB;
constexpr size_t WS_X = 217 * MiB;
constexpr size_t WS_H = 297 * MiB;
constexpr size_t WS_O = 337 * MiB;
constexpr size_t WS_U = 377 * MiB;
constexpr size_t WS_END = 497 * MiB;

constexpr size_t OUT_YP = 0, OUT_YS = 4194304, OUT_AK = 20971520, OUT_AV = 22020096, OUT_BK = 23068672, OUT_BV = 27262976, OUT_CK = 31457280, OUT_CV = 39845888;

constexpr int LDS_BYTES = 131072 + 1024;

__device__ __forceinline__ unsigned pk2(float lo, float hi) { f32x2 v = {lo, hi}; bf16x2_t b = __builtin_convertvector(v, bf16x2_t); return __builtin_bit_cast(unsigned, b); }
__device__ __forceinline__ float wave_sum(float v) {
#pragma unroll
    for (int o = 1; o < 64; o <<= 1) v += __shfl_xor(v, o);
    return v;
}
__device__ __forceinline__ float fast_exp2(float x) { return __builtin_amdgcn_exp2f(x); }
__device__ __forceinline__ float fast_rcp(float x) { return __builtin_amdgcn_rcpf(x); }

struct Args { const float* in[26]; float* out; unsigned char* ws; int ph_lo, ph_hi; };
#define GAS __attribute__((address_space(1)))
__device__ __forceinline__ const float* inp(const Args& a, int i) { asm volatile("" : "+s"(i)); GAS const float* g = (GAS const float*)a.in[i]; return (const float*)g; }
__device__ __forceinline__ unsigned char* wsp(const Args& a) { GAS unsigned char* g = (GAS unsigned char*)a.ws; asm volatile("" : "+s"(g)); return (unsigned char*)g; }
__device__ __forceinline__ float* outp(const Args& a) { GAS float* g = (GAS float*)a.out; return (float*)g; }

struct EpiSwiGLU {
    static constexpr bool PERM = true, AFTER_DRAIN = false;
    bf16_t* U;
    __device__ __forceinline__ void operator()(const f32x4 (&acc)[2][2][4][2], const pg8::Unit& u, int wr, int wc, int fr, int fq) const {
        const int row0 = u.pm * 256 + wr * 64 + fr, col0 = u.pn * 128 + wc * 32 + 8 * fq;
#pragma unroll
        for (int ai = 0; ai < 2; ++ai)
#pragma unroll
            for (int m = 0; m < 4; ++m) {
                bf16_t* rowp = U + (size_t)(row0 + ai * 128 + m * 16) * DFF + col0;
                float o[8];
#pragma unroll
                for (int n = 0; n < 2; ++n)
#pragma unroll
                    for (int i = 0; i < 4; ++i) { const float a = acc[ai][0][m][n][i], b = acc[ai][1][m][n][i];
                        o[n * 4 + i] = a * fast_rcp(1.f + fast_exp2(-a * LOG2E)) * b; }
                u32x4 w; w.x = pk2(o[0], o[1]); w.y = pk2(o[2], o[3]); w.z = pk2(o[4], o[5]); w.w = pk2(o[6], o[7]);
                *(u32x4*)rowp = w;
            }
    }
};
struct EpiResid {
    static constexpr bool PERM = false, AFTER_DRAIN = false;
    float* x; const float* gate; float coef;
    __device__ __forceinline__ void operator()(const f32x4 (&acc)[2][2][4][2], const pg8::Unit& u, int wr, int wc, int fr, int fq) const {
        const int mi = u.pm < 64 ? (u.pm >> 3) : 8;
        const float* g = gate + (size_t)mi * 9216;
        const int col0 = u.pn * 256 + wc * 32 + 4 * fq;
        f32x4 g4[2][2];
#pragma unroll
        for (int bj = 0; bj < 2; ++bj)
#pragma unroll
            for (int n = 0; n < 2; ++n) g4[bj][n] = *(const f32x4*)(g + col0 + bj * 128 + n * 16) * coef;
#pragma unroll
        for (int ai = 0; ai < 2; ++ai)
#pragma unroll
            for (int m = 0; m < 4; ++m) {
                float* p = x + (size_t)(u.pm * 256 + ai * 128 + wr * 64 + m * 16 + fr) * DM + col0;
#pragma unroll
                for (int bj = 0; bj < 2; ++bj)
#pragma unroll
                    for (int n = 0; n < 2; ++n) { float* q = p + bj * 128 + n * 16; *(f32x4*)q = *(const f32x4*)q + g4[bj][n] * acc[ai][bj][m][n]; }
                asm volatile("" ::: "memory");
            }
    }
};
struct EpiQKV {
    static constexpr bool PERM = false, AFTER_DRAIN = false;
    bf16_t* Q; int ldq; int even; int e; const float* qn; const float* kn; const f32x2* rope; float* out;
    __device__ __forceinline__ void operator()(const f32x4 (&acc)[2][2][4][2], const pg8::Unit& u, int wr, int wc, int fr, int fq) const {
        const int hu = 4 * u.pn + wc;
        const bool lat = u.pm < 64;
        bool do_rope; const float* nw = nullptr; float* ob = nullptr; int ow = 0;
        if (even) {
            do_rope = hu < 10;
            if (hu < 8) nw = qn; else if (hu < 10) { nw = kn; ob = out + OUT_AK + 64 * (hu - 8); ow = 128; }
            else if (hu < 12) { ob = out + OUT_AV + 64 * (hu - 10); ow = 128; }
            else if (hu < 20) {}
            else if (hu < 28) { ob = out + OUT_BK + 64 * (hu - 20); ow = 512; }
            else { ob = out + OUT_BV + 64 * (hu - 28); ow = 512; }
        } else {
            do_rope = hu < 32;
            if (hu < 16) {} else if (hu < 32) { ob = out + OUT_CK + 64 * (hu - 16); ow = 1024; }
            else { ob = out + OUT_CV + 64 * (hu - 32); ow = 1024; }
        }
        f32x4 w4[2][2];
        if (nw) {
#pragma unroll
            for (int bj = 0; bj < 2; ++bj)
#pragma unroll
                for (int n = 0; n < 2; ++n) w4[bj][n] = *(const f32x4*)(nw + 32 * bj + 16 * n + 4 * fq);
        }
#pragma unroll
        for (int ai = 0; ai < 2; ++ai)
#pragma unroll
            for (int m = 0; m < 4; ++m) {
                const int row = u.pm * 256 + ai * 128 + wr * 64 + m * 16 + fr;
                f32x4 v[2][2];
#pragma unroll
                for (int bj = 0; bj < 2; ++bj)
#pragma unroll
                    for (int n = 0; n < 2; ++n) v[bj][n] = acc[ai][bj][m][n];
                if (nw) {
                    float ss = 0.f;
#pragma unroll
                    for (int bj = 0; bj < 2; ++bj)
#pragma unroll
                        for (int n = 0; n < 2; ++n) ss += (v[bj][n][0] * v[bj][n][0] + v[bj][n][1] * v[bj][n][1]) + (v[bj][n][2] * v[bj][n][2] + v[bj][n][3] * v[bj][n][3]);
                    ss += __shfl_xor(ss, 16); ss += __shfl_xor(ss, 32);
                    const float rstd = rsqrtf(ss * (1.f / 64.f) + EPS);
#pragma unroll
                    for (int bj = 0; bj < 2; ++bj)
#pragma unroll
                        for (int n = 0; n < 2; ++n) v[bj][n] = v[bj][n] * rstd * w4[bj][n];
                }
                if (do_rope && lat) {
                    const int t = row & 2047;
#pragma unroll
                    for (int bj = 0; bj < 2; ++bj) {
                        const int pos = bj ? (t & 63) : (t >> 6);
                        const f32x2* rp = rope + pos * 16 + 4 * fq;
#pragma unroll
                        for (int i = 0; i < 4; ++i) { const f32x2 cs = rp[i]; const float x1 = v[bj][0][i], x2 = v[bj][1][i];
                            v[bj][0][i] = x1 * cs.x - x2 * cs.y; v[bj][1][i] = x2 * cs.x + x1 * cs.y; }
                    }
                }
                bf16_t* qp = Q + (size_t)row * ldq + 64 * hu + 4 * fq;
#pragma unroll
                for (int bj = 0; bj < 2; ++bj)
#pragma unroll
                    for (int n = 0; n < 2; ++n) { u32x2 w; w.x = pk2(v[bj][n][0], v[bj][n][1]); w.y = pk2(v[bj][n][2], v[bj][n][3]); *(u32x2*)(qp + 32 * bj + 16 * n) = w; }
                if (ob && !lat) {
                    const int cr = row - NLAT, b = cr >> 8, s = cr & 255;
                    float* op = ob + (size_t)((b * 2 + e) * 256 + s) * ow + 4 * fq;
#pragma unroll
                    for (int bj = 0; bj < 2; ++bj)
#pragma unroll
                        for (int n = 0; n < 2; ++n) *(f32x4*)(op + 32 * bj + 16 * n) = v[bj][n];
                }
            }
    }
};

__device__ __forceinline__ void transpose_item(const float* W, int K, int N, bf16_t* WT, int k0, int n0, int drow, LAS float* scr, int lane) {
#pragma unroll 8
    for (int i = 0; i < 32; ++i) { const int kk = 2 * i + (lane >> 5); scr[kk * 33 + (lane & 31)] = W[(size_t)(k0 + kk) * N + n0 + (lane & 31)]; }
    asm volatile("s_waitcnt lgkmcnt(0)" ::: "memory");
    const int c = lane & 7;
#pragma unroll
    for (int j = 0; j < 4; ++j) { const int n = (lane >> 3) + 8 * j; const LAS float* s = scr + (8 * c) * 33 + n;
        u32x4 o; o.x = pk2(s[0 * 33], s[1 * 33]); o.y = pk2(s[2 * 33], s[3 * 33]); o.z = pk2(s[4 * 33], s[5 * 33]); o.w = pk2(s[6 * 33], s[7 * 33]);
        *(u32x4*)(WT + (size_t)(drow + n) * K + k0 + 8 * c) = o; }
    asm volatile("s_waitcnt lgkmcnt(0)" ::: "memory");
}
__device__ __forceinline__ int qkv_drow(int n0) { const int hu = n0 >> 6, bj = (n0 >> 5) & 1; return 256 * (hu >> 2) + 128 * bj + 32 * (hu & 3); }

__device__ __forceinline__ void cvt_seg(const float* src, bf16_t* dst, int n4, int gt, int NT) {
    for (int i = gt; i < n4; i += NT) { const f32x4 v = ((const f32x4*)src)[i]; u32x2 w; w.x = pk2(v[0], v[1]); w.y = pk2(v[2], v[3]); ((u32x2*)dst)[i] = w; }
}

__device__ __forceinline__ void prologue_phase(const Args& a, LAS unsigned char* lds, int vcu, int G) {
    const int tid = opaque_tid(), lane = tid & 63, wave = __builtin_amdgcn_readfirstlane(tid >> 6);
    unsigned char* ws = wsp(a);
    {
        LAS float* sc = (LAS float*)lds;
        LAS f32x4* red = (LAS f32x4*)(lds + 36864);
        const int first = G - 1 - (int)blockIdx.x;
        if (first < 144) {
            for (int i = tid; i < 9 * 1024; i += 512) { const int r = i >> 10, k = i & 1023; const float cv = r < 8 ? inp(a, 8)[r * 1024 + k] : inp(a, 9)[k]; sc[i] = cv / (1.f + __expf(-cv)); }
            __syncthreads();
            for (int item = first; item < 144; item += G) {
                const int l = item / 36, cb = item % 36, col = cb * 256 + lane * 4;
                const float* wp = inp(a, 10) + ((size_t)l * 1024 + wave * 128) * 9216 + col;
                f32x4 acc[9];
#pragma unroll
                for (int r = 0; r < 9; ++r) acc[r] = (f32x4){0.f, 0.f, 0.f, 0.f};
#pragma unroll 4
                for (int k = 0; k < 128; ++k) {
                    const f32x4 wv = *(const f32x4*)(wp + (size_t)k * 9216);
#pragma unroll
                    for (int r = 0; r < 9; ++r) acc[r] += wv * sc[r * 1024 + wave * 128 + k];
                }
#pragma unroll
                for (int r = 0; r < 9; ++r) red[(wave * 9 + r) * 64 + lane] = acc[r];
                __syncthreads();
                for (int o = tid; o < 9 * 64; o += 512) {
                    const int r = o >> 6, ln = o & 63;
                    f32x4 s = *(const f32x4*)(inp(a, 11) + l * 9216 + cb * 256 + ln * 4);
#pragma unroll
                    for (int w = 0; w < 8; ++w) s += red[(w * 9 + r) * 64 + ln];
                    *(f32x4*)((float*)(ws + WS_MOD) + ((size_t)l * 9 + r) * 9216 + cb * 256 + ln * 4) = s;
                }
                __syncthreads();
            }
        }
        __syncthreads();
    }
    {
        LAS float* scr = (LAS float*)(lds + wave * 8704);
        const int gw = vcu * 8 + wave, NGW = G * 8;
        for (int it = gw; it < 41216; it += NGW) {
            if (it < 33792) {
                const int lf = it / 4224, r = it % 4224, which = r / 1408, q = r % 1408;
                if (which < 2) { const int kb = q / 88, nb = q % 88, n0 = 32 * nb; const int drow = 256 * (n0 >> 7) + (n0 & 127) + 128 * which;
                    transpose_item(inp(a, which == 0 ? 13 : 14) + (size_t)lf * 1024 * DFF, 1024, DFF, (bf16_t*)(ws + WS_W13T) + (size_t)lf * 5632 * 1024, 64 * kb, n0, drow, scr, lane); }
                else { const int kb = q / 32, nb = q % 32;
                    transpose_item(inp(a, 15) + (size_t)lf * DFF * 1024, DFF, 1024, (bf16_t*)(ws + WS_W2T) + (size_t)lf * 1024 * DFF, 64 * kb, 32 * nb, 32 * nb, scr, lane); }
            } else {
                int r = it - 33792;
                if (r < 2304) { const int e = r / 1152, q = r % 1152, kb = q / 72, nb = q % 72;
                    transpose_item(inp(a, 16) + (size_t)e * 1024 * NQ_E, 1024, NQ_E, (bf16_t*)(ws + WS_WINAB) + (size_t)e * NQ_E * 1024, 64 * kb, 32 * nb, qkv_drow(32 * nb), scr, lane); continue; }
                r -= 2304;
                if (r < 3072) { const int e = r / 1536, q = r % 1536, kb = q / 96, nb = q % 96;
                    transpose_item(inp(a, 21) + (size_t)e * 1024 * NQ_O, 1024, NQ_O, (bf16_t*)(ws + WS_WINC) + (size_t)e * NQ_O * 1024, 64 * kb, 32 * nb, qkv_drow(32 * nb), scr, lane); continue; }
                r -= 3072;
                if (r < 1024) { const int e = r / 512, q = r % 512, kb = q / 32, nb = q % 32;
                    transpose_item(inp(a, 17) + (size_t)e * 1024 * 1024, 1024, 1024, (bf16_t*)(ws + WS_WOUTAB) + (size_t)e * 1024 * 1024, 64 * kb, 32 * nb, 32 * nb, scr, lane); continue; }
                r -= 1024;
                { const int e = r / 512, q = r % 512, kb = q / 32, nb = q % 32;
                    transpose_item(inp(a, 22) + (size_t)e * 1024 * 1024, 1024, 1024, (bf16_t*)(ws + WS_WOUTC) + (size_t)e * 1024 * 1024, 64 * kb, 32 * nb, 32 * nb, scr, lane); }
            }
        }
    }
    {
        const int gt = blockIdx.x * 512 + tid, NT = G * 512;
        cvt_seg(inp(a, 2), (bf16_t*)(ws + WS_CAK), 1048576 / 4, gt, NT);
        cvt_seg(inp(a, 3), (bf16_t*)(ws + WS_CAV), 1048576 / 4, gt, NT);
        cvt_seg(inp(a, 4), (bf16_t*)(ws + WS_CBK), 4194304 / 4, gt, NT);
        cvt_seg(inp(a, 5), (bf16_t*)(ws + WS_CBV), 4194304 / 4, gt, NT);
        cvt_seg(inp(a, 6), (bf16_t*)(ws + WS_CCK), 8388608 / 4, gt, NT);
        cvt_seg(inp(a, 7), (bf16_t*)(ws + WS_CCV), 8388608 / 4, gt, NT);
        if (gt < 1024) { const int pos = gt >> 4, f = gt & 15;
            const float inv = exp2f(-(float)f * (13.287712379549449f / 16.f));
            const float rev = (float)pos * inv * 0.15915494309189535f;
            f32x2 cs; cs.x = __builtin_amdgcn_cosf(rev); cs.y = __builtin_amdgcn_sinf(rev);
            ((f32x2*)(ws + WS_ROPE))[gt] = cs; }
    }
}

__device__ __forceinline__ void norm_phase(const Args& a, bool first, const float* nw, const float* modl, int sub, int vcu, int G) {
    const int tid = opaque_tid(), lane = tid & 63, wave = tid >> 6;
    float* xb = (float*)(wsp(a) + WS_X); bf16_t* hb = (bf16_t*)(wsp(a) + WS_H);
    for (int row = vcu * 8 + wave; row < MROWS; row += G * 8) {
        const float* xr = first ? (row < NLAT ? inp(a, 1) + (size_t)row * DM : inp(a, 0) + (size_t)(row - NLAT) * DM) : xb + (size_t)row * DM;
        f32x4 v[4]; float ss = 0.f;
#pragma unroll
        for (int j = 0; j < 4; ++j) { v[j] = ((const f32x4*)xr)[lane + 64 * j]; ss += (v[j][0] * v[j][0] + v[j][1] * v[j][1]) + (v[j][2] * v[j][2] + v[j][3] * v[j][3]); }
        const float rstd = rsqrtf(wave_sum(ss) * (1.f / DM) + EPS);
        if (first) {
#pragma unroll
            for (int j = 0; j < 4; ++j) ((f32x4*)(xb + (size_t)row * DM))[lane + 64 * j] = v[j];
        }
        const int mi = row < NLAT ? (row >> 11) : 8;
        const float* sh = modl + (size_t)mi * 9216 + (3 * sub) * 1024; const float* sc = sh + 1024;
#pragma unroll
        for (int j = 0; j < 4; ++j) {
            const int c4 = lane + 64 * j;
            const f32x4 w = ((const f32x4*)nw)[c4], s4 = ((const f32x4*)sc)[c4], m4 = ((const f32x4*)sh)[c4];
            const f32x4 o = v[j] * rstd * w * (1.f + s4) + m4;
            u32x2 pw; pw.x = pk2(o[0], o[1]); pw.y = pk2(o[2], o[3]);
            ((u32x2*)(hb + (size_t)row * DM))[c4] = pw;
        }
    }
}
__device__ __forceinline__ void final_norm_phase(const Args& a, int vcu, int G) {
    const int tid = opaque_tid(), lane = tid & 63, wave = tid >> 6;
    const float* xb = (const float*)(wsp(a) + WS_X); const float* nw = inp(a, 25);
    for (int row = vcu * 8 + wave; row < MROWS; row += G * 8) {
        const float* xr = xb + (size_t)row * DM;
        float* orow = row < NLAT ? outp(a) + OUT_YS + (size_t)row * DM : outp(a) + OUT_YP + (size_t)(row - NLAT) * DM;
        f32x4 v[4]; float ss = 0.f;
#pragma unroll
        for (int j = 0; j < 4; ++j) { v[j] = ((const f32x4*)xr)[lane + 64 * j]; ss += (v[j][0] * v[j][0] + v[j][1] * v[j][1]) + (v[j][2] * v[j][2] + v[j][3] * v[j][3]); }
        const float rstd = rsqrtf(wave_sum(ss) * (1.f / DM) + EPS);
#pragma unroll
        for (int j = 0; j < 4; ++j) ((f32x4*)orow)[lane + 64 * j] = v[j] * rstd * ((const f32x4*)nw)[lane + 64 * j];
    }
}

struct KVSrc { const bf16_t* k; const bf16_t* v; int ks, vs; };
constexpr int AT_K = 0, AT_V = 24576, AT_BIAS = 57344;
__device__ __forceinline__ int crow(int r, int hi) { return (r & 3) + 8 * (r >> 2) + 4 * hi; }
typedef short v4i16_t __attribute__((ext_vector_type(4)));
__device__ __forceinline__ s16x4 vtr(const LAS unsigned char* p) { return __builtin_bit_cast(s16x4, __builtin_amdgcn_ds_read_tr16_b64_v4i16((LAS v4i16_t*)p)); }

__device__ __forceinline__ float xhalf_max(float m) {
    auto rr = __builtin_amdgcn_permlane32_swap(__float_as_uint(m), __float_as_uint(m), false, false);
    return fmaxf(__uint_as_float(rr[0]), __uint_as_float(rr[1]));
}
__device__ __forceinline__ void qk_tile(const LAS unsigned char* Kb, const int (&kl)[4], const bf16x8 (&qr)[4], f32x16& p0, f32x16& p1) {
    bf16x8 kf[8];
#pragma unroll
    for (int d0 = 0; d0 < 4; ++d0) { kf[2 * d0] = *(const LAS bf16x8*)(Kb + kl[d0]); kf[2 * d0 + 1] = *(const LAS bf16x8*)(Kb + kl[d0] + 512); }
    __builtin_amdgcn_sched_barrier(0);
    p0 = f32x16{}; p1 = f32x16{};
#pragma unroll
    for (int d0 = 0; d0 < 4; ++d0) {
        p0 = __builtin_amdgcn_mfma_f32_32x32x16_bf16(kf[2 * d0], qr[d0], p0, 0, 0, 0);
        p1 = __builtin_amdgcn_mfma_f32_32x32x16_bf16(kf[2 * d0 + 1], qr[d0], p1, 0, 0, 0);
    }
}
template <int DV, bool NB>
__device__ __forceinline__ void sm_pv(f32x16& p0, f32x16& p1, const LAS unsigned char* Vb, f32x16 (&OT)[DV / 32], float& m_run, float& l_run,
                                      const bool masked, const LAS float* brow, const int c, const int cs, const int hi) {
    float mn;
    if (NB && masked) {
        int co = c - 4 * hi, cso = cs - 4 * hi; asm volatile("" : "+v"(co), "+v"(cso));
#pragma unroll
        for (int r = 0; r < 16; ++r) {
            const int kc0 = (r & 3) + 8 * (r >> 2), kc1 = kc0 + 32;
            const int i0 = min(max(kc0 - co + 15, 0), 30), i1 = min(max(kc1 - co + 15, 0), 30);
            const float b0 = brow[i0], b1 = brow[i1];
            p0[r] = (kc0 >= cso && kc0 < cso + 16) ? p0[r] * SCL2 + b0 : -1e30f;
            p1[r] = (kc1 >= cso && kc1 < cso + 16) ? p1[r] * SCL2 + b1 : -1e30f;
        }
        float rm = fmaxf(p0[0], p1[0]);
#pragma unroll
        for (int r = 1; r < 16; ++r) rm = fmaxf(fmaxf(rm, p0[r]), p1[r]);
        rm = xhalf_max(rm);
        mn = fmaxf(m_run, rm);
#pragma unroll
        for (int r = 0; r < 16; ++r) { p0[r] = fast_exp2(p0[r] - mn); p1[r] = fast_exp2(p1[r] - mn); }
    } else {
        float rm = fmaxf(p0[0], p1[0]);
#pragma unroll
        for (int r = 1; r < 16; ++r) rm = fmaxf(fmaxf(rm, p0[r]), p1[r]);
        rm = xhalf_max(rm);
        mn = fmaxf(m_run, rm * SCL2);
#pragma unroll
        for (int r = 0; r < 16; ++r) { p0[r] = fast_exp2(p0[r] * SCL2 - mn); p1[r] = fast_exp2(p1[r] * SCL2 - mn); }
    }
    float ls0 = 0.f, ls1 = 0.f;
#pragma unroll
    for (int r = 0; r < 16; ++r) { ls0 += p0[r]; ls1 += p1[r]; }
    const float alpha = fast_exp2(m_run - mn);
    m_run = mn;
    l_run = l_run * alpha + (ls0 + ls1);
    if (__any(alpha != 1.f)) {
#pragma unroll
        for (int d = 0; d < DV / 32; ++d) OT[d] *= alpha;
    }
    bf16x8 pa[4];
#pragma unroll
    for (int k = 0; k < 4; ++k) {
        u32x4 w;
        if (k < 2) { w.x = pk2(p0[8 * k + 0], p0[8 * k + 1]); w.y = pk2(p0[8 * k + 2], p0[8 * k + 3]); w.z = pk2(p0[8 * k + 4], p0[8 * k + 5]); w.w = pk2(p0[8 * k + 6], p0[8 * k + 7]); }
        else { const int kk = k - 2; w.x = pk2(p1[8 * kk + 0], p1[8 * kk + 1]); w.y = pk2(p1[8 * kk + 2], p1[8 * kk + 3]); w.z = pk2(p1[8 * kk + 4], p1[8 * kk + 5]); w.w = pk2(p1[8 * kk + 6], p1[8 * kk + 7]); }
        pa[k] = __builtin_bit_cast(bf16x8, w);
    }
#pragma unroll
    for (int dd = 0; dd < DV / 64; ++dd) {
        s16x4 lo[2][4], hh[2][4];
#pragma unroll
        for (int d = 0; d < 2; ++d)
#pragma unroll
            for (int k = 0; k < 4; ++k) { lo[d][k] = vtr(Vb + (2 * dd + d) * 4096 + k * 1024); hh[d][k] = vtr(Vb + (2 * dd + d) * 4096 + k * 1024 + 512); }
        __builtin_amdgcn_sched_barrier(0);
#pragma unroll
        for (int k = 0; k < 4; ++k)
#pragma unroll
            for (int d = 0; d < 2; ++d) {
                const bf16x8 vf = {lo[d][k][0], lo[d][k][1], lo[d][k][2], lo[d][k][3], hh[d][k][0], hh[d][k][1], hh[d][k][2], hh[d][k][3]};
                OT[2 * dd + d] = __builtin_amdgcn_mfma_f32_32x32x16_bf16(vf, pa[k], OT[2 * dd + d], 0, 0, 0);
            }
    }
}

#define AT_BAR() do { asm volatile("s_waitcnt lgkmcnt(0)" ::: "memory"); __builtin_amdgcn_s_barrier(); asm volatile("" ::: "memory"); } while (0)
template <int DV, bool NB>
__device__ __forceinline__ void attn_pass(LAS unsigned char* lds, const bf16x8 (&qr)[4], const KVSrc s0, const int nt0, const KVSrc s1, const int nt1,
                                          f32x16 (&OT)[DV / 32], float& m_run, float& l_run,
                                          const int R, const int c, const int kr0) {
    constexpr int NV = DV / 64;
    const int tid = opaque_tid(), lane = tid & 63, r32 = lane & 31, hi = lane >> 5;
    const int NT = nt0 + nt1;
    const int wtype = __builtin_amdgcn_readfirstlane(tid >> 8);
    const int kkv = tid >> 3, kch = tid & 7;
    u32x4 kA, kB, vA[NV], vB[NV];
#define AT_LOADK(kreg, t_) do { const int t__ = (t_); const bool f__ = t__ < nt0; const int tt__ = f__ ? t__ : t__ - nt0; \
        const bf16_t* kp__ = f__ ? s0.k : s1.k; const int ks__ = f__ ? s0.ks : s1.ks; \
        kreg = *(const u32x4*)(kp__ + (size_t)(tt__ * 64 + kkv) * ks__ + kch * 8); } while (0)
#define AT_LOADV(vreg, t_) do { const int t__ = (t_); const bool f__ = t__ < nt0; const int tt__ = f__ ? t__ : t__ - nt0; \
        const bf16_t* vp__ = f__ ? s0.v : s1.v; const int vs__ = f__ ? s0.vs : s1.vs; \
        _Pragma("unroll") for (int i__ = 0; i__ < NV; ++i__) { const int cc__ = tid + 512 * i__; const int vkv__ = NV == 1 ? (cc__ >> 3) : (cc__ >> 4), vch__ = NV == 1 ? (cc__ & 7) : (cc__ & 15); \
            vreg[i__] = *(const u32x4*)(vp__ + (size_t)(tt__ * 64 + vkv__) * vs__ + vch__ * 8); } } while (0)
#define AT_STOREK(kreg, off_) do { *(LAS u32x4*)(lds + AT_K + (off_) + kch * 1024 + (kkv ^ kch) * 16) = kreg; } while (0)
#define AT_STOREV(vreg, b_) do { _Pragma("unroll") for (int i__ = 0; i__ < NV; ++i__) { const int cc__ = tid + 512 * i__; const int vkv__ = NV == 1 ? (cc__ >> 3) : (cc__ >> 4), vch__ = NV == 1 ? (cc__ & 7) : (cc__ & 15); \
            *(LAS u32x4*)(lds + AT_V + (b_) * 16384 + (vch__ >> 2) * 4096 + vkv__ * 64 + (vch__ & 3) * 16) = vreg[i__]; } } while (0)
    const int rs = NB ? min(max(R - 4, 0), 24) : 0;
    const int cs = NB ? min(max(c - 8, 0), 48) : 0;
    const LAS float* biasL = (const LAS float*)(lds + AT_BIAS);
    const int vlane = ((lane >> 4) & 1) * 32 + (lane & 3) * 8 + (4 * hi + ((lane & 15) >> 2)) * 64;
    int kl[4];
#pragma unroll
    for (int d0 = 0; d0 < 4; ++d0) kl[d0] = (2 * d0 + hi) * 1024 + (r32 ^ (2 * d0 + hi)) * 16;
    const LAS unsigned char* Kl = lds + AT_K;
#define AT_ACTIVE(t_) (!NB || (t_) < nt0 || (kr0 + ((t_) - nt0) >= rs && kr0 + ((t_) - nt0) < rs + 8))
    AT_LOADK(kA, 0);
    if (NT > 1) AT_LOADK(kB, 1);
    AT_LOADV(vB, 0);
    AT_STOREK(kA, 0);
    if (NT > 1) AT_STOREK(kB, 8192);
    AT_STOREV(vB, 0);
    if (NT > 2) AT_LOADK(kA, 2);
    if (NT > 1) AT_LOADV(vA, 1);
    AT_BAR();
    f32x16 p0, p1;
    if (AT_ACTIVE(0)) qk_tile(Kl, kl, qr, p0, p1);
    int kcur = 0;
#define AT_STEP(t_, KL, VL, KS, VS) do { const int t = (t_); \
        const int knext = kcur == 16384 ? 0 : kcur + 8192, knn = knext == 16384 ? 0 : knext + 8192; \
        if (t + 3 < NT) AT_LOADK(KL, t + 3); \
        if (t + 2 < NT) AT_LOADV(VL, t + 2); \
        if (AT_ACTIVE(t)) sm_pv<DV, NB>(p0, p1, lds + AT_V + (t & 1) * 16384 + vlane, OT, m_run, l_run, NB && t >= nt0, biasL + (kr0 + (t - nt0) - R + 7) * 31, c, cs, hi); \
        if (wtype == 0) { if (t + 2 < NT) AT_STOREK(KS, knn); if (t + 1 < NT) AT_STOREV(VS, (t + 1) & 1); AT_BAR(); } \
        if (t + 1 < NT && AT_ACTIVE(t + 1)) qk_tile(Kl + knext, kl, qr, p0, p1); \
        if (wtype != 0) { if (t + 2 < NT) AT_STOREK(KS, knn); if (t + 1 < NT) AT_STOREV(VS, (t + 1) & 1); AT_BAR(); } \
        kcur = knext; } while (0)
    for (int t2 = 0; t2 < NT; t2 += 2) {
        AT_STEP(t2, kB, vB, kA, vA);
        if (t2 + 1 < NT) AT_STEP(t2 + 1, kA, vA, kB, vB);
    }
    AT_BAR();
#undef AT_LOADK
#undef AT_LOADV
#undef AT_STOREK
#undef AT_STOREV
#undef AT_ACTIVE
#undef AT_STEP
}

__device__ __forceinline__ void load_q(bf16x8 (&qr)[4], const bf16_t* Q, int ldq) {
    const int tid = opaque_tid(), lane = tid & 63, r32 = lane & 31, hi = lane >> 5, wid = tid >> 6;
    const bf16_t* p = Q + (size_t)(wid * 32 + r32) * ldq + hi * 8;
#pragma unroll
    for (int d0 = 0; d0 < 4; ++d0) qr[d0] = *(const bf16x8*)(p + d0 * 16);
}
__device__ __forceinline__ void store_o64(const f32x16 (&OT)[2], float l_run, bf16_t* O  ) {
    const int tid = opaque_tid(), lane = tid & 63, r32 = lane & 31, hi = lane >> 5, wid = tid >> 6;
    const float inv = 1.f / (l_run + __shfl_xor(l_run, 32));
    bf16_t* op = O + (size_t)(wid * 32 + r32) * DM + 4 * hi;
#pragma unroll
    for (int d = 0; d < 2; ++d)
#pragma unroll
        for (int g = 0; g < 4; ++g) { u32x2 w; w.x = pk2(OT[d][4 * g] * inv, OT[d][4 * g + 1] * inv); w.y = pk2(OT[d][4 * g + 2] * inv, OT[d][4 * g + 3] * inv); *(u32x2*)(op + 32 * d + 8 * g) = w; }
}

__device__ __forceinline__ void attn_even_phase(const Args& a, LAS unsigned char* lds, int e, int vcu, int G) {
    const int tid = opaque_tid(), lane = tid & 63, r32 = lane & 31, wid = tid >> 6;
    unsigned char* ws = wsp(a);
    const bf16_t* QKV = (const bf16_t*)(ws + WS_U); bf16_t* OB = (bf16_t*)(ws + WS_O);
    for (int u = vcu; u < 1280; u += G) {
        bf16x8 qr[4]; f32x16 OT[2]; OT[0] = f32x16{}; OT[1] = f32x16{};
        float m_run = -1e30f, l_run = 0.f;
        if (u < 512) {
            const int b = u >> 6, h = (u >> 3) & 7, qb = u & 7, g = h >> 2;
            const size_t row0 = (size_t)b * 2048 + qb * 256;
            load_q(qr, QKV + row0 * NQ_E + 64 * h, NQ_E);
            const KVSrc s0{QKV + (size_t)b * 2048 * NQ_E + 512 + 64 * g, QKV + (size_t)b * 2048 * NQ_E + 640 + 64 * g, NQ_E, NQ_E};
            const size_t co = (size_t)(b * 2 + e) * 512 * 128 + 64 * g;
            const KVSrc s1{(const bf16_t*)(ws + WS_CAK) + co, (const bf16_t*)(ws + WS_CAV) + co, 128, 128};
            attn_pass<64, false>(lds, qr, s0, 32, s1, 8, OT, m_run, l_run, 0, 0, 0);
            store_o64(OT, l_run, OB + row0 * DM + 64 * h);
        } else if (u < 1024) {
            const int v = u - 512, b = v >> 6, h = (v >> 3) & 7, qb = v & 7;
            const size_t row0 = (size_t)b * 2048 + qb * 256;
            for (int i = tid; i < 465; i += 512) ((LAS float*)(lds + AT_BIAS))[i] = inp(a, 20)[(size_t)(e * 8 + h) * 465 + i] * LOG2E;
            load_q(qr, QKV + row0 * NQ_E + 768 + 64 * h, NQ_E);
            const size_t co = (size_t)(b * 2 + e) * 512 * 512 + 64 * h;
            const KVSrc s0{(const bf16_t*)(ws + WS_CBK) + co, (const bf16_t*)(ws + WS_CBV) + co, 512, 512};
            const int klo = min(max(4 * qb - 4, 0), 24), khi = min(max(4 * qb - 1, 0), 24) + 8;
            const size_t lo = ((size_t)b * 2048 + klo * 64) * NQ_E;
            const KVSrc s1{QKV + lo + 1280 + 64 * h, QKV + lo + 1792 + 64 * h, NQ_E, NQ_E};
            attn_pass<64, true>(lds, qr, s0, 8, s1, khi - klo, OT, m_run, l_run, 4 * qb + (wid >> 1), 32 * (wid & 1) + r32, klo);
            store_o64(OT, l_run, OB + row0 * DM + 512 + 64 * h);
        } else {
            const int v = u - 1024, isb = v >> 7, b = (v >> 3) & 15, h = v & 7;
            const size_t row0 = (size_t)NLAT + b * 256;
            const int qc = isb ? 768 + 64 * h : 64 * h, kc = isb ? 1280 + 64 * h : 512 + 64 * (h >> 2), vc = isb ? 1792 + 64 * h : 640 + 64 * (h >> 2);
            load_q(qr, QKV + row0 * NQ_E + qc, NQ_E);
            const KVSrc s0{QKV + row0 * NQ_E + kc, QKV + row0 * NQ_E + vc, NQ_E, NQ_E};
            attn_pass<64, false>(lds, qr, s0, 4, s0, 0, OT, m_run, l_run, 0, 0, 0);
            store_o64(OT, l_run, OB + row0 * DM + (isb ? 512 : 0) + 64 * h);
        }
    }
}

__device__ __forceinline__ void attn_odd_phase(const Args& a, LAS unsigned char* lds, int o, float lam_init, int vcu, int G) {
    const int tid = opaque_tid(), lane = tid & 63, r32 = lane & 31, hi = lane >> 5, wid = tid >> 6;
    unsigned char* ws = wsp(a);
    const bf16_t* QKV = (const bf16_t*)(ws + WS_U); bf16_t* OB = (bf16_t*)(ws + WS_O);
    const float* lp = inp(a, 23) + o * 256;
    const float lam = __expf(wave_sum(lp[lane] * lp[64 + lane])) - __expf(wave_sum(lp[128 + lane] * lp[192 + lane])) + lam_init;
    const float* sub = inp(a, 24) + o * 128;
    for (int u = vcu; u < 640; u += G) {
        int b, h, qb, nt0, nt1; size_t row0, krow0;
        if (u < 512) { b = u >> 6; h = (u >> 3) & 7; qb = u & 7; row0 = (size_t)b * 2048 + qb * 256; krow0 = (size_t)b * 2048; nt0 = 32; nt1 = 8; }
        else { const int v = u - 512; b = v >> 3; h = v & 7; qb = 0; row0 = (size_t)NLAT + b * 256; krow0 = row0; nt0 = 4; nt1 = 0; }
        LAS u32x4* o0s = (LAS u32x4*)(lds + 65536 + wid * 8192 + lane * 16);
#pragma unroll
        for (int j = 0; j < 2; ++j) {
            bf16x8 qr[4]; f32x16 OT[4];
#pragma unroll
            for (int d = 0; d < 4; ++d) OT[d] = f32x16{};
            float m_run = -1e30f, l_run = 0.f;
            load_q(qr, QKV + row0 * NQ_O + 128 * h + 64 * j, NQ_O);
            const KVSrc s0{QKV + krow0 * NQ_O + 1024 + 128 * h + 64 * j, QKV + krow0 * NQ_O + 2048 + 128 * h, NQ_O, NQ_O};
            const size_t co = (size_t)((b & 7) * 2 + o) * 512 * 1024 + 128 * h;
            const KVSrc s1{(const bf16_t*)(ws + WS_CCK) + co + 64 * j, (const bf16_t*)(ws + WS_CCV) + co, 1024, 1024};
            attn_pass<128, false>(lds, qr, s0, nt0, s1, nt1, OT, m_run, l_run, 0, 0, 0);
            const float inv = 1.f / (l_run + __shfl_xor(l_run, 32));
            if (j == 0) {
#pragma unroll
                for (int d = 0; d < 4; ++d)
#pragma unroll
                    for (int r = 0; r < 2; ++r) { u32x4 w; w.x = pk2(OT[d][8 * r] * inv, OT[d][8 * r + 1] * inv); w.y = pk2(OT[d][8 * r + 2] * inv, OT[d][8 * r + 3] * inv);
                        w.z = pk2(OT[d][8 * r + 4] * inv, OT[d][8 * r + 5] * inv); w.w = pk2(OT[d][8 * r + 6] * inv, OT[d][8 * r + 7] * inv); o0s[(d * 2 + r) * 64] = w; }
            } else {
                const float f1 = lam * inv; float ss = 0.f;
#pragma unroll
                for (int d = 0; d < 4; ++d)
#pragma unroll
                    for (int rr = 0; rr < 2; ++rr) { const u32x4 w = o0s[(d * 2 + rr) * 64];
#pragma unroll
                        for (int q = 0; q < 4; ++q) { const int r = 4 * rr + q;
                            const float a0 = __uint_as_float(w[q] << 16), a1 = __uint_as_float(w[q] & 0xffff0000u);
                            OT[d][2 * r] = a0 - OT[d][2 * r] * f1; OT[d][2 * r + 1] = a1 - OT[d][2 * r + 1] * f1;
                            ss += OT[d][2 * r] * OT[d][2 * r] + OT[d][2 * r + 1] * OT[d][2 * r + 1]; } }
                ss += __shfl_xor(ss, 32);
                const float rstd = rsqrtf(ss * (1.f / 128.f) + EPS) * (1.f - lam_init);
                bf16_t* op = OB + (row0 + wid * 32 + r32) * DM + 128 * h + 4 * hi;
#pragma unroll
                for (int d = 0; d < 4; ++d)
#pragma unroll
                    for (int g = 0; g < 4; ++g) {
                        const f32x4 sw = *(const f32x4*)(sub + 32 * d + 8 * g + 4 * hi);
                        u32x2 w; w.x = pk2(OT[d][4 * g] * rstd * sw[0], OT[d][4 * g + 1] * rstd * sw[1]); w.y = pk2(OT[d][4 * g + 2] * rstd * sw[2], OT[d][4 * g + 3] * rstd * sw[3]);
                        *(u32x2*)(op + 32 * d + 8 * g) = w;
                    }
            }
        }
    }
}

#define XB_TMO      128
#define XB_XCNT(j)  (256  + 64 * (j))
#define XB_XSUB(j)  (1280 + 64 * (j))
#define XB_XGEN(j)  (2304 + 64 * (j))
#define XB_TOP      3328
#define XB_TOPGEN   3392
#define XCD_BAR_WORDS 3456
#define XB_SPIN_CAP (1u << 18)

__device__ __forceinline__ unsigned xb_ld(unsigned* p)              { return __hip_atomic_load(p, __ATOMIC_RELAXED, __HIP_MEMORY_SCOPE_AGENT); }
__device__ __forceinline__ unsigned xb_add(unsigned* p, unsigned v) { return __hip_atomic_fetch_add(p, v, __ATOMIC_RELAXED, __HIP_MEMORY_SCOPE_AGENT); }
__device__ __forceinline__ unsigned xb_xcc_id() { return (unsigned)__builtin_amdgcn_s_getreg((3 << 11) | 20) & 0xFu; }
#define XB_SPIN(cond, bar) do { unsigned _sp = 0; while (cond) { __builtin_amdgcn_s_sleep(1); \
    if ((++_sp & 255u) == 0u) { if (xb_ld(&(bar)[XB_TMO])) break; if (_sp > XB_SPIN_CAP) { atomicAdd(&(bar)[XB_TMO], 1u); break; } } } } while (0)

struct XcdBarrier {
    unsigned* bar; unsigned x;
    volatile LAS unsigned* st;
};

__device__ __forceinline__ XcdBarrier xcd_barrier_post(unsigned* bar, volatile LAS unsigned* st) {
    XcdBarrier b; b.bar = bar; b.x = xb_xcc_id(); b.st = st;
    if (threadIdx.x == 0) (void)xb_add(&bar[XB_XCNT(b.x)], 1u);
    return b;
}
__device__ __forceinline__ void xcd_barrier_complete(unsigned* bar, unsigned x, unsigned& nloc, unsigned& nx) {
    const unsigned G = gridDim.x * gridDim.y * gridDim.z;
    unsigned sum, cnt, mine, sp = 0u;
    for (;;) {
        sum = 0u; cnt = 0u; mine = 0u;
#pragma unroll
        for (unsigned j = 0; j < 16; ++j) { const unsigned c = xb_ld(&bar[XB_XCNT(j)]); sum += c; cnt += (c > 0u) ? 1u : 0u; mine = (j == x) ? c : mine; }
        if (sum == G) break;
        __builtin_amdgcn_s_sleep(1);
        if ((++sp & 255u) == 0u) { if (xb_ld(&bar[XB_TMO])) break; if (sp > XB_SPIN_CAP) { atomicAdd(&bar[XB_TMO], 1u); break; } }
    }
    nloc = mine > 0u ? mine : 1u; nx = cnt > 0u ? cnt : 1u;
}

__device__ __forceinline__ void xcd_barrier(const XcdBarrier& b) {
    asm volatile("s_waitcnt vmcnt(0)" ::: "memory");
    __syncthreads();
    if (threadIdx.x == 0) {
        unsigned* bar = b.bar;
        __builtin_amdgcn_s_waitcnt(0);
        unsigned nloc = b.st[0], nx = b.st[1];
        if (nloc == 0u) { xcd_barrier_complete(bar, b.x, nloc, nx); b.st[0] = nloc; b.st[1] = nx; }
        const unsigned old = xb_add(&bar[XB_XSUB(b.x)], 1u);
        const unsigned gen = old / nloc;
        if (old + 1u == (gen + 1u) * nloc) {
            __builtin_amdgcn_fence(__ATOMIC_RELEASE, "agent");
            asm volatile("s_waitcnt vmcnt(0)" ::: "memory");
            const unsigned og = xb_add(&bar[XB_TOP], 1u);
            const unsigned tg = og / nx;
            if (og + 1u == (tg + 1u) * nx) xb_add(&bar[XB_TOPGEN], 1u);
            else XB_SPIN(xb_ld(&bar[XB_TOPGEN]) == tg, bar);
            __builtin_amdgcn_fence(__ATOMIC_ACQUIRE, "agent");
            xb_add(&bar[XB_XGEN(b.x)], 1u);
            asm volatile("s_waitcnt vmcnt(0)" ::: "memory");
        } else {
            XB_SPIN(xb_ld(&bar[XB_XGEN(b.x)]) == gen, bar);
            __builtin_amdgcn_fence(__ATOMIC_ACQUIRE, "agent");
            asm volatile("s_waitcnt vmcnt(0)" ::: "memory");
        }
    }
    __syncthreads();
}

__global__ void __launch_bounds__(512, 2) mega_fwd(Args a) {
    extern __shared__ __attribute__((aligned(16))) unsigned char lds_raw[];
    LAS unsigned char* lds = (LAS unsigned char*)lds_raw;
    cg::grid_group grid = cg::this_grid();
    const int G = gridDim.x; const int bx = blockIdx.x;
    const int vcu = (G % 8 == 0) ? (bx % 8) * (G / 8) + bx / 8 : bx;
    unsigned char* ws = wsp(a);
    const float* MOD = (const float*)(ws + WS_MOD);
    bf16_t* HB = (bf16_t*)(ws + WS_H); bf16_t* UB = (bf16_t*)(ws + WS_U); bf16_t* OB = (bf16_t*)(ws + WS_O); float* XB = (float*)(ws + WS_X);
    volatile LAS unsigned* bst = (volatile LAS unsigned*)(lds + 131072);
    if (threadIdx.x < 2) bst[threadIdx.x] = 0u;
    __syncthreads();
    const XcdBarrier xbar = xcd_barrier_post((unsigned*)(wsp(a) + WS_BAR), bst);
    int ph = 0;
#define GSYNC() do { if (ph == 0) grid.sync(); else xcd_barrier(xbar); } while (0)
#ifndef DUP_MASK
#define DUP_MASK 0
#endif
#ifndef XSYNC
#define XSYNC 1
#endif
#define RUN(...) do { if (ph >= a.ph_lo && ph < a.ph_hi) { __VA_ARGS__; if (ph + 1 < a.ph_hi) GSYNC(); } ++ph; } while (0)
#define RUND(bit, ...) do { if (ph >= a.ph_lo && ph < a.ph_hi) { int nrep_ = (DUP_MASK & (bit)) ? 2 : 1; asm volatile("" : "+s"(nrep_)); for (int rep_ = 0; rep_ < nrep_; ++rep_) { __VA_ARGS__; if (rep_ + 1 < nrep_ || ph + 1 < a.ph_hi) { GSYNC(); if (XSYNC) { xcd_barrier(xbar); xcd_barrier(xbar); } } } } ++ph; } while (0)

#ifndef PH_MASK
#define PH_MASK 0xff
#endif
    RUND(1, if (PH_MASK & 1) prologue_phase(a, lds, vcu, G));
    for (int l = 0; l < 4; ++l) {
        const float* modl = MOD + (size_t)l * 9 * 9216;
        for (int half = 0; half < 2; ++half) {
            const int sub = half ? 2 : 0, lf = l * 2 + half;
            RUND(2, if (PH_MASK & 2) norm_phase(a, l == 0 && half == 0, inp(a, 12) + (l * 3 + sub) * DM, modl, sub, vcu, G));
            RUND(4, if (PH_MASK & 4) { pg8::Gemm g{HB, (const bf16_t*)(ws + WS_W13T) + (size_t)lf * 5632 * 1024, MROWS, 5632, 1024}; pg8::StaticOrder S; S.init(MROWS, 5632, G, bx);
                  EpiSwiGLU E{UB}; pg8::gemm_phase<EpiSwiGLU, pg8::StaticOrder, true, true>(lds, g, S, E); });
            RUND(8, if (PH_MASK & 8) { pg8::Gemm g{UB, (const bf16_t*)(ws + WS_W2T) + (size_t)lf * 1024 * DFF, MROWS, 1024, DFF}; pg8::StaticOrder S; S.init(MROWS, 1024, G, bx);
                  EpiResid E{XB, modl + (3 * sub + 2) * 1024, (rep_ + 1 < nrep_) ? 0.f : 0.5f}; pg8::gemm_phase<EpiResid, pg8::StaticOrder, true, true>(lds, g, S, E); });
            if (half == 0) {
                const int eo = l >> 1; const bool even = (l & 1) == 0;
                RUND(2, if (PH_MASK & 2) norm_phase(a, false, inp(a, 12) + (l * 3 + 1) * DM, modl, 1, vcu, G));
                RUND(16, if (PH_MASK & 16) { const int nq = even ? NQ_E : NQ_O;
                      pg8::Gemm g{HB, even ? (const bf16_t*)(ws + WS_WINAB) + (size_t)eo * NQ_E * 1024 : (const bf16_t*)(ws + WS_WINC) + (size_t)eo * NQ_O * 1024, MROWS, nq, 1024};
                      pg8::StaticOrder S; S.init(MROWS, nq, G, bx);
                      EpiQKV E{UB, nq, even ? 1 : 0, eo, inp(a, 18) + eo * 64, inp(a, 19) + eo * 64, (const f32x2*)(ws + WS_ROPE), outp(a)};
                      pg8::gemm_phase<EpiQKV, pg8::StaticOrder, true, true>(lds, g, S, E); });
                RUND(32, { if (even) { if (PH_MASK & 32) attn_even_phase(a, lds, eo, vcu, G); } else if (PH_MASK & 64) attn_odd_phase(a, lds, eo, l == 1 ? 0.35550906759096926f : 0.5560582041556405f, vcu, G); });
                RUND(8, if (PH_MASK & 8) { pg8::Gemm g{OB, even ? (const bf16_t*)(ws + WS_WOUTAB) + (size_t)eo * 1024 * 1024 : (const bf16_t*)(ws + WS_WOUTC) + (size_t)eo * 1024 * 1024, MROWS, 1024, 1024};
                      pg8::StaticOrder S; S.init(MROWS, 1024, G, bx);
                      EpiResid E{XB, modl + 5 * 1024, (rep_ + 1 < nrep_) ? 0.f : 1.0f}; pg8::gemm_phase<EpiResid, pg8::StaticOrder, true, true>(lds, g, S, E); });
            }
        }
    }
    RUN(if (PH_MASK & 2) final_norm_phase(a, vcu, G));
#undef RUN
#undef RUND
}

extern "C" void kernel_launch(void* const* d_in, const int* in_sizes, int n_in, void* d_out, int out_size, void* d_ws, size_t ws_size, hipStream_t stream) {
    static int grid = 0;
    if (grid == 0) {
        int dev = 0, cus = 0, per_cu = 0;
        hipGetDevice(&dev);
        hipDeviceGetAttribute(&cus, hipDeviceAttributeMultiprocessorCount, dev);
        hipFuncSetAttribute((const void*)mega_fwd, hipFuncAttributeMaxDynamicSharedMemorySize, LDS_BYTES);
        hipOccupancyMaxActiveBlocksPerMultiprocessor(&per_cu, (const void*)mega_fwd, 512, LDS_BYTES);
        if (per_cu < 1) per_cu = 1;
        if (per_cu > 1) per_cu = 1;
        grid = cus * per_cu;
        if (n_in != 26 || ws_size < WS_END) { fprintf(stderr, "kernel_launch: unexpected n_in %d / ws %zu\n", n_in, ws_size); }
    }
    hipMemsetAsync((unsigned char*)d_ws + WS_BAR, 0, WS_BAR_BYTES, stream);
    Args a{};
    for (int i = 0; i < 26; ++i) a.in[i] = (const float*)d_in[i];
    a.out = (float*)d_out; a.ws = (unsigned char*)d_ws; a.ph_lo = 0; a.ph_hi = 1000;
    void* args[] = {&a};
    hipError_t e = hipLaunchCooperativeKernel((const void*)mega_fwd, dim3(grid), dim3(512), args, LDS_BYTES, stream);
    if (e != hipSuccess) fprintf(stderr, "cooperative launch failed: %s (grid %d)\n", hipGetErrorString(e), grid);
}
```

```cpp
#define DUP_MASK 0
#define XSYNC 0
#include <hip/hip_runtime.h>
#include <hip/hip_cooperative_groups.h>
#include <cstdio>
#include <cstdint>
namespace cg = cooperative_groups;
__device__ __forceinline__ int opaque_tid() { int t = threadIdx.x; asm volatile("" : "+v"(t)); return t; }
namespace pg8 {
#define PG8_LAS __attribute__((address_space(3)))
typedef unsigned short bf16_t;
typedef short bf16x8 __attribute__((ext_vector_type(8)));
typedef float f32x4 __attribute__((ext_vector_type(4)));
typedef unsigned u32x4 __attribute__((ext_vector_type(4)));
constexpr int BM = 256, BK = 64, HALF = 128, HTB = HALF * BK * 2  , STAGE_BYTES = 8 * HTB, NXCD = 8, WGM = 8;

__host__ __device__ __forceinline__ int lds_byte(int r, int c) { const int st = (r >> 4) * 2 + (c >> 5), rr = r & 15, cc = c & 31, ob = rr * 64 + cc * 2; return st * 1024 + (ob ^ (((ob >> 9) & 1) << 5)); }
__host__ __device__ __forceinline__ void stage_rc(int b, int& R, int& C) { const int st = b / 1024, sb = b % 1024, swz = sb ^ (((sb >> 9) & 1) << 5); R = (st >> 1) * 16 + swz / 64; C = (st & 1) * 32 + (swz % 64) / 2; }
__host__ __device__ __forceinline__ int perm32(int rho) { const int n = rho >> 4, i = rho & 15; return 8 * (i >> 2) + 4 * n + (i & 3); }

struct Unit { int pm, pn; };
struct Gemm { const bf16_t* A; const bf16_t* Bt; int M, N, K; };

struct StaticOrder {
    int nM, nN, nwg, G, c;
    __host__ __device__ void init(int M, int N, int G_, int c_) { nM = M / BM; nN = N / BM; nwg = nM * nN; G = G_; c = c_; }
    __host__ __device__ bool next(int i, Unit& u) const {
        const long L = (long)i * G + c; if (L >= nwg) return false;
        int wgid = (int)L; { const int q = nwg / NXCD, r = nwg % NXCD, xcd = wgid % NXCD, off = wgid / NXCD; wgid = (xcd < r ? xcd * (q + 1) : r * (q + 1) + (xcd - r) * q) + off; }
        const int nig = WGM * nN, gid = wgid / nig, fm = gid * WGM, gsz = (nM - fm) < WGM ? (nM - fm) : WGM;
        u.pm = fm + ((wgid % nig) % gsz); u.pn = (wgid % nig) / gsz; return true;
    }
    __device__ __forceinline__ void a_ready(const Unit&) const {}
    __device__ __forceinline__ void done(const Unit&) const {}
};

template <class Epi, class Sched, bool ALIGN_EPI = false, bool SP2 = false, bool HALFM = false>
__device__ __forceinline__ void gemm_phase(PG8_LAS unsigned char* lds, const Gemm g, const Sched& S, const Epi& E) {
    const int tid = opaque_tid(), wid = __builtin_amdgcn_readfirstlane(tid >> 6), lane = tid & 63, wr = wid >> 2, wc = wid & 3, fr = lane & 15, fq = lane >> 4;
    const int K = g.K, nt = K / BK;
    unsigned voffA[2], voffB[2];
#pragma unroll
    for (int i = 0; i < 2; ++i) { int R, C; stage_rc(tid * 16 + i * 8192, R, C); const int Rb = Epi::PERM ? ((R & ~31) + perm32(R & 31)) : R;
        voffA[i] = (unsigned)(R * K + C) * 2u; voffB[i] = (unsigned)(Rb * K + C) * 2u; }
    const size_t kstep = (size_t)(BK * 2);
    const size_t hstep = (size_t)HALF * K * 2;
    const size_t tstep = 2 * hstep;
    const unsigned ldsw = (unsigned)wid * 1024u;
    const int aoff = lds_byte(wr * 64 + fr, fq * 8), boff = lds_byte(wc * 32 + fr, fq * 8);
#define PG8_SA(b, h) (((b) * 2 + (h)) * HTB)
#define PG8_SB(b, h) ((4 + (b) * 2 + (h)) * HTB)
#define PG8_STAGE(bufoff, gbase, voff) do { _Pragma("unroll") for (int _i = 0; _i < 2; ++_i) \
        __builtin_amdgcn_global_load_lds((const unsigned*)((const char*)(gbase) + (voff)[_i]), (PG8_LAS unsigned*)(lds + (bufoff) + ldsw + _i * 8192), 16, 0, 0); } while (0)
#define PG8_LDA(dst, b, h) do { _Pragma("unroll") for (int m = 0; m < 4; ++m) _Pragma("unroll") for (int k = 0; k < 2; ++k) dst[m][k] = *(const PG8_LAS bf16x8*)(lds + PG8_SA(b, h) + aoff + m * 2048 + k * 1024); } while (0)
#define PG8_LDB(dst, b, h) do { _Pragma("unroll") for (int n = 0; n < 2; ++n) _Pragma("unroll") for (int k = 0; k < 2; ++k) dst[n][k] = *(const PG8_LAS bf16x8*)(lds + PG8_SB(b, h) + boff + n * 2048 + k * 1024); } while (0)
#define PG8_MMA(ai, bj, At, Bt) do { if (HALFM && (ai) == 1) break; __builtin_amdgcn_s_setprio(1); _Pragma("unroll") for (int m = 0; m < 4; ++m) _Pragma("unroll") for (int n = 0; n < 2; ++n) _Pragma("unroll") for (int k = 0; k < 2; ++k) \
        acc[ai][bj][m][n] = __builtin_amdgcn_mfma_f32_16x16x32_bf16(Bt[n][k], At[m][k], acc[ai][bj][m][n], 0, 0, 0); __builtin_amdgcn_s_setprio(0); } while (0)
#define PG8_WAIT_V(n) asm volatile("s_waitcnt vmcnt(" #n ")" ::: "memory")
#define PG8_WAIT_L(n) asm volatile("s_waitcnt lgkmcnt(" #n ")" ::: "memory")
#define PG8_BAR __builtin_amdgcn_s_barrier()
#define PG8_SCHED __builtin_amdgcn_sched_barrier(0)
    Unit cur, nxt; int ui = 0;
    if (!S.next(0, cur)) return;
    f32x4 acc[2][2][4][2];
#pragma unroll
    for (int a = 0; a < 2; ++a)
#pragma unroll
        for (int b = 0; b < 2; ++b)
#pragma unroll
            for (int m = 0; m < 4; ++m)
#pragma unroll
                for (int n = 0; n < 2; ++n) acc[a][b][m][n] = (f32x4){0.f, 0.f, 0.f, 0.f};
    bf16x8 At[4][2], B0[2][2], B1[2][2];
    const char* cA = (const char*)g.A + (size_t)cur.pm * tstep; const char* cB = (const char*)g.Bt + (size_t)cur.pn * tstep;
    S.a_ready(cur);
    if constexpr (SP2) {
        PG8_STAGE(PG8_SB(0, 0), cB, voffB); PG8_STAGE(PG8_SB(0, 1), cB + hstep, voffB); PG8_STAGE(PG8_SA(0, 0), cA, voffA); PG8_STAGE(PG8_SA(0, 1), cA + hstep, voffA);
        if (wr == 1) PG8_BAR;
        PG8_WAIT_V(2); PG8_BAR;
        PG8_STAGE(PG8_SB(1, 0), cB + kstep, voffB); PG8_STAGE(PG8_SA(1, 0), cA + kstep, voffA); PG8_STAGE(PG8_SB(1, 1), cB + hstep + kstep, voffB);
        PG8_WAIT_V(6); PG8_BAR;
    } else {
        PG8_STAGE(PG8_SB(0, 0), cB, voffB); PG8_STAGE(PG8_SA(0, 0), cA, voffA); PG8_STAGE(PG8_SB(0, 1), cB + hstep, voffB); PG8_STAGE(PG8_SA(0, 1), cA + hstep, voffA);
        if (wr == 1) PG8_BAR;
        PG8_WAIT_V(4); PG8_BAR;
        PG8_STAGE(PG8_SB(1, 0), cB + kstep, voffB); PG8_STAGE(PG8_SA(1, 0), cA + kstep, voffA); PG8_STAGE(PG8_SB(1, 1), cB + hstep + kstep, voffB);
        PG8_WAIT_V(6); PG8_BAR;
    }
    for (;;) {
        const bool has_next = S.next(ui + 1, nxt);
        const char* nA = has_next ? (const char*)g.A + (size_t)nxt.pm * tstep : cA; const char* nB = has_next ? (const char*)g.Bt + (size_t)nxt.pn * tstep : cB;
        for (int t = 0; t < nt; t += 2) {
            const bool last = (t == nt - 2);
            const char* a1 = cA + (size_t)(t + 1) * kstep;
            const char* a2 = last ? nA : cA + (size_t)(t + 2) * kstep; const char* b2 = last ? nB : cB + (size_t)(t + 2) * kstep;
            const char* a3 = a2 + kstep; const char* b3 = b2 + kstep;
            if (last && has_next) S.a_ready(nxt);
            if constexpr (SP2) {
            PG8_LDB(B0, 0, 0); PG8_LDB(B1, 0, 1); PG8_SCHED; PG8_LDA(At, 0, 0); PG8_STAGE(PG8_SA(1, 1), a1 + hstep, voffA);
            PG8_WAIT_V(8); PG8_WAIT_L(0); PG8_BAR; PG8_MMA(0, 0, At, B0); PG8_MMA(0, 1, At, B1); PG8_BAR; PG8_SCHED;
            PG8_LDA(At, 0, 1); PG8_STAGE(PG8_SB(0, 0), b2, voffB); PG8_STAGE(PG8_SB(0, 1), b2 + hstep, voffB); PG8_STAGE(PG8_SA(0, 0), a2, voffA);
            PG8_WAIT_V(8); PG8_WAIT_L(0); PG8_BAR; PG8_MMA(1, 0, At, B0); PG8_MMA(1, 1, At, B1); PG8_BAR; PG8_SCHED;
            PG8_LDB(B0, 1, 0); PG8_LDB(B1, 1, 1); PG8_SCHED; PG8_LDA(At, 1, 0); PG8_STAGE(PG8_SA(0, 1), a2 + hstep, voffA);
            PG8_WAIT_V(8); PG8_WAIT_L(0); PG8_BAR; PG8_MMA(0, 0, At, B0); PG8_MMA(0, 1, At, B1); PG8_BAR; PG8_SCHED;
            PG8_LDA(At, 1, 1); PG8_STAGE(PG8_SB(1, 0), b3, voffB); PG8_STAGE(PG8_SB(1, 1), b3 + hstep, voffB); PG8_STAGE(PG8_SA(1, 0), a3, voffA);
            PG8_WAIT_V(8); PG8_WAIT_L(0); PG8_BAR; PG8_MMA(1, 0, At, B0); PG8_MMA(1, 1, At, B1); PG8_BAR; PG8_SCHED;
            } else {
            PG8_LDB(B0, 0, 0); PG8_SCHED; PG8_LDA(At, 0, 0); PG8_STAGE(PG8_SA(1, 1), a1 + hstep, voffA);
            PG8_WAIT_L(8); PG8_BAR; PG8_WAIT_L(0); PG8_MMA(0, 0, At, B0); PG8_BAR; PG8_SCHED;
            PG8_LDB(B1, 0, 1); PG8_STAGE(PG8_SB(0, 0), b2, voffB);
            PG8_BAR; PG8_WAIT_L(0); PG8_MMA(0, 1, At, B1); PG8_BAR;
            PG8_LDA(At, 0, 1); PG8_STAGE(PG8_SA(0, 0), a2, voffA);
            PG8_BAR; PG8_WAIT_L(0); PG8_MMA(1, 0, At, B0); PG8_BAR; PG8_SCHED;
            PG8_STAGE(PG8_SB(0, 1), b2 + hstep, voffB);
            PG8_WAIT_V(6); PG8_BAR; PG8_MMA(1, 1, At, B1); PG8_BAR;
            PG8_LDB(B0, 1, 0); PG8_SCHED; PG8_LDA(At, 1, 0); PG8_STAGE(PG8_SA(0, 1), a2 + hstep, voffA);
            PG8_WAIT_L(8); PG8_BAR; PG8_WAIT_L(0); PG8_MMA(0, 0, At, B0); PG8_BAR; PG8_SCHED;
            PG8_LDB(B1, 1, 1); PG8_STAGE(PG8_SB(1, 0), b3, voffB);
            PG8_BAR; PG8_WAIT_L(0); PG8_MMA(0, 1, At, B1); PG8_BAR;
            PG8_LDA(At, 1, 1); PG8_STAGE(PG8_SA(1, 0), a3, voffA);
            PG8_BAR; PG8_WAIT_L(0); PG8_MMA(1, 0, At, B0); PG8_BAR; PG8_SCHED;
            PG8_STAGE(PG8_SB(1, 1), b3 + hstep, voffB);
            PG8_WAIT_V(6); PG8_BAR; PG8_MMA(1, 1, At, B1); PG8_BAR;
            }
        }
        if constexpr (ALIGN_EPI) { if (wr == 0) PG8_BAR; }
        if constexpr (!Epi::AFTER_DRAIN) { E(acc, cur, wr, wc, fr, fq); S.done(cur); }
        if (!has_next) break;
#pragma unroll
        for (int a = 0; a < 2; ++a)
#pragma unroll
            for (int b = 0; b < 2; ++b)
#pragma unroll
                for (int m = 0; m < 4; ++m)
#pragma unroll
                    for (int n = 0; n < 2; ++n) acc[a][b][m][n] = (f32x4){0.f, 0.f, 0.f, 0.f};
        cur = nxt; cA = nA; cB = nB; ++ui;
        if constexpr (ALIGN_EPI) { if (wr == 1) PG8_BAR; }
    }
    PG8_WAIT_V(0);
    if constexpr (!ALIGN_EPI) { if (wr == 0) PG8_BAR; }
    PG8_BAR;
    if constexpr (Epi::AFTER_DRAIN) { E.fused(acc, cur, wr, wc, fr, fq, lds, wid, lane); S.done(cur); }
#undef PG8_SA
#undef PG8_SB
#undef PG8_STAGE
#undef PG8_LDA
#undef PG8_LDB
#undef PG8_MMA
#undef PG8_WAIT_V
#undef PG8_WAIT_L
#undef PG8_BAR
#undef PG8_SCHED
}
}

#define LAS __attribute__((address_space(3)))
typedef unsigned short bf16_t;
typedef short bf16x8 __attribute__((ext_vector_type(8)));
typedef short s16x4 __attribute__((ext_vector_type(4)));
typedef float f32x4 __attribute__((ext_vector_type(4)));
typedef float f32x2 __attribute__((ext_vector_type(2)));
typedef float f32x16 __attribute__((ext_vector_type(16)));
typedef unsigned u32x4 __attribute__((ext_vector_type(4)));
typedef unsigned u32x2 __attribute__((ext_vector_type(2)));
typedef __bf16 bf16x2_t __attribute__((ext_vector_type(2)));

constexpr int DM = 1024, NLAT = 16384, NCTX = 4096, MROWS = 20480, DFF = 2816;
constexpr int NQ_E = 2304, NQ_O = 3072;
constexpr float EPS = 1e-6f;
constexpr float LOG2E = 1.4426950408889634f;
constexpr float SCL2 = 0.125f * LOG2E;

constexpr size_t MiB = 1u << 20;
constexpr size_t WS_BAR = 65536, WS_BAR_BYTES = 16384;
constexpr size_t WS_ROPE = 4096;
constexpr size_t WS_MOD = 1 * MiB;
constexpr size_t WS_W13T = 4 * MiB;
constexpr size_t WS_W2T = 92 * MiB;
constexpr size_t WS_WINAB = 136 * MiB;
constexpr size_t WS_WOUTAB = 145 * MiB;
constexpr size_t WS_WINC = 149 * MiB;
constexpr size_t WS_WOUTC = 161 * MiB;
constexpr size_t WS_CAK = 165 * MiB, WS_CAV = 167 * MiB, WS_CBK = 169 * MiB, WS_CBV = 177 * MiB, WS_CCK = 185 * MiB, WS_CCV = 201 * MiB;
constexpr size_t WS_X = 217 * MiB;
constexpr size_t WS_H = 297 * MiB;
constexpr size_t WS_O = 337 * MiB;
constexpr size_t WS_U = 377 * MiB;
constexpr size_t WS_ROWSS = 3 * MiB;
constexpr size_t WS_BIASV = 497 * MiB;
constexpr size_t WS_END = 500 * MiB;

constexpr size_t OUT_YP = 0, OUT_YS = 4194304, OUT_AK = 20971520, OUT_AV = 22020096, OUT_BK = 23068672, OUT_BV = 27262976, OUT_CK = 31457280, OUT_CV = 39845888;

constexpr int LDS_BYTES = 131072 + 1024;

__device__ __forceinline__ unsigned pk2(float lo, float hi) { f32x2 v = {lo, hi}; bf16x2_t b = __builtin_convertvector(v, bf16x2_t); return __builtin_bit_cast(unsigned, b); }
__device__ __forceinline__ float wave_sum(float v) {
#pragma unroll
    for (int o = 1; o < 64; o <<= 1) v += __shfl_xor(v, o);
    return v;
}
__device__ __forceinline__ float fast_exp2(float x) { return __builtin_amdgcn_exp2f(x); }
__device__ __forceinline__ float fast_rcp(float x) { return __builtin_amdgcn_rcpf(x); }

struct Args { const float* in[26]; float* out; unsigned char* ws; int ph_lo, ph_hi; };
#define GAS __attribute__((address_space(1)))
__device__ __forceinline__ const float* inp(const Args& a, int i) { asm volatile("" : "+s"(i)); GAS const float* g = (GAS const float*)a.in[i]; return (const float*)g; }
__device__ __forceinline__ unsigned char* wsp(const Args& a) { GAS unsigned char* g = (GAS unsigned char*)a.ws; asm volatile("" : "+s"(g)); return (unsigned char*)g; }
__device__ __forceinline__ float* outp(const Args& a) { GAS float* g = (GAS float*)a.out; return (float*)g; }

struct EpiSwiGLU {
    static constexpr bool PERM = true, AFTER_DRAIN = false;
    bf16_t* U; const float* rowss; const float* bias;
    __device__ __forceinline__ void operator()(const f32x4 (&acc)[2][2][4][2], const pg8::Unit& u, int wr, int wc, int fr, int fq) const {
        const int row0 = u.pm * 256 + wr * 64 + fr, col0 = u.pn * 128 + wc * 32 + 8 * fq;
        const int mi = u.pm < 64 ? (u.pm >> 3) : 8;
        const float* bp = bias + (size_t)mi * 5632 + u.pn * 256 + wc * 32 + 8 * fq;
        f32x4 b4[2][2];
#pragma unroll
        for (int bj = 0; bj < 2; ++bj)
#pragma unroll
            for (int n = 0; n < 2; ++n) b4[bj][n] = *(const f32x4*)(bp + bj * 128 + 4 * n);
#pragma unroll
        for (int ai = 0; ai < 2; ++ai)
#pragma unroll
            for (int m = 0; m < 4; ++m) {
                const int row = row0 + ai * 128 + m * 16;
                const float rstd = rsqrtf(rowss[row] * (1.f / DM) + EPS);
                bf16_t* rowp = U + (size_t)row * DFF + col0;
                float o[8];
#pragma unroll
                for (int n = 0; n < 2; ++n)
#pragma unroll
                    for (int i = 0; i < 4; ++i) { const float a = acc[ai][0][m][n][i] * rstd + b4[0][n][i], b = acc[ai][1][m][n][i] * rstd + b4[1][n][i];
                        o[n * 4 + i] = a * fast_rcp(1.f + fast_exp2(-a * LOG2E)) * b; }
                u32x4 w; w.x = pk2(o[0], o[1]); w.y = pk2(o[2], o[3]); w.z = pk2(o[4], o[5]); w.w = pk2(o[6], o[7]);
                *(u32x4*)rowp = w;
            }
    }
};
struct EpiResid {
    static constexpr bool PERM = true, AFTER_DRAIN = false;
    float* x; const float* gate; float coef;
    bf16_t* hb; const float* fnw; const float* fscale; float* rowss;
    int roff, nai;
    __device__ __forceinline__ void operator()(const f32x4 (&acc)[2][2][4][2], const pg8::Unit& u, int wr, int wc, int fr, int fq) const {
        const int mi = u.pm < 64 ? (u.pm >> 3) : 8;
        const int col0 = u.pn * 256 + wc * 32 + 8 * fq;
        const float* g = gate + (size_t)mi * 9216 + col0;
        const float* fs = fscale + (size_t)mi * 9216 + col0;
        const float* fw = fnw + col0;
#pragma unroll
        for (int ai = 0; ai < 2; ++ai) {
            if (ai >= nai) break;
#pragma unroll
            for (int m = 0; m < 4; ++m) {
                const int row = u.pm * 256 + roff + ai * 128 + wr * 64 + m * 16 + fr;
                float* p = x + (size_t)row * DM + col0;
                float ss = 0.f;
#pragma unroll
                for (int bj = 0; bj < 2; ++bj) {
                    f32x4 xv[2];
#pragma unroll
                    for (int n = 0; n < 2; ++n) {
                        const f32x4 g4 = *(const f32x4*)(g + bj * 128 + 4 * n) * coef;
                        xv[n] = *(const f32x4*)(p + bj * 128 + 4 * n) + g4 * acc[ai][bj][m][n];
                        *(f32x4*)(p + bj * 128 + 4 * n) = xv[n];
                        ss += (xv[n][0] * xv[n][0] + xv[n][1] * xv[n][1]) + (xv[n][2] * xv[n][2] + xv[n][3] * xv[n][3]);
                    }
                    if (hb) {
#pragma unroll
                        for (int n = 0; n < 2; ++n) xv[n] = xv[n] * (*(const f32x4*)(fw + bj * 128 + 4 * n)) * (1.f + *(const f32x4*)(fs + bj * 128 + 4 * n));
                        u32x4 w; w.x = pk2(xv[0][0], xv[0][1]); w.y = pk2(xv[0][2], xv[0][3]); w.z = pk2(xv[1][0], xv[1][1]); w.w = pk2(xv[1][2], xv[1][3]);
                        *(u32x4*)(hb + (size_t)row * DM + col0 + bj * 128) = w;
                    }
                }
                if (hb) {
                    ss += __shfl_xor(ss, 16); ss += __shfl_xor(ss, 32);
                    if (fq == 0) unsafeAtomicAdd(rowss + row, ss);
                }
                asm volatile("" ::: "memory");
            }
        }
    }
};
struct OneUnit {
    int pm, pn;
    __device__ __forceinline__ bool next(int i, pg8::Unit& u) const { if (i) return false; u.pm = pm; u.pn = pn; return true; }
    __device__ __forceinline__ void a_ready(const pg8::Unit&) const {}
    __device__ __forceinline__ void done(const pg8::Unit&) const {}
};
struct EpiQKV {
    static constexpr bool PERM = false, AFTER_DRAIN = false;
    bf16_t* Q; int ldq; int even; int e; const float* qn; const float* kn; const f32x2* rope; float* out; const float* rowss; const float* bias;
    __device__ __forceinline__ void operator()(const f32x4 (&acc)[2][2][4][2], const pg8::Unit& u, int wr, int wc, int fr, int fq) const {
        const int hu = 4 * u.pn + wc;
        const bool lat = u.pm < 64;
        const float* bp = bias + (size_t)(u.pm < 64 ? (u.pm >> 3) : 8) * 5632 + u.pn * 256 + wc * 32 + 4 * fq;
        bool do_rope; const float* nw = nullptr; float* ob = nullptr; int ow = 0;
        if (even) {
            do_rope = hu < 10;
            if (hu < 8) nw = qn; else if (hu < 10) { nw = kn; ob = out + OUT_AK + 64 * (hu - 8); ow = 128; }
            else if (hu < 12) { ob = out + OUT_AV + 64 * (hu - 10); ow = 128; }
            else if (hu < 20) {}
            else if (hu < 28) { ob = out + OUT_BK + 64 * (hu - 20); ow = 512; }
            else { ob = out + OUT_BV + 64 * (hu - 28); ow = 512; }
        } else {
            do_rope = hu < 32;
            if (hu < 16) {} else if (hu < 32) { ob = out + OUT_CK + 64 * (hu - 16); ow = 1024; }
            else { ob = out + OUT_CV + 64 * (hu - 32); ow = 1024; }
        }
        f32x4 w4[2][2];
        if (nw) {
#pragma unroll
            for (int bj = 0; bj < 2; ++bj)
#pragma unroll
                for (int n = 0; n < 2; ++n) w4[bj][n] = *(const f32x4*)(nw + 32 * bj + 16 * n + 4 * fq);
        }
#pragma unroll
        for (int ai = 0; ai < 2; ++ai)
#pragma unroll
            for (int m = 0; m < 4; ++m) {
                const int row = u.pm * 256 + ai * 128 + wr * 64 + m * 16 + fr;
                f32x4 v[2][2];
                const float rstd0 = rsqrtf(rowss[row] * (1.f / DM) + EPS);
#pragma unroll
                for (int bj = 0; bj < 2; ++bj)
#pragma unroll
                    for (int n = 0; n < 2; ++n) v[bj][n] = acc[ai][bj][m][n] * rstd0 + *(const f32x4*)(bp + bj * 128 + 16 * n);
                if (nw) {
                    float ss = 0.f;
#pragma unroll
                    for (int bj = 0; bj < 2; ++bj)
#pragma unroll
                        for (int n = 0; n < 2; ++n) ss += (v[bj][n][0] * v[bj][n][0] + v[bj][n][1] * v[bj][n][1]) + (v[bj][n][2] * v[bj][n][2] + v[bj][n][3] * v[bj][n][3]);
                    ss += __shfl_xor(ss, 16); ss += __shfl_xor(ss, 32);
                    const float rstd = rsqrtf(ss * (1.f / 64.f) + EPS);
#pragma unroll
                    for (int bj = 0; bj < 2; ++bj)
#pragma unroll
                        for (int n = 0; n < 2; ++n) v[bj][n] = v[bj][n] * rstd * w4[bj][n];
                }
                if (do_rope && lat) {
                    const int t = row & 2047;
#pragma unroll
                    for (int bj = 0; bj < 2; ++bj) {
                        const int pos = bj ? (t & 63) : (t >> 6);
                        const f32x2* rp = rope + pos * 16 + 4 * fq;
#pragma unroll
                        for (int i = 0; i < 4; ++i) { const f32x2 cs = rp[i]; const float x1 = v[bj][0][i], x2 = v[bj][1][i];
                            v[bj][0][i] = x1 * cs.x - x2 * cs.y; v[bj][1][i] = x2 * cs.x + x1 * cs.y; }
                    }
                }
                bf16_t* qp = Q + (size_t)row * ldq + 64 * hu + 4 * fq;
#pragma unroll
                for (int bj = 0; bj < 2; ++bj)
#pragma unroll
                    for (int n = 0; n < 2; ++n) { u32x2 w; w.x = pk2(v[bj][n][0], v[bj][n][1]); w.y = pk2(v[bj][n][2], v[bj][n][3]); *(u32x2*)(qp + 32 * bj + 16 * n) = w; }
                if (ob && !lat) {
                    const int cr = row - NLAT, b = cr >> 8, s = cr & 255;
                    float* op = ob + (size_t)((b * 2 + e) * 256 + s) * ow + 4 * fq;
#pragma unroll
                    for (int bj = 0; bj < 2; ++bj)
#pragma unroll
                        for (int n = 0; n < 2; ++n) *(f32x4*)(op + 32 * bj + 16 * n) = v[bj][n];
                }
            }
    }
};

__device__ __forceinline__ void transpose_item(const float* W, int K, int N, bf16_t* WT, int k0, int n0, int drow, LAS float* scr, int lane) {
#pragma unroll 8
    for (int i = 0; i < 32; ++i) { const int kk = 2 * i + (lane >> 5); scr[kk * 33 + (lane & 31)] = W[(size_t)(k0 + kk) * N + n0 + (lane & 31)]; }
    asm volatile("s_waitcnt lgkmcnt(0)" ::: "memory");
    const int c = lane & 7;
#pragma unroll
    for (int j = 0; j < 4; ++j) { const int n = (lane >> 3) + 8 * j; const LAS float* s = scr + (8 * c) * 33 + n;
        u32x4 o; o.x = pk2(s[0 * 33], s[1 * 33]); o.y = pk2(s[2 * 33], s[3 * 33]); o.z = pk2(s[4 * 33], s[5 * 33]); o.w = pk2(s[6 * 33], s[7 * 33]);
        *(u32x4*)(WT + (size_t)(drow + n) * K + k0 + 8 * c) = o; }
    asm volatile("s_waitcnt lgkmcnt(0)" ::: "memory");
}
__device__ __forceinline__ int qkv_drow(int n0) { const int hu = n0 >> 6, bj = (n0 >> 5) & 1; return 256 * (hu >> 2) + 128 * bj + 32 * (hu & 3); }

__device__ __forceinline__ void cvt_seg(const float* src, bf16_t* dst, int n4, int gt, int NT) {
    for (int i = gt; i < n4; i += NT) { const f32x4 v = ((const f32x4*)src)[i]; u32x2 w; w.x = pk2(v[0], v[1]); w.y = pk2(v[2], v[3]); ((u32x2*)dst)[i] = w; }
}

__device__ __forceinline__ void prologue_phase(const Args& a, LAS unsigned char* lds, int vcu, int G) {
    const int tid = opaque_tid(), lane = tid & 63, wave = __builtin_amdgcn_readfirstlane(tid >> 6);
    unsigned char* ws = wsp(a);
    {
        LAS float* sc = (LAS float*)lds;
        LAS f32x4* red = (LAS f32x4*)(lds + 36864);
        const int first = G - 1 - (int)blockIdx.x;
        if (first < 144) {
            for (int i = tid; i < 9 * 1024; i += 512) { const int r = i >> 10, k = i & 1023; const float cv = r < 8 ? inp(a, 8)[r * 1024 + k] : inp(a, 9)[k]; sc[i] = cv / (1.f + __expf(-cv)); }
            __syncthreads();
            for (int item = first; item < 144; item += G) {
                const int l = item / 36, cb = item % 36, col = cb * 256 + lane * 4;
                const float* wp = inp(a, 10) + ((size_t)l * 1024 + wave * 128) * 9216 + col;
                f32x4 acc[9];
#pragma unroll
                for (int r = 0; r < 9; ++r) acc[r] = (f32x4){0.f, 0.f, 0.f, 0.f};
#pragma unroll 4
                for (int k = 0; k < 128; ++k) {
                    const f32x4 wv = *(const f32x4*)(wp + (size_t)k * 9216);
#pragma unroll
                    for (int r = 0; r < 9; ++r) acc[r] += wv * sc[r * 1024 + wave * 128 + k];
                }
#pragma unroll
                for (int r = 0; r < 9; ++r) red[(wave * 9 + r) * 64 + lane] = acc[r];
                __syncthreads();
                for (int o = tid; o < 9 * 64; o += 512) {
                    const int r = o >> 6, ln = o & 63;
                    f32x4 s = *(const f32x4*)(inp(a, 11) + l * 9216 + cb * 256 + ln * 4);
#pragma unroll
                    for (int w = 0; w < 8; ++w) s += red[(w * 9 + r) * 64 + ln];
                    *(f32x4*)((float*)(ws + WS_MOD) + ((size_t)l * 9 + r) * 9216 + cb * 256 + ln * 4) = s;
                }
                __syncthreads();
            }
        }
        __syncthreads();
    }
    {
        LAS float* scr = (LAS float*)(lds + wave * 8704);
        const int gw = vcu * 8 + wave, NGW = G * 8;
        for (int it = gw; it < 41216; it += NGW) {
            if (it < 33792) {
                const int lf = it / 4224, r = it % 4224, which = r / 1408, q = r % 1408;
                if (which < 2) { const int kb = q / 88, nb = q % 88, n0 = 32 * nb; const int drow = 256 * (n0 >> 7) + (n0 & 127) + 128 * which;
                    transpose_item(inp(a, which == 0 ? 13 : 14) + (size_t)lf * 1024 * DFF, 1024, DFF, (bf16_t*)(ws + WS_W13T) + (size_t)lf * 5632 * 1024, 64 * kb, n0, drow, scr, lane); }
                else { const int kb = q / 32, nb = q % 32;
                    transpose_item(inp(a, 15) + (size_t)lf * DFF * 1024, DFF, 1024, (bf16_t*)(ws + WS_W2T) + (size_t)lf * 1024 * DFF, 64 * kb, 32 * nb, 32 * nb, scr, lane); }
            } else {
                int r = it - 33792;
                if (r < 2304) { const int e = r / 1152, q = r % 1152, kb = q / 72, nb = q % 72;
                    transpose_item(inp(a, 16) + (size_t)e * 1024 * NQ_E, 1024, NQ_E, (bf16_t*)(ws + WS_WINAB) + (size_t)e * NQ_E * 1024, 64 * kb, 32 * nb, qkv_drow(32 * nb), scr, lane); continue; }
                r -= 2304;
                if (r < 3072) { const int e = r / 1536, q = r % 1536, kb = q / 96, nb = q % 96;
                    transpose_item(inp(a, 21) + (size_t)e * 1024 * NQ_O, 1024, NQ_O, (bf16_t*)(ws + WS_WINC) + (size_t)e * NQ_O * 1024, 64 * kb, 32 * nb, qkv_drow(32 * nb), scr, lane); continue; }
                r -= 3072;
                if (r < 1024) { const int e = r / 512, q = r % 512, kb = q / 32, nb = q % 32;
                    transpose_item(inp(a, 17) + (size_t)e * 1024 * 1024, 1024, 1024, (bf16_t*)(ws + WS_WOUTAB) + (size_t)e * 1024 * 1024, 64 * kb, 32 * nb, 32 * nb, scr, lane); continue; }
                r -= 1024;
                { const int e = r / 512, q = r % 512, kb = q / 32, nb = q % 32;
                    transpose_item(inp(a, 22) + (size_t)e * 1024 * 1024, 1024, 1024, (bf16_t*)(ws + WS_WOUTC) + (size_t)e * 1024 * 1024, 64 * kb, 32 * nb, 32 * nb, scr, lane); }
            }
        }
    }
    {
        const int gt = blockIdx.x * 512 + tid, NT = G * 512;
        cvt_seg(inp(a, 2), (bf16_t*)(ws + WS_CAK), 1048576 / 4, gt, NT);
        cvt_seg(inp(a, 3), (bf16_t*)(ws + WS_CAV), 1048576 / 4, gt, NT);
        cvt_seg(inp(a, 4), (bf16_t*)(ws + WS_CBK), 4194304 / 4, gt, NT);
        cvt_seg(inp(a, 5), (bf16_t*)(ws + WS_CBV), 4194304 / 4, gt, NT);
        cvt_seg(inp(a, 6), (bf16_t*)(ws + WS_CCK), 8388608 / 4, gt, NT);
        cvt_seg(inp(a, 7), (bf16_t*)(ws + WS_CCV), 8388608 / 4, gt, NT);
        for (int i = gt; i < 12 * MROWS / 4; i += NT) ((f32x4*)(ws + WS_ROWSS))[i] = (f32x4){0.f, 0.f, 0.f, 0.f};
        if (gt < 1024) { const int pos = gt >> 4, f = gt & 15;
            const float inv = exp2f(-(float)f * (13.287712379549449f / 16.f));
            const float rev = (float)pos * inv * 0.15915494309189535f;
            f32x2 cs; cs.x = __builtin_amdgcn_cosf(rev); cs.y = __builtin_amdgcn_sinf(rev);
            ((f32x2*)(ws + WS_ROPE))[gt] = cs; }
    }
}

__device__ __forceinline__ void norm_phase(const Args& a, const float* nw, const float* modl, int vcu, int G) {
    const int tid = opaque_tid(), lane = tid & 63, wave = tid >> 6;
    float* xb = (float*)(wsp(a) + WS_X); bf16_t* hb = (bf16_t*)(wsp(a) + WS_H); float* rss = (float*)(wsp(a) + WS_ROWSS);
    for (int row = vcu * 8 + wave; row < MROWS; row += G * 8) {
        const float* xr = row < NLAT ? inp(a, 1) + (size_t)row * DM : inp(a, 0) + (size_t)(row - NLAT) * DM;
        f32x4 v[4]; float ss = 0.f;
#pragma unroll
        for (int j = 0; j < 4; ++j) { v[j] = ((const f32x4*)xr)[lane + 64 * j]; ss += (v[j][0] * v[j][0] + v[j][1] * v[j][1]) + (v[j][2] * v[j][2] + v[j][3] * v[j][3]); }
        ss = wave_sum(ss);
        if (lane == 0) rss[row] = ss;
#pragma unroll
        for (int j = 0; j < 4; ++j) ((f32x4*)(xb + (size_t)row * DM))[lane + 64 * j] = v[j];
        const int mi = row < NLAT ? (row >> 11) : 8;
        const float* sc = modl + (size_t)mi * 9216 + 1024;
#pragma unroll
        for (int j = 0; j < 4; ++j) {
            const int c4 = lane + 64 * j;
            const f32x4 o = v[j] * ((const f32x4*)nw)[c4] * (1.f + ((const f32x4*)sc)[c4]);
            u32x2 pw; pw.x = pk2(o[0], o[1]); pw.y = pk2(o[2], o[3]);
            ((u32x2*)(hb + (size_t)row * DM))[c4] = pw;
        }
    }
}
__device__ __forceinline__ void bias_phase(const Args& a, LAS unsigned char* lds, int G) {
    const int tid = opaque_tid(), lane = tid & 63, wave = tid >> 6;
    unsigned char* ws = wsp(a);
    LAS float* sh = (LAS float*)lds;
    int cur_g = -1;
    for (int it = blockIdx.x; it < 872; it += G) {
        int r = it, l = 0, sub = 0, base = 0;
        for (l = 0; l < 4; ++l) { const int nq = (l & 1) ? 48 : 36; const int tot = 176 + nq; if (r < tot) break; r -= tot; }
        { const int nq = (l & 1) ? 48 : 36; if (r < 88) { sub = 0; base = r; } else if (r < 88 + nq) { sub = 1; base = r - 88; } else { sub = 2; base = r - 88 - nq; } }
        const int g = l * 3 + sub;
        const bf16_t* Wt = sub == 1 ? ((l & 1) ? (const bf16_t*)(ws + WS_WINC) + (size_t)(l >> 1) * NQ_O * 1024 : (const bf16_t*)(ws + WS_WINAB) + (size_t)(l >> 1) * NQ_E * 1024)
                                    : (const bf16_t*)(ws + WS_W13T) + (size_t)(l * 2 + (sub >> 1)) * 5632 * 1024;
        if (g != cur_g) {
            __syncthreads();
            const float* modl = (const float*)(ws + WS_MOD) + (size_t)l * 9 * 9216 + (3 * sub) * 1024;
            for (int i = tid; i < 9 * 1024; i += 512) sh[i] = modl[(size_t)(i >> 10) * 9216 + (i & 1023)];
            __syncthreads();
            cur_g = g;
        }
        float* bo = (float*)(ws + WS_BIASV) + (size_t)g * 9 * 5632;
        for (int rr = 0; rr < 8; ++rr) {
            const int p = base * 64 + wave * 8 + rr;
            const u32x4 w0 = *(const u32x4*)(Wt + (size_t)p * 1024 + lane * 8), w1 = *(const u32x4*)(Wt + (size_t)p * 1024 + 512 + lane * 8);
            float wf[16];
#pragma unroll
            for (int q = 0; q < 4; ++q) { wf[2 * q] = __uint_as_float(w0[q] << 16); wf[2 * q + 1] = __uint_as_float(w0[q] & 0xffff0000u);
                                          wf[8 + 2 * q] = __uint_as_float(w1[q] << 16); wf[8 + 2 * q + 1] = __uint_as_float(w1[q] & 0xffff0000u); }
#pragma unroll
            for (int mi = 0; mi < 9; ++mi) {
                const LAS f32x4* s0 = (const LAS f32x4*)(sh + mi * 1024 + lane * 8); const LAS f32x4* s1 = (const LAS f32x4*)(sh + mi * 1024 + 512 + lane * 8);
                const f32x4 a0 = s0[0], a1 = s0[1], c0 = s1[0], c1 = s1[1];
                float acc = (wf[0] * a0[0] + wf[1] * a0[1]) + (wf[2] * a0[2] + wf[3] * a0[3]) + (wf[4] * a1[0] + wf[5] * a1[1]) + (wf[6] * a1[2] + wf[7] * a1[3])
                          + (wf[8] * c0[0] + wf[9] * c0[1]) + (wf[10] * c0[2] + wf[11] * c0[3]) + (wf[12] * c1[0] + wf[13] * c1[1]) + (wf[14] * c1[2] + wf[15] * c1[3]);
                acc = wave_sum(acc);
                if (lane == 0) bo[(size_t)mi * 5632 + p] = acc;
            }
        }
    }
    __syncthreads();
}
__device__ __forceinline__ void final_norm_phase(const Args& a, int vcu, int G) {
    const int tid = opaque_tid(), lane = tid & 63, wave = tid >> 6;
    const float* xb = (const float*)(wsp(a) + WS_X); const float* nw = inp(a, 25);
    for (int row = vcu * 8 + wave; row < MROWS; row += G * 8) {
        const float* xr = xb + (size_t)row * DM;
        float* orow = row < NLAT ? outp(a) + OUT_YS + (size_t)row * DM : outp(a) + OUT_YP + (size_t)(row - NLAT) * DM;
        f32x4 v[4]; float ss = 0.f;
#pragma unroll
        for (int j = 0; j < 4; ++j) { v[j] = ((const f32x4*)xr)[lane + 64 * j]; ss += (v[j][0] * v[j][0] + v[j][1] * v[j][1]) + (v[j][2] * v[j][2] + v[j][3] * v[j][3]); }
        const float rstd = rsqrtf(wave_sum(ss) * (1.f / DM) + EPS);
#pragma unroll
        for (int j = 0; j < 4; ++j) ((f32x4*)orow)[lane + 64 * j] = v[j] * rstd * ((const f32x4*)nw)[lane + 64 * j];
    }
}

struct KVSrc { const bf16_t* k; const bf16_t* v; int ks, vs; };
constexpr int AT_K = 0, AT_V = 24576, AT_BIAS = 57344;
__device__ __forceinline__ int crow(int r, int hi) { return (r & 3) + 8 * (r >> 2) + 4 * hi; }
typedef short v4i16_t __attribute__((ext_vector_type(4)));
__device__ __forceinline__ s16x4 vtr(const LAS unsigned char* p) { return __builtin_bit_cast(s16x4, __builtin_amdgcn_ds_read_tr16_b64_v4i16((LAS v4i16_t*)p)); }

__device__ __forceinline__ float xhalf_max(float m) {
    auto rr = __builtin_amdgcn_permlane32_swap(__float_as_uint(m), __float_as_uint(m), false, false);
    return fmaxf(__uint_as_float(rr[0]), __uint_as_float(rr[1]));
}
__device__ __forceinline__ void qk_tile(const LAS unsigned char* Kb, const int (&kl)[4], const bf16x8 (&qr)[4], f32x16& p0, f32x16& p1) {
    bf16x8 kf[8];
#pragma unroll
    for (int d0 = 0; d0 < 4; ++d0) { kf[2 * d0] = *(const LAS bf16x8*)(Kb + kl[d0]); kf[2 * d0 + 1] = *(const LAS bf16x8*)(Kb + kl[d0] + 512); }
    __builtin_amdgcn_sched_barrier(0);
    p0 = f32x16{}; p1 = f32x16{};
#pragma unroll
    for (int d0 = 0; d0 < 4; ++d0) {
        p0 = __builtin_amdgcn_mfma_f32_32x32x16_bf16(kf[2 * d0], qr[d0], p0, 0, 0, 0);
        p1 = __builtin_amdgcn_mfma_f32_32x32x16_bf16(kf[2 * d0 + 1], qr[d0], p1, 0, 0, 0);
    }
}
template <int DV, bool NB>
__device__ __forceinline__ void sm_pv(f32x16& p0, f32x16& p1, const LAS unsigned char* Vb, f32x16 (&OT)[DV / 32], float& m_run, float& l_run,
                                      const bool masked, const LAS float* brow, const int c, const int cs, const int hi) {
    float mn;
    if (NB && masked) {
        int co = c - 4 * hi, cso = cs - 4 * hi; asm volatile("" : "+v"(co), "+v"(cso));
#pragma unroll
        for (int r = 0; r < 16; ++r) {
            const int kc0 = (r & 3) + 8 * (r >> 2), kc1 = kc0 + 32;
            const int i0 = min(max(kc0 - co + 15, 0), 30), i1 = min(max(kc1 - co + 15, 0), 30);
            const float b0 = brow[i0], b1 = brow[i1];
            p0[r] = (kc0 >= cso && kc0 < cso + 16) ? p0[r] * SCL2 + b0 : -1e30f;
            p1[r] = (kc1 >= cso && kc1 < cso + 16) ? p1[r] * SCL2 + b1 : -1e30f;
        }
        float rm = fmaxf(p0[0], p1[0]);
#pragma unroll
        for (int r = 1; r < 16; ++r) rm = fmaxf(fmaxf(rm, p0[r]), p1[r]);
        rm = xhalf_max(rm);
        mn = fmaxf(m_run, rm);
#pragma unroll
        for (int r = 0; r < 16; ++r) { p0[r] = fast_exp2(p0[r] - mn); p1[r] = fast_exp2(p1[r] - mn); }
    } else {
        float rm = fmaxf(p0[0], p1[0]);
#pragma unroll
        for (int r = 1; r < 16; ++r) rm = fmaxf(fmaxf(rm, p0[r]), p1[r]);
        rm = xhalf_max(rm);
        mn = fmaxf(m_run, rm * SCL2);
#pragma unroll
        for (int r = 0; r < 16; ++r) { p0[r] = fast_exp2(p0[r] * SCL2 - mn); p1[r] = fast_exp2(p1[r] * SCL2 - mn); }
    }
    float ls0 = 0.f, ls1 = 0.f;
#pragma unroll
    for (int r = 0; r < 16; ++r) { ls0 += p0[r]; ls1 += p1[r]; }
    const float alpha = fast_exp2(m_run - mn);
    m_run = mn;
    l_run = l_run * alpha + (ls0 + ls1);
    if (__any(alpha != 1.f)) {
#pragma unroll
        for (int d = 0; d < DV / 32; ++d) OT[d] *= alpha;
    }
    bf16x8 pa[4];
#pragma unroll
    for (int k = 0; k < 4; ++k) {
        u32x4 w;
        if (k < 2) { w.x = pk2(p0[8 * k + 0], p0[8 * k + 1]); w.y = pk2(p0[8 * k + 2], p0[8 * k + 3]); w.z = pk2(p0[8 * k + 4], p0[8 * k + 5]); w.w = pk2(p0[8 * k + 6], p0[8 * k + 7]); }
        else { const int kk = k - 2; w.x = pk2(p1[8 * kk + 0], p1[8 * kk + 1]); w.y = pk2(p1[8 * kk + 2], p1[8 * kk + 3]); w.z = pk2(p1[8 * kk + 4], p1[8 * kk + 5]); w.w = pk2(p1[8 * kk + 6], p1[8 * kk + 7]); }
        pa[k] = __builtin_bit_cast(bf16x8, w);
    }
#pragma unroll
    for (int dd = 0; dd < DV / 64; ++dd) {
        s16x4 lo[2][4], hh[2][4];
#pragma unroll
        for (int d = 0; d < 2; ++d)
#pragma unroll
            for (int k = 0; k < 4; ++k) { lo[d][k] = vtr(Vb + (2 * dd + d) * 4096 + k * 1024); hh[d][k] = vtr(Vb + (2 * dd + d) * 4096 + k * 1024 + 512); }
        __builtin_amdgcn_sched_barrier(0);
#pragma unroll
        for (int k = 0; k < 4; ++k)
#pragma unroll
            for (int d = 0; d < 2; ++d) {
                const bf16x8 vf = {lo[d][k][0], lo[d][k][1], lo[d][k][2], lo[d][k][3], hh[d][k][0], hh[d][k][1], hh[d][k][2], hh[d][k][3]};
                OT[2 * dd + d] = __builtin_amdgcn_mfma_f32_32x32x16_bf16(vf, pa[k], OT[2 * dd + d], 0, 0, 0);
            }
    }
}

#define AT_BAR() do { asm volatile("s_waitcnt lgkmcnt(0)" ::: "memory"); __builtin_amdgcn_s_barrier(); asm volatile("" ::: "memory"); } while (0)
template <int DV, bool NB>
__device__ __forceinline__ void attn_pass(LAS unsigned char* lds, const bf16x8 (&qr)[4], const KVSrc s0, const int nt0, const KVSrc s1, const int nt1,
                                          f32x16 (&OT)[DV / 32], float& m_run, float& l_run,
                                          const int R, const int c, const int kr0) {
    constexpr int NV = DV / 64;
    const int tid = opaque_tid(), lane = tid & 63, r32 = lane & 31, hi = lane >> 5;
    const int NT = nt0 + nt1;
    const int wtype = __builtin_amdgcn_readfirstlane(tid >> 8);
    const int kkv = tid >> 3, kch = tid & 7;
    u32x4 kA, kB, vA[NV], vB[NV];
#define AT_LOADK(kreg, t_) do { const int t__ = (t_); const bool f__ = t__ < nt0; const int tt__ = f__ ? t__ : t__ - nt0; \
        const bf16_t* kp__ = f__ ? s0.k : s1.k; const int ks__ = f__ ? s0.ks : s1.ks; \
        kreg = *(const u32x4*)(kp__ + (size_t)(tt__ * 64 + kkv) * ks__ + kch * 8); } while (0)
#define AT_LOADV(vreg, t_) do { const int t__ = (t_); const bool f__ = t__ < nt0; const int tt__ = f__ ? t__ : t__ - nt0; \
        const bf16_t* vp__ = f__ ? s0.v : s1.v; const int vs__ = f__ ? s0.vs : s1.vs; \
        _Pragma("unroll") for (int i__ = 0; i__ < NV; ++i__) { const int cc__ = tid + 512 * i__; const int vkv__ = NV == 1 ? (cc__ >> 3) : (cc__ >> 4), vch__ = NV == 1 ? (cc__ & 7) : (cc__ & 15); \
            vreg[i__] = *(const u32x4*)(vp__ + (size_t)(tt__ * 64 + vkv__) * vs__ + vch__ * 8); } } while (0)
#define AT_STOREK(kreg, off_) do { *(LAS u32x4*)(lds + AT_K + (off_) + kch * 1024 + (kkv ^ kch) * 16) = kreg; } while (0)
#define AT_STOREV(vreg, b_) do { _Pragma("unroll") for (int i__ = 0; i__ < NV; ++i__) { const int cc__ = tid + 512 * i__; const int vkv__ = NV == 1 ? (cc__ >> 3) : (cc__ >> 4), vch__ = NV == 1 ? (cc__ & 7) : (cc__ & 15); \
            *(LAS u32x4*)(lds + AT_V + (b_) * 16384 + (vch__ >> 2) * 4096 + vkv__ * 64 + (vch__ & 3) * 16) = vreg[i__]; } } while (0)
    const int rs = NB ? min(max(R - 4, 0), 24) : 0;
    const int cs = NB ? min(max(c - 8, 0), 48) : 0;
    const LAS float* biasL = (const LAS float*)(lds + AT_BIAS);
    const int vlane = ((lane >> 4) & 1) * 32 + (lane & 3) * 8 + (4 * hi + ((lane & 15) >> 2)) * 64;
    int kl[4];
#pragma unroll
    for (int d0 = 0; d0 < 4; ++d0) kl[d0] = (2 * d0 + hi) * 1024 + (r32 ^ (2 * d0 + hi)) * 16;
    const LAS unsigned char* Kl = lds + AT_K;
#define AT_ACTIVE(t_) (!NB || (t_) < nt0 || (kr0 + ((t_) - nt0) >= rs && kr0 + ((t_) - nt0) < rs + 8))
    AT_LOADK(kA, 0);
    if (NT > 1) AT_LOADK(kB, 1);
    AT_LOADV(vB, 0);
    AT_STOREK(kA, 0);
    if (NT > 1) AT_STOREK(kB, 8192);
    AT_STOREV(vB, 0);
    if (NT > 2) AT_LOADK(kA, 2);
    if (NT > 1) AT_LOADV(vA, 1);
    AT_BAR();
    f32x16 p0, p1;
    if (AT_ACTIVE(0)) qk_tile(Kl, kl, qr, p0, p1);
    int kcur = 0;
#define AT_STEP(t_, KL, VL, KS, VS) do { const int t = (t_); \
        const int knext = kcur == 16384 ? 0 : kcur + 8192, knn = knext == 16384 ? 0 : knext + 8192; \
        if (t + 3 < NT) AT_LOADK(KL, t + 3); \
        if (t + 2 < NT) AT_LOADV(VL, t + 2); \
        if (AT_ACTIVE(t)) sm_pv<DV, NB>(p0, p1, lds + AT_V + (t & 1) * 16384 + vlane, OT, m_run, l_run, NB && t >= nt0, biasL + (kr0 + (t - nt0) - R + 7) * 31, c, cs, hi); \
        if (wtype == 0) { if (t + 2 < NT) AT_STOREK(KS, knn); if (t + 1 < NT) AT_STOREV(VS, (t + 1) & 1); AT_BAR(); } \
        if (t + 1 < NT && AT_ACTIVE(t + 1)) qk_tile(Kl + knext, kl, qr, p0, p1); \
        if (wtype != 0) { if (t + 2 < NT) AT_STOREK(KS, knn); if (t + 1 < NT) AT_STOREV(VS, (t + 1) & 1); AT_BAR(); } \
        kcur = knext; } while (0)
    for (int t2 = 0; t2 < NT; t2 += 2) {
        AT_STEP(t2, kB, vB, kA, vA);
        if (t2 + 1 < NT) AT_STEP(t2 + 1, kA, vA, kB, vB);
    }
    AT_BAR();
#undef AT_LOADK
#undef AT_LOADV
#undef AT_STOREK
#undef AT_STOREV
#undef AT_ACTIVE
#undef AT_STEP
}

__device__ __forceinline__ void load_q(bf16x8 (&qr)[4], const bf16_t* Q, int ldq) {
    const int tid = opaque_tid(), lane = tid & 63, r32 = lane & 31, hi = lane >> 5, wid = tid >> 6;
    const bf16_t* p = Q + (size_t)(wid * 32 + r32) * ldq + hi * 8;
#pragma unroll
    for (int d0 = 0; d0 < 4; ++d0) qr[d0] = *(const bf16x8*)(p + d0 * 16);
}
__device__ __forceinline__ void store_o64(const f32x16 (&OT)[2], float l_run, bf16_t* O  ) {
    const int tid = opaque_tid(), lane = tid & 63, r32 = lane & 31, hi = lane >> 5, wid = tid >> 6;
    const float inv = 1.f / (l_run + __shfl_xor(l_run, 32));
    bf16_t* op = O + (size_t)(wid * 32 + r32) * DM + 4 * hi;
#pragma unroll
    for (int d = 0; d < 2; ++d)
#pragma unroll
        for (int g = 0; g < 4; ++g) { u32x2 w; w.x = pk2(OT[d][4 * g] * inv, OT[d][4 * g + 1] * inv); w.y = pk2(OT[d][4 * g + 2] * inv, OT[d][4 * g + 3] * inv); *(u32x2*)(op + 32 * d + 8 * g) = w; }
}

__device__ __forceinline__ void attn_even_phase(const Args& a, LAS unsigned char* lds, int e, int vcu, int G) {
    const int tid = opaque_tid(), lane = tid & 63, r32 = lane & 31, wid = tid >> 6;
    unsigned char* ws = wsp(a);
    const bf16_t* QKV = (const bf16_t*)(ws + WS_U); bf16_t* OB = (bf16_t*)(ws + WS_O);
    for (int u = vcu; u < 1280; u += G) {
        bf16x8 qr[4]; f32x16 OT[2]; OT[0] = f32x16{}; OT[1] = f32x16{};
        float m_run = -1e30f, l_run = 0.f;
        if (u < 512) {
            const int b = u >> 6, h = (u >> 3) & 7, qb = u & 7, g = h >> 2;
            const size_t row0 = (size_t)b * 2048 + qb * 256;
            load_q(qr, QKV + row0 * NQ_E + 64 * h, NQ_E);
            const KVSrc s0{QKV + (size_t)b * 2048 * NQ_E + 512 + 64 * g, QKV + (size_t)b * 2048 * NQ_E + 640 + 64 * g, NQ_E, NQ_E};
            const size_t co = (size_t)(b * 2 + e) * 512 * 128 + 64 * g;
            const KVSrc s1{(const bf16_t*)(ws + WS_CAK) + co, (const bf16_t*)(ws + WS_CAV) + co, 128, 128};
            attn_pass<64, false>(lds, qr, s0, 32, s1, 8, OT, m_run, l_run, 0, 0, 0);
            store_o64(OT, l_run, OB + row0 * DM + 64 * h);
        } else if (u < 1024) {
            const int v = u - 512, b = v >> 6, h = (v >> 3) & 7, qb = v & 7;
            const size_t row0 = (size_t)b * 2048 + qb * 256;
            for (int i = tid; i < 465; i += 512) ((LAS float*)(lds + AT_BIAS))[i] = inp(a, 20)[(size_t)(e * 8 + h) * 465 + i] * LOG2E;
            load_q(qr, QKV + row0 * NQ_E + 768 + 64 * h, NQ_E);
            const size_t co = (size_t)(b * 2 + e) * 512 * 512 + 64 * h;
            const KVSrc s0{(const bf16_t*)(ws + WS_CBK) + co, (const bf16_t*)(ws + WS_CBV) + co, 512, 512};
            const int klo = min(max(4 * qb - 4, 0), 24), khi = min(max(4 * qb - 1, 0), 24) + 8;
            const size_t lo = ((size_t)b * 2048 + klo * 64) * NQ_E;
            const KVSrc s1{QKV + lo + 1280 + 64 * h, QKV + lo + 1792 + 64 * h, NQ_E, NQ_E};
            attn_pass<64, true>(lds, qr, s0, 8, s1, khi - klo, OT, m_run, l_run, 4 * qb + (wid >> 1), 32 * (wid & 1) + r32, klo);
            store_o64(OT, l_run, OB + row0 * DM + 512 + 64 * h);
        } else {
            const int v = u - 1024, isb = v >> 7, b = (v >> 3) & 15, h = v & 7;
            const size_t row0 = (size_t)NLAT + b * 256;
            const int qc = isb ? 768 + 64 * h : 64 * h, kc = isb ? 1280 + 64 * h : 512 + 64 * (h >> 2), vc = isb ? 1792 + 64 * h : 640 + 64 * (h >> 2);
            load_q(qr, QKV + row0 * NQ_E + qc, NQ_E);
            const KVSrc s0{QKV + row0 * NQ_E + kc, QKV + row0 * NQ_E + vc, NQ_E, NQ_E};
            attn_pass<64, false>(lds, qr, s0, 4, s0, 0, OT, m_run, l_run, 0, 0, 0);
            store_o64(OT, l_run, OB + row0 * DM + (isb ? 512 : 0) + 64 * h);
        }
    }
}

__device__ __forceinline__ void attn_odd_phase(const Args& a, LAS unsigned char* lds, int o, float lam_init, int vcu, int G) {
    const int tid = opaque_tid(), lane = tid & 63, r32 = lane & 31, hi = lane >> 5, wid = tid >> 6;
    unsigned char* ws = wsp(a);
    const bf16_t* QKV = (const bf16_t*)(ws + WS_U); bf16_t* OB = (bf16_t*)(ws + WS_O);
    const float* lp = inp(a, 23) + o * 256;
    const float lam = __expf(wave_sum(lp[lane] * lp[64 + lane])) - __expf(wave_sum(lp[128 + lane] * lp[192 + lane])) + lam_init;
    const float* sub = inp(a, 24) + o * 128;
    for (int u = vcu; u < 640; u += G) {
        int b, h, qb, nt0, nt1; size_t row0, krow0;
        if (u < 512) { b = u >> 6; h = (u >> 3) & 7; qb = u & 7; row0 = (size_t)b * 2048 + qb * 256; krow0 = (size_t)b * 2048; nt0 = 32; nt1 = 8; }
        else { const int v = u - 512; b = v >> 3; h = v & 7; qb = 0; row0 = (size_t)NLAT + b * 256; krow0 = row0; nt0 = 4; nt1 = 0; }
        LAS u32x4* o0s = (LAS u32x4*)(lds + 65536 + wid * 8192 + lane * 16);
#pragma unroll
        for (int j = 0; j < 2; ++j) {
            bf16x8 qr[4]; f32x16 OT[4];
#pragma unroll
            for (int d = 0; d < 4; ++d) OT[d] = f32x16{};
            float m_run = -1e30f, l_run = 0.f;
            load_q(qr, QKV + row0 * NQ_O + 128 * h + 64 * j, NQ_O);
            const KVSrc s0{QKV + krow0 * NQ_O + 1024 + 128 * h + 64 * j, QKV + krow0 * NQ_O + 2048 + 128 * h, NQ_O, NQ_O};
            const size_t co = (size_t)((b & 7) * 2 + o) * 512 * 1024 + 128 * h;
            const KVSrc s1{(const bf16_t*)(ws + WS_CCK) + co + 64 * j, (const bf16_t*)(ws + WS_CCV) + co, 1024, 1024};
            attn_pass<128, false>(lds, qr, s0, nt0, s1, nt1, OT, m_run, l_run, 0, 0, 0);
            const float inv = 1.f / (l_run + __shfl_xor(l_run, 32));
            if (j == 0) {
#pragma unroll
                for (int d = 0; d < 4; ++d)
#pragma unroll
                    for (int r = 0; r < 2; ++r) { u32x4 w; w.x = pk2(OT[d][8 * r] * inv, OT[d][8 * r + 1] * inv); w.y = pk2(OT[d][8 * r + 2] * inv, OT[d][8 * r + 3] * inv);
                        w.z = pk2(OT[d][8 * r + 4] * inv, OT[d][8 * r + 5] * inv); w.w = pk2(OT[d][8 * r + 6] * inv, OT[d][8 * r + 7] * inv); o0s[(d * 2 + r) * 64] = w; }
            } else {
                const float f1 = lam * inv; float ss = 0.f;
#pragma unroll
                for (int d = 0; d < 4; ++d)
#pragma unroll
                    for (int rr = 0; rr < 2; ++rr) { const u32x4 w = o0s[(d * 2 + rr) * 64];
#pragma unroll
                        for (int q = 0; q < 4; ++q) { const int r = 4 * rr + q;
                            const float a0 = __uint_as_float(w[q] << 16), a1 = __uint_as_float(w[q] & 0xffff0000u);
                            OT[d][2 * r] = a0 - OT[d][2 * r] * f1; OT[d][2 * r + 1] = a1 - OT[d][2 * r + 1] * f1;
                            ss += OT[d][2 * r] * OT[d][2 * r] + OT[d][2 * r + 1] * OT[d][2 * r + 1]; } }
                ss += __shfl_xor(ss, 32);
                const float rstd = rsqrtf(ss * (1.f / 128.f) + EPS) * (1.f - lam_init);
                bf16_t* op = OB + (row0 + wid * 32 + r32) * DM + 128 * h + 4 * hi;
#pragma unroll
                for (int d = 0; d < 4; ++d)
#pragma unroll
                    for (int g = 0; g < 4; ++g) {
                        const f32x4 sw = *(const f32x4*)(sub + 32 * d + 8 * g + 4 * hi);
                        u32x2 w; w.x = pk2(OT[d][4 * g] * rstd * sw[0], OT[d][4 * g + 1] * rstd * sw[1]); w.y = pk2(OT[d][4 * g + 2] * rstd * sw[2], OT[d][4 * g + 3] * rstd * sw[3]);
                        *(u32x2*)(op + 32 * d + 8 * g) = w;
                    }
            }
        }
    }
}

#define XB_TMO      128
#define XB_XCNT(j)  (256  + 64 * (j))
#define XB_XSUB(j)  (1280 + 64 * (j))
#define XB_XGEN(j)  (2304 + 64 * (j))
#define XB_TOP      3328
#define XB_TOPGEN   3392
#define XCD_BAR_WORDS 3456
#define XB_SPIN_CAP (1u << 18)

__device__ __forceinline__ unsigned xb_ld(unsigned* p)              { return __hip_atomic_load(p, __ATOMIC_RELAXED, __HIP_MEMORY_SCOPE_AGENT); }
__device__ __forceinline__ unsigned xb_add(unsigned* p, unsigned v) { return __hip_atomic_fetch_add(p, v, __ATOMIC_RELAXED, __HIP_MEMORY_SCOPE_AGENT); }
__device__ __forceinline__ unsigned xb_xcc_id() { return (unsigned)__builtin_amdgcn_s_getreg((3 << 11) | 20) & 0xFu; }
#define XB_SPIN(cond, bar) do { unsigned _sp = 0; while (cond) { __builtin_amdgcn_s_sleep(1); \
    if ((++_sp & 255u) == 0u) { if (xb_ld(&(bar)[XB_TMO])) break; if (_sp > XB_SPIN_CAP) { atomicAdd(&(bar)[XB_TMO], 1u); break; } } } } while (0)

struct XcdBarrier {
    unsigned* bar; unsigned x;
    volatile LAS unsigned* st;
};

__device__ __forceinline__ XcdBarrier xcd_barrier_post(unsigned* bar, volatile LAS unsigned* st) {
    XcdBarrier b; b.bar = bar; b.x = xb_xcc_id(); b.st = st;
    if (threadIdx.x == 0) (void)xb_add(&bar[XB_XCNT(b.x)], 1u);
    return b;
}
__device__ __forceinline__ void xcd_barrier_complete(unsigned* bar, unsigned x, unsigned& nloc, unsigned& nx) {
    const unsigned G = gridDim.x * gridDim.y * gridDim.z;
    unsigned sum, cnt, mine, sp = 0u;
    for (;;) {
        sum = 0u; cnt = 0u; mine = 0u;
#pragma unroll
        for (unsigned j = 0; j < 16; ++j) { const unsigned c = xb_ld(&bar[XB_XCNT(j)]); sum += c; cnt += (c > 0u) ? 1u : 0u; mine = (j == x) ? c : mine; }
        if (sum == G) break;
        __builtin_amdgcn_s_sleep(1);
        if ((++sp & 255u) == 0u) { if (xb_ld(&bar[XB_TMO])) break; if (sp > XB_SPIN_CAP) { atomicAdd(&bar[XB_TMO], 1u); break; } }
    }
    nloc = mine > 0u ? mine : 1u; nx = cnt > 0u ? cnt : 1u;
}

__device__ __forceinline__ void xcd_barrier(const XcdBarrier& b) {
    asm volatile("s_waitcnt vmcnt(0)" ::: "memory");
    __syncthreads();
    if (threadIdx.x == 0) {
        unsigned* bar = b.bar;
        __builtin_amdgcn_s_waitcnt(0);
        unsigned nloc = b.st[0], nx = b.st[1];
        if (nloc == 0u) { xcd_barrier_complete(bar, b.x, nloc, nx); b.st[0] = nloc; b.st[1] = nx; }
        const unsigned old = xb_add(&bar[XB_XSUB(b.x)], 1u);
        const unsigned gen = old / nloc;
        if (old + 1u == (gen + 1u) * nloc) {
            __builtin_amdgcn_fence(__ATOMIC_RELEASE, "agent");
            asm volatile("s_waitcnt vmcnt(0)" ::: "memory");
            const unsigned og = xb_add(&bar[XB_TOP], 1u);
            const unsigned tg = og / nx;
            if (og + 1u == (tg + 1u) * nx) xb_add(&bar[XB_TOPGEN], 1u);
            else XB_SPIN(xb_ld(&bar[XB_TOPGEN]) == tg, bar);
            __builtin_amdgcn_fence(__ATOMIC_ACQUIRE, "agent");
            xb_add(&bar[XB_XGEN(b.x)], 1u);
            asm volatile("s_waitcnt vmcnt(0)" ::: "memory");
        } else {
            XB_SPIN(xb_ld(&bar[XB_XGEN(b.x)]) == gen, bar);
            __builtin_amdgcn_fence(__ATOMIC_ACQUIRE, "agent");
            asm volatile("s_waitcnt vmcnt(0)" ::: "memory");
        }
    }
    __syncthreads();
}

__global__ void __launch_bounds__(512, 2) mega_fwd(Args a) {
    extern __shared__ __attribute__((aligned(16))) unsigned char lds_raw[];
    LAS unsigned char* lds = (LAS unsigned char*)lds_raw;
    cg::grid_group grid = cg::this_grid();
    const int G = gridDim.x; const int bx = blockIdx.x;
    const int vcu = (G % 8 == 0) ? (bx % 8) * (G / 8) + bx / 8 : bx;
    unsigned char* ws = wsp(a);
    const float* MOD = (const float*)(ws + WS_MOD);
    bf16_t* HB = (bf16_t*)(ws + WS_H); bf16_t* UB = (bf16_t*)(ws + WS_U); bf16_t* OB = (bf16_t*)(ws + WS_O); float* XB = (float*)(ws + WS_X);
    volatile LAS unsigned* bst = (volatile LAS unsigned*)(lds + 131072);
    if (threadIdx.x < 2) bst[threadIdx.x] = 0u;
    __syncthreads();
    const XcdBarrier xbar = xcd_barrier_post((unsigned*)(wsp(a) + WS_BAR), bst);
    int ph = 0;
#define GSYNC() do { if (ph == 0) grid.sync(); else xcd_barrier(xbar); } while (0)
#ifndef DUP_MASK
#define DUP_MASK 0
#endif
#ifndef XSYNC
#define XSYNC 1
#endif
#define RUN(...) do { if (ph >= a.ph_lo && ph < a.ph_hi) { __VA_ARGS__; if (ph + 1 < a.ph_hi) GSYNC(); } ++ph; } while (0)
#define RUND(bit, ...) do { if (ph >= a.ph_lo && ph < a.ph_hi) { int nrep_ = (DUP_MASK & (bit)) ? 2 : 1; asm volatile("" : "+s"(nrep_)); for (int rep_ = 0; rep_ < nrep_; ++rep_) { __VA_ARGS__; if (rep_ + 1 < nrep_ || ph + 1 < a.ph_hi) { GSYNC(); if (XSYNC) { xcd_barrier(xbar); xcd_barrier(xbar); } } } } ++ph; } while (0)

#ifndef PH_MASK
#define PH_MASK 0xff
#endif
    RUND(1, if (PH_MASK & 1) prologue_phase(a, lds, vcu, G));
    RUN({ bias_phase(a, lds, G); norm_phase(a, inp(a, 12), MOD, vcu, G); });
    const float* RSS = (const float*)(ws + WS_ROWSS); const float* BIASV = (const float*)(ws + WS_BIASV);
    for (int l = 0; l < 4; ++l) {
        const float* modl = MOD + (size_t)l * 9 * 9216;
        for (int half = 0; half < 2; ++half) {
            const int sub = half ? 2 : 0, lf = l * 2 + half;
            RUND(4, if (PH_MASK & 4) { pg8::Gemm g{HB, (const bf16_t*)(ws + WS_W13T) + (size_t)lf * 5632 * 1024, MROWS, 5632, 1024}; pg8::StaticOrder S; S.init(MROWS, 5632, G, bx);
                  EpiSwiGLU E{UB, RSS + (size_t)(l * 3 + sub) * MROWS, BIASV + (size_t)(l * 3 + sub) * 9 * 5632}; pg8::gemm_phase<EpiSwiGLU, pg8::StaticOrder, true, true>(lds, g, S, E); });
            RUN(if (PH_MASK & 8) { const bf16_t* W2 = (const bf16_t*)(ws + WS_W2T) + (size_t)lf * 1024 * DFF;
                  const int nl = half ? l + 1 : l, ns = half ? 0 : 1; const bool has = nl < 4;
                  EpiResid E{XB, modl + (3 * sub + 2) * 1024, 0.5f, has ? HB : nullptr, inp(a, 12) + (size_t)((has ? nl : 0) * 3 + ns) * DM,
                             MOD + (size_t)(has ? nl : 0) * 9 * 9216 + (3 * ns + 1) * 1024, (float*)(ws + WS_ROWSS) + (size_t)((has ? nl : 0) * 3 + ns) * MROWS, 0, 2};
                  { pg8::Gemm g{UB, W2, NLAT, 1024, DFF}; pg8::StaticOrder S; S.init(NLAT, 1024, G, bx);
                    pg8::gemm_phase<EpiResid, pg8::StaticOrder, true, true>(lds, g, S, E); }
                  for (int c = bx; c < 128; c += G) {
                      const int t = c >> 1, hf = c & 1;
                      pg8::Gemm g{UB + (size_t)hf * 128 * DFF, W2, MROWS, 1024, DFF};
                      OneUnit S1{64 + (t >> 2), t & 3};
                      EpiResid E2 = E; E2.roff = hf * 128; E2.nai = 1;
                      pg8::gemm_phase<EpiResid, OneUnit, true, true, true>(lds, g, S1, E2);
                  } });
            if (half == 0) {
                const int eo = l >> 1; const bool even = (l & 1) == 0;
                RUND(16, if (PH_MASK & 16) { const int nq = even ? NQ_E : NQ_O;
                      pg8::Gemm g{HB, even ? (const bf16_t*)(ws + WS_WINAB) + (size_t)eo * NQ_E * 1024 : (const bf16_t*)(ws + WS_WINC) + (size_t)eo * NQ_O * 1024, MROWS, nq, 1024};
                      pg8::StaticOrder S; S.init(MROWS, nq, G, bx);
                      EpiQKV E{UB, nq, even ? 1 : 0, eo, inp(a, 18) + eo * 64, inp(a, 19) + eo * 64, (const f32x2*)(ws + WS_ROPE), outp(a), RSS + (size_t)(l * 3 + 1) * MROWS, BIASV + (size_t)(l * 3 + 1) * 9 * 5632};
                      pg8::gemm_phase<EpiQKV, pg8::StaticOrder, true, true>(lds, g, S, E); });
                RUND(32, { if (even) { if (PH_MASK & 32) attn_even_phase(a, lds, eo, vcu, G); } else if (PH_MASK & 64) attn_odd_phase(a, lds, eo, l == 1 ? 0.35550906759096926f : 0.5560582041556405f, vcu, G); });
                RUN(if (PH_MASK & 8) { const bf16_t* WO = even ? (const bf16_t*)(ws + WS_WOUTAB) + (size_t)eo * 1024 * 1024 : (const bf16_t*)(ws + WS_WOUTC) + (size_t)eo * 1024 * 1024;
                      EpiResid E{XB, modl + 5 * 1024, 1.0f, HB, inp(a, 12) + (size_t)(l * 3 + 2) * DM, modl + 7 * 1024, (float*)(ws + WS_ROWSS) + (size_t)(l * 3 + 2) * MROWS, 0, 2};
                      { pg8::Gemm g{OB, WO, NLAT, 1024, 1024}; pg8::StaticOrder S; S.init(NLAT, 1024, G, bx);
                        pg8::gemm_phase<EpiResid, pg8::StaticOrder, true, true>(lds, g, S, E); }
                      for (int c = bx; c < 128; c += G) {
                          const int t = c >> 1, hf = c & 1;
                          pg8::Gemm g{OB + (size_t)hf * 128 * 1024, WO, MROWS, 1024, 1024};
                          OneUnit S1{64 + (t >> 2), t & 3};
                          EpiResid E2 = E; E2.roff = hf * 128; E2.nai = 1;
                          pg8::gemm_phase<EpiResid, OneUnit, true, true, true>(lds, g, S1, E2);
                      } });
            }
        }
    }
    RUN(if (PH_MASK & 2) final_norm_phase(a, vcu, G));
#undef RUN
#undef RUND
}

extern "C" void kernel_launch(void* const* d_in, const int* in_sizes, int n_in, void* d_out, int out_size, void* d_ws, size_t ws_size, hipStream_t stream) {
    static int grid = 0;
    if (grid == 0) {
        int dev = 0, cus = 0, per_cu = 0;
        hipGetDevice(&dev);
        hipDeviceGetAttribute(&cus, hipDeviceAttributeMultiprocessorCount, dev);
        hipFuncSetAttribute((const void*)mega_fwd, hipFuncAttributeMaxDynamicSharedMemorySize, LDS_BYTES);
        hipOccupancyMaxActiveBlocksPerMultiprocessor(&per_cu, (const void*)mega_fwd, 512, LDS_BYTES);
        if (per_cu < 1) per_cu = 1;
        if (per_cu > 1) per_cu = 1;
        grid = cus * per_cu;
        if (n_in != 26 || ws_size < WS_END) { fprintf(stderr, "kernel_launch: unexpected n_in %d / ws %zu\n", n_in, ws_size); }
    }
    hipMemsetAsync((unsigned char*)d_ws + WS_BAR, 0, WS_BAR_BYTES, stream);
    Args a{};
    for (int i = 0; i < 26; ++i) a.in[i] = (const float*)d_in[i];
    a.out = (float*)d_out; a.ws = (unsigned char*)d_ws; a.ph_lo = 0; a.ph_hi = 1000;
    void* args[] = {&a};
    hipError_t e = hipLaunchCooperativeKernel((const void*)mega_fwd, dim3(grid), dim3(512), args, LDS_BYTES, stream);
    if (e != hipSuccess) fprintf(stderr, "cooperative launch failed: %s (grid %d)\n", hipGetErrorString(e), grid);
}
```

```cpp
#define DUP_MASK 0
#define XSYNC 0
#define SPLIT_PROBE 0
#define TPROBE 0
#include <hip/hip_runtime.h>
#include <hip/hip_cooperative_groups.h>
#include <cstdio>
#include <cstdint>
namespace cg = cooperative_groups;
__device__ __forceinline__ int opaque_tid() { int t = threadIdx.x; asm volatile("" : "+v"(t)); return t; }
namespace pg8 {
#define PG8_LAS __attribute__((address_space(3)))
typedef unsigned short bf16_t;
typedef short bf16x8 __attribute__((ext_vector_type(8)));
typedef float f32x4 __attribute__((ext_vector_type(4)));
typedef unsigned u32x4 __attribute__((ext_vector_type(4)));
constexpr int BM = 256, BK = 64, HALF = 128, HTB = HALF * BK * 2  , STAGE_BYTES = 8 * HTB, NXCD = 8, WGM = 8;

__host__ __device__ __forceinline__ int lds_byte(int r, int c) { const int st = (r >> 4) * 2 + (c >> 5), rr = r & 15, cc = c & 31, ob = rr * 64 + cc * 2; return st * 1024 + (ob ^ (((ob >> 9) & 1) << 5)); }
__host__ __device__ __forceinline__ void stage_rc(int b, int& R, int& C) { const int st = b / 1024, sb = b % 1024, swz = sb ^ (((sb >> 9) & 1) << 5); R = (st >> 1) * 16 + swz / 64; C = (st & 1) * 32 + (swz % 64) / 2; }
__host__ __device__ __forceinline__ int perm32(int rho) { const int n = rho >> 4, i = rho & 15; return 8 * (i >> 2) + 4 * n + (i & 3); }

struct Unit { int pm, pn; };
struct Gemm { const bf16_t* A; const bf16_t* Bt; int M, N, K; };

struct StaticOrder {
    int nM, nN, nwg, G, c;
    __host__ __device__ void init(int M, int N, int G_, int c_) { nM = M / BM; nN = N / BM; nwg = nM * nN; G = G_; c = c_; }
    __host__ __device__ bool next(int i, Unit& u) const {
        const long L = (long)i * G + c; if (L >= nwg) return false;
        int wgid = (int)L; { const int q = nwg / NXCD, r = nwg % NXCD, xcd = wgid % NXCD, off = wgid / NXCD; wgid = (xcd < r ? xcd * (q + 1) : r * (q + 1) + (xcd - r) * q) + off; }
        const int nig = WGM * nN, gid = wgid / nig, fm = gid * WGM, gsz = (nM - fm) < WGM ? (nM - fm) : WGM;
        u.pm = fm + ((wgid % nig) % gsz); u.pn = (wgid % nig) / gsz; return true;
    }
    __device__ __forceinline__ void a_ready(const Unit&) const {}
    __device__ __forceinline__ void done(const Unit&) const {}
};

template <class Epi, class Sched, bool ALIGN_EPI = false, bool SP2 = false, bool HALFM = false>
__device__ __forceinline__ void gemm_phase(PG8_LAS unsigned char* lds, const Gemm g, const Sched& S, const Epi& E) {
    const int tid = opaque_tid(), wid = __builtin_amdgcn_readfirstlane(tid >> 6), lane = tid & 63, wr = wid >> 2, wc = wid & 3, fr = lane & 15, fq = lane >> 4;
    const int K = g.K, nt = K / BK;
    unsigned voffA[2], voffB[2];
#pragma unroll
    for (int i = 0; i < 2; ++i) { int R, C; stage_rc(tid * 16 + i * 8192, R, C); const int Rb = Epi::PERM ? ((R & ~31) + perm32(R & 31)) : R;
        voffA[i] = (unsigned)(R * K + C) * 2u; voffB[i] = (unsigned)(Rb * K + C) * 2u; }
    const size_t kstep = (size_t)(BK * 2);
    const size_t hstep = (size_t)HALF * K * 2;
    const size_t tstep = 2 * hstep;
    const unsigned ldsw = (unsigned)wid * 1024u;
    const int aoff = lds_byte(wr * 64 + fr, fq * 8), boff = lds_byte(wc * 32 + fr, fq * 8);
#define PG8_SA(b, h) (((b) * 2 + (h)) * HTB)
#define PG8_SB(b, h) ((4 + (b) * 2 + (h)) * HTB)
#define PG8_STAGE(bufoff, gbase, voff) do { _Pragma("unroll") for (int _i = 0; _i < 2; ++_i) \
        __builtin_amdgcn_global_load_lds((const unsigned*)((const char*)(gbase) + (voff)[_i]), (PG8_LAS unsigned*)(lds + (bufoff) + ldsw + _i * 8192), 16, 0, 0); } while (0)
#define PG8_LDA(dst, b, h) do { _Pragma("unroll") for (int m = 0; m < 4; ++m) _Pragma("unroll") for (int k = 0; k < 2; ++k) dst[m][k] = *(const PG8_LAS bf16x8*)(lds + PG8_SA(b, h) + aoff + m * 2048 + k * 1024); } while (0)
#define PG8_LDB(dst, b, h) do { _Pragma("unroll") for (int n = 0; n < 2; ++n) _Pragma("unroll") for (int k = 0; k < 2; ++k) dst[n][k] = *(const PG8_LAS bf16x8*)(lds + PG8_SB(b, h) + boff + n * 2048 + k * 1024); } while (0)
#define PG8_MMA(ai, bj, At, Bt) do { if (HALFM && (ai) == 1) break; __builtin_amdgcn_s_setprio(1); _Pragma("unroll") for (int m = 0; m < 4; ++m) _Pragma("unroll") for (int n = 0; n < 2; ++n) _Pragma("unroll") for (int k = 0; k < 2; ++k) \
        acc[ai][bj][m][n] = __builtin_amdgcn_mfma_f32_16x16x32_bf16(Bt[n][k], At[m][k], acc[ai][bj][m][n], 0, 0, 0); __builtin_amdgcn_s_setprio(0); } while (0)
#define PG8_WAIT_V(n) asm volatile("s_waitcnt vmcnt(" #n ")" ::: "memory")
#define PG8_WAIT_L(n) asm volatile("s_waitcnt lgkmcnt(" #n ")" ::: "memory")
#define PG8_BAR __builtin_amdgcn_s_barrier()
#define PG8_SCHED __builtin_amdgcn_sched_barrier(0)
    Unit cur, nxt; int ui = 0;
    if (!S.next(0, cur)) return;
    f32x4 acc[2][2][4][2];
#pragma unroll
    for (int a = 0; a < 2; ++a)
#pragma unroll
        for (int b = 0; b < 2; ++b)
#pragma unroll
            for (int m = 0; m < 4; ++m)
#pragma unroll
                for (int n = 0; n < 2; ++n) acc[a][b][m][n] = (f32x4){0.f, 0.f, 0.f, 0.f};
    bf16x8 At[4][2], B0[2][2], B1[2][2];
    const char* cA = (const char*)g.A + (size_t)cur.pm * tstep; const char* cB = (const char*)g.Bt + (size_t)cur.pn * tstep;
    S.a_ready(cur);
    if constexpr (SP2) {
        PG8_STAGE(PG8_SB(0, 0), cB, voffB); PG8_STAGE(PG8_SB(0, 1), cB + hstep, voffB); PG8_STAGE(PG8_SA(0, 0), cA, voffA); PG8_STAGE(PG8_SA(0, 1), cA + hstep, voffA);
        if (wr == 1) PG8_BAR;
        PG8_WAIT_V(2); PG8_BAR;
        PG8_STAGE(PG8_SB(1, 0), cB + kstep, voffB); PG8_STAGE(PG8_SA(1, 0), cA + kstep, voffA); PG8_STAGE(PG8_SB(1, 1), cB + hstep + kstep, voffB);
        PG8_WAIT_V(6); PG8_BAR;
    } else {
        PG8_STAGE(PG8_SB(0, 0), cB, voffB); PG8_STAGE(PG8_SA(0, 0), cA, voffA); PG8_STAGE(PG8_SB(0, 1), cB + hstep, voffB); PG8_STAGE(PG8_SA(0, 1), cA + hstep, voffA);
        if (wr == 1) PG8_BAR;
        PG8_WAIT_V(4); PG8_BAR;
        PG8_STAGE(PG8_SB(1, 0), cB + kstep, voffB); PG8_STAGE(PG8_SA(1, 0), cA + kstep, voffA); PG8_STAGE(PG8_SB(1, 1), cB + hstep + kstep, voffB);
        PG8_WAIT_V(6); PG8_BAR;
    }
    for (;;) {
        const bool has_next = S.next(ui + 1, nxt);
        const char* nA = has_next ? (const char*)g.A + (size_t)nxt.pm * tstep : cA; const char* nB = has_next ? (const char*)g.Bt + (size_t)nxt.pn * tstep : cB;
        for (int t = 0; t < nt; t += 2) {
            const bool last = (t == nt - 2);
            const char* a1 = cA + (size_t)(t + 1) * kstep;
            const char* a2 = last ? nA : cA + (size_t)(t + 2) * kstep; const char* b2 = last ? nB : cB + (size_t)(t + 2) * kstep;
            const char* a3 = a2 + kstep; const char* b3 = b2 + kstep;
            if (last && has_next) S.a_ready(nxt);
            if constexpr (SP2) {
            PG8_LDB(B0, 0, 0); PG8_LDB(B1, 0, 1); PG8_SCHED; PG8_LDA(At, 0, 0); PG8_STAGE(PG8_SA(1, 1), a1 + hstep, voffA);
            PG8_WAIT_V(8); PG8_WAIT_L(0); PG8_BAR; PG8_MMA(0, 0, At, B0); PG8_MMA(0, 1, At, B1); PG8_BAR; PG8_SCHED;
            PG8_LDA(At, 0, 1); PG8_STAGE(PG8_SB(0, 0), b2, voffB); PG8_STAGE(PG8_SB(0, 1), b2 + hstep, voffB); PG8_STAGE(PG8_SA(0, 0), a2, voffA);
            PG8_WAIT_V(8); PG8_WAIT_L(0); PG8_BAR; PG8_MMA(1, 0, At, B0); PG8_MMA(1, 1, At, B1); PG8_BAR; PG8_SCHED;
            PG8_LDB(B0, 1, 0); PG8_LDB(B1, 1, 1); PG8_SCHED; PG8_LDA(At, 1, 0); PG8_STAGE(PG8_SA(0, 1), a2 + hstep, voffA);
            PG8_WAIT_V(8); PG8_WAIT_L(0); PG8_BAR; PG8_MMA(0, 0, At, B0); PG8_MMA(0, 1, At, B1); PG8_BAR; PG8_SCHED;
            PG8_LDA(At, 1, 1); PG8_STAGE(PG8_SB(1, 0), b3, voffB); PG8_STAGE(PG8_SB(1, 1), b3 + hstep, voffB); PG8_STAGE(PG8_SA(1, 0), a3, voffA);
            PG8_WAIT_V(8); PG8_WAIT_L(0); PG8_BAR; PG8_MMA(1, 0, At, B0); PG8_MMA(1, 1, At, B1); PG8_BAR; PG8_SCHED;
            } else {
            PG8_LDB(B0, 0, 0); PG8_SCHED; PG8_LDA(At, 0, 0); PG8_STAGE(PG8_SA(1, 1), a1 + hstep, voffA);
            PG8_WAIT_L(8); PG8_BAR; PG8_WAIT_L(0); PG8_MMA(0, 0, At, B0); PG8_BAR; PG8_SCHED;
            PG8_LDB(B1, 0, 1); PG8_STAGE(PG8_SB(0, 0), b2, voffB);
            PG8_BAR; PG8_WAIT_L(0); PG8_MMA(0, 1, At, B1); PG8_BAR;
            PG8_LDA(At, 0, 1); PG8_STAGE(PG8_SA(0, 0), a2, voffA);
            PG8_BAR; PG8_WAIT_L(0); PG8_MMA(1, 0, At, B0); PG8_BAR; PG8_SCHED;
            PG8_STAGE(PG8_SB(0, 1), b2 + hstep, voffB);
            PG8_WAIT_V(6); PG8_BAR; PG8_MMA(1, 1, At, B1); PG8_BAR;
            PG8_LDB(B0, 1, 0); PG8_SCHED; PG8_LDA(At, 1, 0); PG8_STAGE(PG8_SA(0, 1), a2 + hstep, voffA);
            PG8_WAIT_L(8); PG8_BAR; PG8_WAIT_L(0); PG8_MMA(0, 0, At, B0); PG8_BAR; PG8_SCHED;
            PG8_LDB(B1, 1, 1); PG8_STAGE(PG8_SB(1, 0), b3, voffB);
            PG8_BAR; PG8_WAIT_L(0); PG8_MMA(0, 1, At, B1); PG8_BAR;
            PG8_LDA(At, 1, 1); PG8_STAGE(PG8_SA(1, 0), a3, voffA);
            PG8_BAR; PG8_WAIT_L(0); PG8_MMA(1, 0, At, B0); PG8_BAR; PG8_SCHED;
            PG8_STAGE(PG8_SB(1, 1), b3 + hstep, voffB);
            PG8_WAIT_V(6); PG8_BAR; PG8_MMA(1, 1, At, B1); PG8_BAR;
            }
        }
        if constexpr (ALIGN_EPI) { if (wr == 0) PG8_BAR; }
        if constexpr (!Epi::AFTER_DRAIN) { E(acc, cur, wr, wc, fr, fq); S.done(cur); }
        if (!has_next) break;
#pragma unroll
        for (int a = 0; a < 2; ++a)
#pragma unroll
            for (int b = 0; b < 2; ++b)
#pragma unroll
                for (int m = 0; m < 4; ++m)
#pragma unroll
                    for (int n = 0; n < 2; ++n) acc[a][b][m][n] = (f32x4){0.f, 0.f, 0.f, 0.f};
        cur = nxt; cA = nA; cB = nB; ++ui;
        if constexpr (ALIGN_EPI) { if (wr == 1) PG8_BAR; }
    }
    PG8_WAIT_V(0);
    if constexpr (!ALIGN_EPI) { if (wr == 0) PG8_BAR; }
    PG8_BAR;
    if constexpr (Epi::AFTER_DRAIN) { E.fused(acc, cur, wr, wc, fr, fq, lds, wid, lane); S.done(cur); }
#undef PG8_SA
#undef PG8_SB
#undef PG8_STAGE
#undef PG8_LDA
#undef PG8_LDB
#undef PG8_MMA
#undef PG8_WAIT_V
#undef PG8_WAIT_L
#undef PG8_BAR
#undef PG8_SCHED
}
}

#define LAS __attribute__((address_space(3)))
typedef unsigned short bf16_t;
typedef short bf16x8 __attribute__((ext_vector_type(8)));
typedef short s16x4 __attribute__((ext_vector_type(4)));
typedef float f32x4 __attribute__((ext_vector_type(4)));
typedef float f32x2 __attribute__((ext_vector_type(2)));
typedef float f32x16 __attribute__((ext_vector_type(16)));
typedef unsigned u32x4 __attribute__((ext_vector_type(4)));
typedef unsigned u32x2 __attribute__((ext_vector_type(2)));
typedef __bf16 bf16x2_t __attribute__((ext_vector_type(2)));

constexpr int DM = 1024, NLAT = 16384, NCTX = 4096, MROWS = 20480, DFF = 2816;
constexpr int NQ_E = 2304, NQ_O = 3072;
constexpr float EPS = 1e-6f;
constexpr float LOG2E = 1.4426950408889634f;
constexpr float SCL2 = 0.125f * LOG2E;

constexpr size_t MiB = 1u << 20;
constexpr size_t WS_BAR = 65536, WS_BAR_BYTES = 16384;
constexpr size_t WS_ROPE = 4096;
constexpr size_t WS_MOD = 1 * MiB;
constexpr size_t WS_W13T = 4 * MiB;
constexpr size_t WS_W2T = 92 * MiB;
constexpr size_t WS_WINAB = 136 * MiB;
constexpr size_t WS_WOUTAB = 145 * MiB;
constexpr size_t WS_WINC = 149 * MiB;
constexpr size_t WS_WOUTC = 161 * MiB;
constexpr size_t WS_CAK = 165 * MiB, WS_CAV = 167 * MiB, WS_CBK = 169 * MiB, WS_CBV = 177 * MiB, WS_CCK = 185 * MiB, WS_CCV = 201 * MiB;
constexpr size_t WS_X = 217 * MiB;
constexpr size_t WS_H = 297 * MiB;
constexpr size_t WS_O = 337 * MiB;
constexpr size_t WS_U = 377 * MiB;
constexpr size_t WS_ROWSS = 3 * MiB;
constexpr size_t WS_BIASV = 497 * MiB;
constexpr size_t WS_END = 500 * MiB;

constexpr size_t OUT_YP = 0, OUT_YS = 4194304, OUT_AK = 20971520, OUT_AV = 22020096, OUT_BK = 23068672, OUT_BV = 27262976, OUT_CK = 31457280, OUT_CV = 39845888;

constexpr int LDS_BYTES = 131072 + 1024;

__device__ __forceinline__ unsigned pk2(float lo, float hi) { f32x2 v = {lo, hi}; bf16x2_t b = __builtin_convertvector(v, bf16x2_t); return __builtin_bit_cast(unsigned, b); }
__device__ __forceinline__ float wave_sum(float v) {
#pragma unroll
    for (int o = 1; o < 64; o <<= 1) v += __shfl_xor(v, o);
    return v;
}
__device__ __forceinline__ float fast_exp2(float x) { return __builtin_amdgcn_exp2f(x); }
__device__ __forceinline__ float fast_rcp(float x) { return __builtin_amdgcn_rcpf(x); }

struct Args { const float* in[26]; float* out; unsigned char* ws; int ph_lo, ph_hi; };
#define GAS __attribute__((address_space(1)))
__device__ __forceinline__ const float* inp(const Args& a, int i) { asm volatile("" : "+s"(i)); GAS const float* g = (GAS const float*)a.in[i]; return (const float*)g; }
__device__ __forceinline__ unsigned char* wsp(const Args& a) { GAS unsigned char* g = (GAS unsigned char*)a.ws; asm volatile("" : "+s"(g)); return (unsigned char*)g; }
__device__ __forceinline__ float* outp(const Args& a) { GAS float* g = (GAS float*)a.out; return (float*)g; }

struct EpiSwiGLU {
    static constexpr bool PERM = true, AFTER_DRAIN = false;
    bf16_t* U; const float* rowss; const float* bias;
    __device__ __forceinline__ void operator()(const f32x4 (&acc)[2][2][4][2], const pg8::Unit& u, int wr, int wc, int fr, int fq) const {
        const int row0 = u.pm * 256 + wr * 64 + fr, col0 = u.pn * 128 + wc * 32 + 8 * fq;
        const int mi = u.pm < 64 ? (u.pm >> 3) : 8;
        const float* bp = bias + (size_t)mi * 5632 + u.pn * 256 + wc * 32 + 8 * fq;
        f32x4 b4[2][2];
#pragma unroll
        for (int bj = 0; bj < 2; ++bj)
#pragma unroll
            for (int n = 0; n < 2; ++n) b4[bj][n] = *(const f32x4*)(bp + bj * 128 + 4 * n);
#pragma unroll
        for (int ai = 0; ai < 2; ++ai)
#pragma unroll
            for (int m = 0; m < 4; ++m) {
                const int row = row0 + ai * 128 + m * 16;
                const float rstd = rsqrtf(rowss[row] * (1.f / DM) + EPS);
                bf16_t* rowp = U + (size_t)row * DFF + col0;
                float o[8];
#pragma unroll
                for (int n = 0; n < 2; ++n)
#pragma unroll
                    for (int i = 0; i < 4; ++i) { const float a = acc[ai][0][m][n][i] * rstd + b4[0][n][i], b = acc[ai][1][m][n][i] * rstd + b4[1][n][i];
                        o[n * 4 + i] = a * fast_rcp(1.f + fast_exp2(-a * LOG2E)) * b; }
                u32x4 w; w.x = pk2(o[0], o[1]); w.y = pk2(o[2], o[3]); w.z = pk2(o[4], o[5]); w.w = pk2(o[6], o[7]);
                *(u32x4*)rowp = w;
            }
    }
};
struct EpiResid {
    static constexpr bool PERM = true, AFTER_DRAIN = false;
    float* x; const float* gate; float coef;
    bf16_t* hb; const float* fnw; const float* fscale; float* rowss;
    int roff, nai;
    __device__ __forceinline__ void operator()(const f32x4 (&acc)[2][2][4][2], const pg8::Unit& u, int wr, int wc, int fr, int fq) const {
        const int mi = u.pm < 64 ? (u.pm >> 3) : 8;
        const int col0 = u.pn * 256 + wc * 32 + 8 * fq;
        const float* g = gate + (size_t)mi * 9216 + col0;
        const float* fs = fscale + (size_t)mi * 9216 + col0;
        const float* fw = fnw + col0;
#pragma unroll
        for (int ai = 0; ai < 2; ++ai) {
            if (ai >= nai) break;
#pragma unroll
            for (int m = 0; m < 4; ++m) {
                const int row = u.pm * 256 + roff + ai * 128 + wr * 64 + m * 16 + fr;
                float* p = x + (size_t)row * DM + col0;
                float ss = 0.f;
#pragma unroll
                for (int bj = 0; bj < 2; ++bj) {
                    f32x4 xv[2];
#pragma unroll
                    for (int n = 0; n < 2; ++n) {
                        const f32x4 g4 = *(const f32x4*)(g + bj * 128 + 4 * n) * coef;
                        xv[n] = *(const f32x4*)(p + bj * 128 + 4 * n) + g4 * acc[ai][bj][m][n];
                        *(f32x4*)(p + bj * 128 + 4 * n) = xv[n];
                        ss += (xv[n][0] * xv[n][0] + xv[n][1] * xv[n][1]) + (xv[n][2] * xv[n][2] + xv[n][3] * xv[n][3]);
                    }
                    if (hb) {
#pragma unroll
                        for (int n = 0; n < 2; ++n) xv[n] = xv[n] * (*(const f32x4*)(fw + bj * 128 + 4 * n)) * (1.f + *(const f32x4*)(fs + bj * 128 + 4 * n));
                        u32x4 w; w.x = pk2(xv[0][0], xv[0][1]); w.y = pk2(xv[0][2], xv[0][3]); w.z = pk2(xv[1][0], xv[1][1]); w.w = pk2(xv[1][2], xv[1][3]);
                        *(u32x4*)(hb + (size_t)row * DM + col0 + bj * 128) = w;
                    }
                }
                if (hb) {
                    ss += __shfl_xor(ss, 16); ss += __shfl_xor(ss, 32);
                    if (fq == 0) unsafeAtomicAdd(rowss + row, ss);
                }
                asm volatile("" ::: "memory");
            }
        }
    }
};
__device__ __forceinline__ void small_gemm_resid(LAS unsigned char* lds, const bf16_t* A, const bf16_t* Wt, const int K, const int c, const EpiResid& E) {
    const int tid = opaque_tid(), lane = tid & 63, wid = __builtin_amdgcn_readfirstlane(tid >> 6), wr = wid >> 2, wc = wid & 3, fr = lane & 15, fq = lane >> 4;
    const int tm = c >> 3, tn = c & 7;
    const char* Ag = (const char*)(A + (size_t)(NLAT + tm * 128) * K);
    const char* Bg = (const char*)(Wt + (size_t)(tn * 128) * K);
    const int nt = K >> 6;
    unsigned voff[2];
#pragma unroll
    for (int i = 0; i < 2; ++i) { int R, C; pg8::stage_rc(tid * 16 + i * 8192, R, C); voff[i] = (unsigned)(R * K + C) * 2u; }
    const unsigned ldsw = (unsigned)wid * 1024u;
    const int aoff = pg8::lds_byte(wr * 64 + fr, fq * 8), boff = pg8::lds_byte(wc * 32 + fr, fq * 8);
#define SG_STAGE(slot_, kt_) do { _Pragma("unroll") for (int i_ = 0; i_ < 2; ++i_) { \
        __builtin_amdgcn_global_load_lds((const unsigned*)(Ag + (size_t)(kt_) * 128 + voff[i_]), (LAS unsigned*)(lds + (slot_) * 32768 + ldsw + i_ * 8192), 16, 0, 0); \
        __builtin_amdgcn_global_load_lds((const unsigned*)(Bg + (size_t)(kt_) * 128 + voff[i_]), (LAS unsigned*)(lds + (slot_) * 32768 + 16384 + ldsw + i_ * 8192), 16, 0, 0); } } while (0)
    f32x4 acc[4][2];
#pragma unroll
    for (int m = 0; m < 4; ++m)
#pragma unroll
        for (int n = 0; n < 2; ++n) acc[m][n] = (f32x4){0.f, 0.f, 0.f, 0.f};
    SG_STAGE(0, 0);
    if (nt > 1) SG_STAGE(1, 1);
    int slot = 0;
    for (int kt = 0; kt < nt; ++kt) {
        if (kt + 1 < nt) asm volatile("s_waitcnt vmcnt(4)" ::: "memory"); else asm volatile("s_waitcnt vmcnt(0)" ::: "memory");
        __builtin_amdgcn_s_barrier(); asm volatile("" ::: "memory");
        const int s2 = slot >= 1 ? slot - 1 : 2;
        if (kt + 2 < nt) SG_STAGE(s2, kt + 2);
        const LAS unsigned char* base = lds + slot * 32768;
        bf16x8 At[4][2], Bt[2][2];
#pragma unroll
        for (int n = 0; n < 2; ++n)
#pragma unroll
            for (int k = 0; k < 2; ++k) Bt[n][k] = *(const LAS bf16x8*)(base + 16384 + boff + n * 2048 + k * 1024);
#pragma unroll
        for (int m = 0; m < 4; ++m)
#pragma unroll
            for (int k = 0; k < 2; ++k) At[m][k] = *(const LAS bf16x8*)(base + aoff + m * 2048 + k * 1024);
#pragma unroll
        for (int m = 0; m < 4; ++m)
#pragma unroll
            for (int n = 0; n < 2; ++n)
#pragma unroll
                for (int k = 0; k < 2; ++k) acc[m][n] = __builtin_amdgcn_mfma_f32_16x16x32_bf16(Bt[n][k], At[m][k], acc[m][n], 0, 0, 0);
        asm volatile("s_waitcnt lgkmcnt(0)" ::: "memory");
        slot = slot == 2 ? 0 : slot + 1;
    }
#undef SG_STAGE
    asm volatile("s_waitcnt vmcnt(0)" ::: "memory"); __builtin_amdgcn_s_barrier(); asm volatile("" ::: "memory");
    const float* g = E.gate + (size_t)8 * 9216; const float* fs = E.fscale + (size_t)8 * 9216;
#pragma unroll
    for (int m = 0; m < 4; ++m) {
        const int row = NLAT + tm * 128 + 64 * wr + 16 * m + fr;
        float ss = 0.f;
#pragma unroll
        for (int n = 0; n < 2; ++n) {
            const int col = tn * 128 + 32 * wc + 16 * n + 4 * fq;
            float* p = E.x + (size_t)row * DM + col;
            f32x4 xv = *(const f32x4*)p + (*(const f32x4*)(g + col) * E.coef) * acc[m][n];
            *(f32x4*)p = xv;
            ss += (xv[0] * xv[0] + xv[1] * xv[1]) + (xv[2] * xv[2] + xv[3] * xv[3]);
            if (E.hb) {
                xv = xv * (*(const f32x4*)(E.fnw + col)) * (1.f + *(const f32x4*)(fs + col));
                u32x2 w; w.x = pk2(xv[0], xv[1]); w.y = pk2(xv[2], xv[3]);
                *(u32x2*)(E.hb + (size_t)row * DM + col) = w;
            }
        }
        if (E.hb) { ss += __shfl_xor(ss, 16); ss += __shfl_xor(ss, 32); if (fq == 0) unsafeAtomicAdd(E.rowss + row, ss); }
    }
    __syncthreads();
}
struct RangeOrder {
    pg8::StaticOrder S; int lo, hi;
    __device__ __forceinline__ bool next(int i, pg8::Unit& u) const { return (lo + i < hi) && S.next(lo + i, u); }
    __device__ __forceinline__ void a_ready(const pg8::Unit&) const {}
    __device__ __forceinline__ void done(const pg8::Unit&) const {}
};
struct OneUnit {
    int pm, pn;
    __device__ __forceinline__ bool next(int i, pg8::Unit& u) const { if (i) return false; u.pm = pm; u.pn = pn; return true; }
    __device__ __forceinline__ void a_ready(const pg8::Unit&) const {}
    __device__ __forceinline__ void done(const pg8::Unit&) const {}
};
struct EpiQKV {
    static constexpr bool PERM = true, AFTER_DRAIN = false;
    bf16_t* Q; int ldq; int even; int e; const float* qn; const float* kn; const f32x2* rope; float* out; const float* rowss; const float* bias;
    __device__ __forceinline__ void operator()(const f32x4 (&acc)[2][2][4][2], const pg8::Unit& u, int wr, int wc, int fr, int fq) const {
        const int hu = 4 * u.pn + wc;
        const bool lat = u.pm < 64;
        const float* bp = bias + (size_t)(u.pm < 64 ? (u.pm >> 3) : 8) * 5632 + u.pn * 256 + wc * 32 + 8 * fq;
        const int d0 = 8 * fq + 16 * (fq >> 1);
        bool do_rope; const float* nw = nullptr; float* ob = nullptr; int ow = 0;
        const bool isq = even ? (hu < 8 || (hu >= 12 && hu < 20)) : (hu < 16);
        if (even) {
            do_rope = hu < 10;
            if (hu < 8) nw = qn; else if (hu < 10) { nw = kn; ob = out + OUT_AK + 64 * (hu - 8); ow = 128; }
            else if (hu < 12) { ob = out + OUT_AV + 64 * (hu - 10); ow = 128; }
            else if (hu < 20) {}
            else if (hu < 28) { ob = out + OUT_BK + 64 * (hu - 20); ow = 512; }
            else { ob = out + OUT_BV + 64 * (hu - 28); ow = 512; }
        } else {
            do_rope = hu < 32;
            if (hu < 16) {} else if (hu < 32) { ob = out + OUT_CK + 64 * (hu - 16); ow = 1024; }
            else { ob = out + OUT_CV + 64 * (hu - 32); ow = 1024; }
        }
        f32x4 w4[2][2], b4[2][2];
#pragma unroll
        for (int bj = 0; bj < 2; ++bj)
#pragma unroll
            for (int n = 0; n < 2; ++n) { b4[bj][n] = *(const f32x4*)(bp + bj * 128 + 4 * n); if (nw) w4[bj][n] = *(const f32x4*)(nw + d0 + 16 * bj + 4 * n); }
#pragma unroll
        for (int ai = 0; ai < 2; ++ai)
#pragma unroll
            for (int m = 0; m < 4; ++m) {
                const int row = u.pm * 256 + ai * 128 + wr * 64 + m * 16 + fr;
                f32x4 v[2][2];
                const float rstd0 = rsqrtf(rowss[row] * (1.f / DM) + EPS);
#pragma unroll
                for (int bj = 0; bj < 2; ++bj)
#pragma unroll
                    for (int n = 0; n < 2; ++n) v[bj][n] = acc[ai][bj][m][n] * rstd0 + b4[bj][n];
                if (nw) {
                    float ss = 0.f;
#pragma unroll
                    for (int bj = 0; bj < 2; ++bj)
#pragma unroll
                        for (int n = 0; n < 2; ++n) ss += (v[bj][n][0] * v[bj][n][0] + v[bj][n][1] * v[bj][n][1]) + (v[bj][n][2] * v[bj][n][2] + v[bj][n][3] * v[bj][n][3]);
                    ss += __shfl_xor(ss, 16); ss += __shfl_xor(ss, 32);
                    const float rstd = rsqrtf(ss * (1.f / 64.f) + EPS);
#pragma unroll
                    for (int bj = 0; bj < 2; ++bj)
#pragma unroll
                        for (int n = 0; n < 2; ++n) v[bj][n] = v[bj][n] * rstd * w4[bj][n];
                }
                if (do_rope && lat) {
                    const int t = row & 2047;
                    const int pos = (fq < 2) ? (t >> 6) : (t & 63);
                    const f32x2* rp = rope + pos * 16 + 8 * (fq & 1);
#pragma unroll
                    for (int n = 0; n < 2; ++n)
#pragma unroll
                        for (int i = 0; i < 4; ++i) { const f32x2 cs = rp[4 * n + i]; const float x1 = v[0][n][i], x2 = v[1][n][i];
                            v[0][n][i] = x1 * cs.x - x2 * cs.y; v[1][n][i] = x2 * cs.x + x1 * cs.y; }
                }
                bf16_t* qp = Q + (size_t)row * ldq + 64 * hu + d0;
                if (isq) {
#pragma unroll
                    for (int bj = 0; bj < 2; ++bj)
#pragma unroll
                        for (int n = 0; n < 2; ++n) v[bj][n] = v[bj][n] * SCL2;
                }
#pragma unroll
                for (int bj = 0; bj < 2; ++bj) { u32x4 w; w.x = pk2(v[bj][0][0], v[bj][0][1]); w.y = pk2(v[bj][0][2], v[bj][0][3]); w.z = pk2(v[bj][1][0], v[bj][1][1]); w.w = pk2(v[bj][1][2], v[bj][1][3]);
                    *(u32x4*)(qp + 16 * bj) = w; }
                if (ob && !lat) {
                    const int cr = row - NLAT, b = cr >> 8, s = cr & 255;
                    float* op = ob + (size_t)((b * 2 + e) * 256 + s) * ow + d0;
#pragma unroll
                    for (int bj = 0; bj < 2; ++bj)
#pragma unroll
                        for (int n = 0; n < 2; ++n) *(f32x4*)(op + 16 * bj + 4 * n) = v[bj][n];
                }
            }
    }
};

__device__ __forceinline__ void transpose_item(const float* W, int K, int N, bf16_t* WT, int k0, int n0, int drow, LAS float* scr, int lane, int dhi = -1) {
#pragma unroll 8
    for (int i = 0; i < 32; ++i) { const int kk = 2 * i + (lane >> 5); scr[kk * 33 + (lane & 31)] = __builtin_nontemporal_load(W + (size_t)(k0 + kk) * N + n0 + (lane & 31)); }
    asm volatile("s_waitcnt lgkmcnt(0)" ::: "memory");
    const int c = lane & 7;
#pragma unroll
    for (int j = 0; j < 4; ++j) { const int n = (lane >> 3) + 8 * j; const LAS float* s = scr + (8 * c) * 33 + n;
        u32x4 o; o.x = pk2(s[0 * 33], s[1 * 33]); o.y = pk2(s[2 * 33], s[3 * 33]); o.z = pk2(s[4 * 33], s[5 * 33]); o.w = pk2(s[6 * 33], s[7 * 33]);
        const int dr = (n < 16 || dhi < 0) ? drow + n : dhi + n - 16;
        *(u32x4*)(WT + (size_t)dr * K + k0 + 8 * c) = o; }
    asm volatile("s_waitcnt lgkmcnt(0)" ::: "memory");
}
__device__ __forceinline__ int qkv_drow(int n0) { const int hu = n0 >> 6, g = (n0 >> 5) & 1; return 256 * (hu >> 2) + 32 * (hu & 3) + 16 * g; }

__device__ __forceinline__ void cvt_seg(const float* src, bf16_t* dst, int n4, int gt, int NT) {
    for (int i = gt; i < n4; i += NT) { const f32x4 v = __builtin_nontemporal_load((const f32x4*)src + i); u32x2 w; w.x = pk2(v[0], v[1]); w.y = pk2(v[2], v[3]); ((u32x2*)dst)[i] = w; }
}

__device__ __forceinline__ void prologue_phase(const Args& a, LAS unsigned char* lds, int vcu, int G) {
    const int tid = opaque_tid(), lane = tid & 63, wave = __builtin_amdgcn_readfirstlane(tid >> 6);
    unsigned char* ws = wsp(a);
    {
        LAS float* sc = (LAS float*)lds;
        LAS f32x4* red = (LAS f32x4*)(lds + 36864);
        const int first = G - 1 - (int)blockIdx.x;
        if (first < 144) {
            for (int i = tid; i < 9 * 1024; i += 512) { const int r = i >> 10, k = i & 1023; const float cv = r < 8 ? inp(a, 8)[r * 1024 + k] : inp(a, 9)[k]; sc[i] = cv / (1.f + __expf(-cv)); }
            __syncthreads();
            for (int item = first; item < 144; item += G) {
                const int l = item / 36, cb = item % 36, col = cb * 256 + lane * 4;
                const float* wp = inp(a, 10) + ((size_t)l * 1024 + wave * 128) * 9216 + col;
                f32x4 acc[9];
#pragma unroll
                for (int r = 0; r < 9; ++r) acc[r] = (f32x4){0.f, 0.f, 0.f, 0.f};
#pragma unroll 4
                for (int k = 0; k < 128; ++k) {
                    const f32x4 wv = __builtin_nontemporal_load((const f32x4*)(wp + (size_t)k * 9216));
#pragma unroll
                    for (int r = 0; r < 9; ++r) acc[r] += wv * sc[r * 1024 + wave * 128 + k];
                }
#pragma unroll
                for (int r = 0; r < 9; ++r) red[(wave * 9 + r) * 64 + lane] = acc[r];
                __syncthreads();
                for (int o = tid; o < 9 * 64; o += 512) {
                    const int r = o >> 6, ln = o & 63;
                    f32x4 s = *(const f32x4*)(inp(a, 11) + l * 9216 + cb * 256 + ln * 4);
#pragma unroll
                    for (int w = 0; w < 8; ++w) s += red[(w * 9 + r) * 64 + ln];
                    *(f32x4*)((float*)(ws + WS_MOD) + ((size_t)l * 9 + r) * 9216 + cb * 256 + ln * 4) = s;
                }
                __syncthreads();
            }
        }
        __syncthreads();
    }
    {
        LAS float* scr = (LAS float*)(lds + wave * 8704);
        const int gw = vcu * 8 + wave, NGW = G * 8;
        for (int it = gw; it < 41216; it += NGW) {
            if (it < 33792) {
                const int lf = it / 4224, r = it % 4224, which = r / 1408, q = r % 1408;
                if (which < 2) { const int kb = q / 88, nb = q % 88, n0 = 32 * nb; const int drow = 256 * (n0 >> 7) + (n0 & 127) + 128 * which;
                    transpose_item(inp(a, which == 0 ? 13 : 14) + (size_t)lf * 1024 * DFF, 1024, DFF, (bf16_t*)(ws + WS_W13T) + (size_t)lf * 5632 * 1024, 64 * kb, n0, drow, scr, lane); }
                else { const int kb = q / 32, nb = q % 32;
                    transpose_item(inp(a, 15) + (size_t)lf * DFF * 1024, DFF, 1024, (bf16_t*)(ws + WS_W2T) + (size_t)lf * 1024 * DFF, 64 * kb, 32 * nb, 32 * nb, scr, lane); }
            } else {
                int r = it - 33792;
                if (r < 2304) { const int e = r / 1152, q = r % 1152, kb = q / 72, nb = q % 72;
                    transpose_item(inp(a, 16) + (size_t)e * 1024 * NQ_E, 1024, NQ_E, (bf16_t*)(ws + WS_WINAB) + (size_t)e * NQ_E * 1024, 64 * kb, 32 * nb, qkv_drow(32 * nb), scr, lane, qkv_drow(32 * nb) + 128); continue; }
                r -= 2304;
                if (r < 3072) { const int e = r / 1536, q = r % 1536, kb = q / 96, nb = q % 96;
                    transpose_item(inp(a, 21) + (size_t)e * 1024 * NQ_O, 1024, NQ_O, (bf16_t*)(ws + WS_WINC) + (size_t)e * NQ_O * 1024, 64 * kb, 32 * nb, qkv_drow(32 * nb), scr, lane, qkv_drow(32 * nb) + 128); continue; }
                r -= 3072;
                if (r < 1024) { const int e = r / 512, q = r % 512, kb = q / 32, nb = q % 32;
                    transpose_item(inp(a, 17) + (size_t)e * 1024 * 1024, 1024, 1024, (bf16_t*)(ws + WS_WOUTAB) + (size_t)e * 1024 * 1024, 64 * kb, 32 * nb, 32 * nb, scr, lane); continue; }
                r -= 1024;
                { const int e = r / 512, q = r % 512, kb = q / 32, nb = q % 32;
                    transpose_item(inp(a, 22) + (size_t)e * 1024 * 1024, 1024, 1024, (bf16_t*)(ws + WS_WOUTC) + (size_t)e * 1024 * 1024, 64 * kb, 32 * nb, 32 * nb, scr, lane); }
            }
        }
    }
    {
        const int gt = blockIdx.x * 512 + tid, NT = G * 512;
        cvt_seg(inp(a, 2), (bf16_t*)(ws + WS_CAK), 1048576 / 4, gt, NT);
        cvt_seg(inp(a, 3), (bf16_t*)(ws + WS_CAV), 1048576 / 4, gt, NT);
        cvt_seg(inp(a, 4), (bf16_t*)(ws + WS_CBK), 4194304 / 4, gt, NT);
        cvt_seg(inp(a, 5), (bf16_t*)(ws + WS_CBV), 4194304 / 4, gt, NT);
        cvt_seg(inp(a, 6), (bf16_t*)(ws + WS_CCK), 8388608 / 4, gt, NT);
        cvt_seg(inp(a, 7), (bf16_t*)(ws + WS_CCV), 8388608 / 4, gt, NT);
        for (int i = gt; i < 12 * MROWS / 4; i += NT) ((f32x4*)(ws + WS_ROWSS))[i] = (f32x4){0.f, 0.f, 0.f, 0.f};
        if (gt < 1024) { const int pos = gt >> 4, f = gt & 15;
            const float inv = exp2f(-(float)f * (13.287712379549449f / 16.f));
            const float rev = (float)pos * inv * 0.15915494309189535f;
            f32x2 cs; cs.x = __builtin_amdgcn_cosf(rev); cs.y = __builtin_amdgcn_sinf(rev);
            ((f32x2*)(ws + WS_ROPE))[gt] = cs; }
    }
}

__device__ __forceinline__ void norm_phase(const Args& a, const float* nw, const float* modl, int vcu, int G) {
    const int tid = opaque_tid(), lane = tid & 63, wave = tid >> 6;
    float* xb = (float*)(wsp(a) + WS_X); bf16_t* hb = (bf16_t*)(wsp(a) + WS_H); float* rss = (float*)(wsp(a) + WS_ROWSS);
    for (int row = vcu * 8 + wave; row < MROWS; row += G * 8) {
        const float* xr = row < NLAT ? inp(a, 1) + (size_t)row * DM : inp(a, 0) + (size_t)(row - NLAT) * DM;
        f32x4 v[4]; float ss = 0.f;
#pragma unroll
        for (int j = 0; j < 4; ++j) { v[j] = ((const f32x4*)xr)[lane + 64 * j]; ss += (v[j][0] * v[j][0] + v[j][1] * v[j][1]) + (v[j][2] * v[j][2] + v[j][3] * v[j][3]); }
        ss = wave_sum(ss);
        if (lane == 0) rss[row] = ss;
#pragma unroll
        for (int j = 0; j < 4; ++j) ((f32x4*)(xb + (size_t)row * DM))[lane + 64 * j] = v[j];
        const int mi = row < NLAT ? (row >> 11) : 8;
        const float* sc = modl + (size_t)mi * 9216 + 1024;
#pragma unroll
        for (int j = 0; j < 4; ++j) {
            const int c4 = lane + 64 * j;
            const f32x4 o = v[j] * ((const f32x4*)nw)[c4] * (1.f + ((const f32x4*)sc)[c4]);
            u32x2 pw; pw.x = pk2(o[0], o[1]); pw.y = pk2(o[2], o[3]);
            ((u32x2*)(hb + (size_t)row * DM))[c4] = pw;
        }
    }
}
__device__ __forceinline__ void bias_phase(const Args& a, LAS unsigned char* lds, int G) {
    const int tid = opaque_tid(), lane = tid & 63, wave = tid >> 6;
    unsigned char* ws = wsp(a);
    LAS float* sh = (LAS float*)lds;
    int cur_g = -1;
    for (int it = blockIdx.x; it < 872; it += G) {
        int r = it, l = 0, sub = 0, base = 0;
        for (l = 0; l < 4; ++l) { const int nq = (l & 1) ? 48 : 36; const int tot = 176 + nq; if (r < tot) break; r -= tot; }
        { const int nq = (l & 1) ? 48 : 36; if (r < 88) { sub = 0; base = r; } else if (r < 88 + nq) { sub = 1; base = r - 88; } else { sub = 2; base = r - 88 - nq; } }
        const int g = l * 3 + sub;
        const bf16_t* Wt = sub == 1 ? ((l & 1) ? (const bf16_t*)(ws + WS_WINC) + (size_t)(l >> 1) * NQ_O * 1024 : (const bf16_t*)(ws + WS_WINAB) + (size_t)(l >> 1) * NQ_E * 1024)
                                    : (const bf16_t*)(ws + WS_W13T) + (size_t)(l * 2 + (sub >> 1)) * 5632 * 1024;
        if (g != cur_g) {
            __syncthreads();
            const float* modl = (const float*)(ws + WS_MOD) + (size_t)l * 9 * 9216 + (3 * sub) * 1024;
            for (int i = tid; i < 9 * 1024; i += 512) sh[i] = modl[(size_t)(i >> 10) * 9216 + (i & 1023)];
            __syncthreads();
            cur_g = g;
        }
        float* bo = (float*)(ws + WS_BIASV) + (size_t)g * 9 * 5632;
        for (int rr = 0; rr < 8; ++rr) {
            const int p = base * 64 + wave * 8 + rr;
            const u32x4 w0 = *(const u32x4*)(Wt + (size_t)p * 1024 + lane * 8), w1 = *(const u32x4*)(Wt + (size_t)p * 1024 + 512 + lane * 8);
            float wf[16];
#pragma unroll
            for (int q = 0; q < 4; ++q) { wf[2 * q] = __uint_as_float(w0[q] << 16); wf[2 * q + 1] = __uint_as_float(w0[q] & 0xffff0000u);
                                          wf[8 + 2 * q] = __uint_as_float(w1[q] << 16); wf[8 + 2 * q + 1] = __uint_as_float(w1[q] & 0xffff0000u); }
#pragma unroll
            for (int mi = 0; mi < 9; ++mi) {
                const LAS f32x4* s0 = (const LAS f32x4*)(sh + mi * 1024 + lane * 8); const LAS f32x4* s1 = (const LAS f32x4*)(sh + mi * 1024 + 512 + lane * 8);
                const f32x4 a0 = s0[0], a1 = s0[1], c0 = s1[0], c1 = s1[1];
                float acc = (wf[0] * a0[0] + wf[1] * a0[1]) + (wf[2] * a0[2] + wf[3] * a0[3]) + (wf[4] * a1[0] + wf[5] * a1[1]) + (wf[6] * a1[2] + wf[7] * a1[3])
                          + (wf[8] * c0[0] + wf[9] * c0[1]) + (wf[10] * c0[2] + wf[11] * c0[3]) + (wf[12] * c1[0] + wf[13] * c1[1]) + (wf[14] * c1[2] + wf[15] * c1[3]);
                acc = wave_sum(acc);
                if (lane == 0) bo[(size_t)mi * 5632 + p] = acc;
            }
        }
    }
    __syncthreads();
}
__device__ __forceinline__ void final_norm_phase(const Args& a, int vcu, int G) {
    const int tid = opaque_tid(), lane = tid & 63, wave = tid >> 6;
    const float* xb = (const float*)(wsp(a) + WS_X); const float* nw = inp(a, 25);
    for (int row = vcu * 8 + wave; row < MROWS; row += G * 8) {
        const float* xr = xb + (size_t)row * DM;
        float* orow = row < NLAT ? outp(a) + OUT_YS + (size_t)row * DM : outp(a) + OUT_YP + (size_t)(row - NLAT) * DM;
        f32x4 v[4]; float ss = 0.f;
#pragma unroll
        for (int j = 0; j < 4; ++j) { v[j] = ((const f32x4*)xr)[lane + 64 * j]; ss += (v[j][0] * v[j][0] + v[j][1] * v[j][1]) + (v[j][2] * v[j][2] + v[j][3] * v[j][3]); }
        const float rstd = rsqrtf(wave_sum(ss) * (1.f / DM) + EPS);
#pragma unroll
        for (int j = 0; j < 4; ++j) ((f32x4*)orow)[lane + 64 * j] = v[j] * rstd * ((const f32x4*)nw)[lane + 64 * j];
    }
}

struct KVSrc { const bf16_t* k; const bf16_t* v; int ks, vs; };
constexpr int AT_K = 0, AT_V = 24576, AT_BIAS = 57344;
__device__ __forceinline__ int crow(int r, int hi) { return (r & 3) + 8 * (r >> 2) + 4 * hi; }
typedef short v4i16_t __attribute__((ext_vector_type(4)));
__device__ __forceinline__ s16x4 vtr(const LAS unsigned char* p) { return __builtin_bit_cast(s16x4, __builtin_amdgcn_ds_read_tr16_b64_v4i16((LAS v4i16_t*)p)); }

__device__ __forceinline__ float xhalf_max(float m) {
    auto rr = __builtin_amdgcn_permlane32_swap(__float_as_uint(m), __float_as_uint(m), false, false);
    return fmaxf(__uint_as_float(rr[0]), __uint_as_float(rr[1]));
}
__device__ __forceinline__ void qk_tile(const LAS unsigned char* Kb, const int (&kl)[4], const bf16x8 (&qr)[4], f32x16& p0, f32x16& p1, const f32x16& cinit) {
    bf16x8 kf[8];
#pragma unroll
    for (int d0 = 0; d0 < 4; ++d0) { kf[2 * d0] = *(const LAS bf16x8*)(Kb + kl[d0]); kf[2 * d0 + 1] = *(const LAS bf16x8*)(Kb + kl[d0] + 512); }
    __builtin_amdgcn_sched_barrier(0);
    p0 = cinit; p1 = cinit;
#pragma unroll
    for (int d0 = 0; d0 < 4; ++d0) {
        p0 = __builtin_amdgcn_mfma_f32_32x32x16_bf16(kf[2 * d0], qr[d0], p0, 0, 0, 0);
        p1 = __builtin_amdgcn_mfma_f32_32x32x16_bf16(kf[2 * d0 + 1], qr[d0], p1, 0, 0, 0);
    }
}
template <int DV, bool NB>
__device__ __forceinline__ void sm_pv(f32x16& p0, f32x16& p1, const LAS unsigned char* Vb, f32x16 (&OT)[DV / 32], float& m_run, float& l_run, f32x16& negm, f32x16& LT,
                                      const bool masked, const LAS float* brow, const int c, const int cs, const int hi) {
    float ls0 = 0.f, ls1 = 0.f;
    if (NB) {
        float mn;
        if (masked) {
            int co = c - 4 * hi, cso = cs - 4 * hi; asm volatile("" : "+v"(co), "+v"(cso));
#pragma unroll
            for (int r = 0; r < 16; ++r) {
                const int kc0 = (r & 3) + 8 * (r >> 2), kc1 = kc0 + 32;
                const int i0 = min(max(kc0 - co + 15, 0), 30), i1 = min(max(kc1 - co + 15, 0), 30);
                const float b0 = brow[i0], b1 = brow[i1];
                p0[r] = (kc0 >= cso && kc0 < cso + 16) ? p0[r] + b0 : -1e30f;
                p1[r] = (kc1 >= cso && kc1 < cso + 16) ? p1[r] + b1 : -1e30f;
            }
        }
        float rm = fmaxf(p0[0], p1[0]);
#pragma unroll
        for (int r = 1; r < 16; ++r) rm = fmaxf(fmaxf(rm, p0[r]), p1[r]);
        rm = xhalf_max(rm);
        mn = fmaxf(m_run, rm);
#pragma unroll
        for (int r = 0; r < 16; ++r) { p0[r] = fast_exp2(p0[r] - mn); p1[r] = fast_exp2(p1[r] - mn); }
#pragma unroll
        for (int r = 0; r < 16; ++r) { ls0 += p0[r]; ls1 += p1[r]; }
        const float alpha = fast_exp2(m_run - mn);
        m_run = mn;
        l_run = l_run * alpha + (ls0 + ls1);
        if (__any(alpha != 1.f)) {
#pragma unroll
            for (int d = 0; d < DV / 32; ++d) OT[d] *= alpha;
        }
    } else {
        float rm = fmaxf(p0[0], p1[0]);
#pragma unroll
        for (int r = 1; r < 16; ++r) rm = fmaxf(fmaxf(rm, p0[r]), p1[r]);
        rm = xhalf_max(rm);
        if (__any(rm > 8.f)) {
            const float d = fmaxf(rm, 0.f);
            m_run += d;
#pragma unroll
            for (int r = 0; r < 16; ++r) { p0[r] -= d; p1[r] -= d; }
            const float alpha = fast_exp2(-d);
            LT *= alpha;
#pragma unroll
            for (int dd = 0; dd < DV / 32; ++dd) OT[dd] *= alpha;
#pragma unroll
            for (int r = 0; r < 16; ++r) negm[r] = -m_run;
        }
#pragma unroll
        for (int r = 0; r < 16; ++r) { p0[r] = fast_exp2(p0[r]); p1[r] = fast_exp2(p1[r]); }
    }
    bf16x8 pa[4];
#pragma unroll
    for (int k = 0; k < 4; ++k) {
        u32x4 w;
        if (k < 2) { w.x = pk2(p0[8 * k + 0], p0[8 * k + 1]); w.y = pk2(p0[8 * k + 2], p0[8 * k + 3]); w.z = pk2(p0[8 * k + 4], p0[8 * k + 5]); w.w = pk2(p0[8 * k + 6], p0[8 * k + 7]); }
        else { const int kk = k - 2; w.x = pk2(p1[8 * kk + 0], p1[8 * kk + 1]); w.y = pk2(p1[8 * kk + 2], p1[8 * kk + 3]); w.z = pk2(p1[8 * kk + 4], p1[8 * kk + 5]); w.w = pk2(p1[8 * kk + 6], p1[8 * kk + 7]); }
        pa[k] = __builtin_bit_cast(bf16x8, w);
    }
    if (!NB) {
        const bf16x8 ones = {0x3F80, 0x3F80, 0x3F80, 0x3F80, 0x3F80, 0x3F80, 0x3F80, 0x3F80};
#pragma unroll
        for (int k = 0; k < 4; ++k) LT = __builtin_amdgcn_mfma_f32_32x32x16_bf16(ones, pa[k], LT, 0, 0, 0);
    }
#pragma unroll
    for (int dd = 0; dd < DV / 64; ++dd) {
        s16x4 lo[2][4], hh[2][4];
#pragma unroll
        for (int d = 0; d < 2; ++d)
#pragma unroll
            for (int k = 0; k < 4; ++k) { lo[d][k] = vtr(Vb + (2 * dd + d) * 4096 + k * 1024); hh[d][k] = vtr(Vb + (2 * dd + d) * 4096 + k * 1024 + 512); }
        __builtin_amdgcn_sched_barrier(0);
#pragma unroll
        for (int k = 0; k < 4; ++k)
#pragma unroll
            for (int d = 0; d < 2; ++d) {
                const bf16x8 vf = {lo[d][k][0], lo[d][k][1], lo[d][k][2], lo[d][k][3], hh[d][k][0], hh[d][k][1], hh[d][k][2], hh[d][k][3]};
                OT[2 * dd + d] = __builtin_amdgcn_mfma_f32_32x32x16_bf16(vf, pa[k], OT[2 * dd + d], 0, 0, 0);
            }
    }
}

#define AT_BAR() do { asm volatile("s_waitcnt lgkmcnt(0)" ::: "memory"); __builtin_amdgcn_s_barrier(); asm volatile("" ::: "memory"); } while (0)
template <int DV, bool NB>
__device__ __forceinline__ void attn_pass(LAS unsigned char* lds, const bf16x8 (&qr)[4], const KVSrc s0, const int nt0, const KVSrc s1, const int nt1,
                                          f32x16 (&OT)[DV / 32], float& m_run, float& l_run,
                                          const int R, const int c, const int kr0) {
    constexpr int NV = DV / 64;
    const int tid = opaque_tid(), lane = tid & 63, r32 = lane & 31, hi = lane >> 5;
    const int NT = nt0 + nt1;
    const int wtype = 0;
    const int wid = __builtin_amdgcn_readfirstlane(tid >> 6);
#define AT_DMAK(t_, koff_) do { const int t__ = (t_); const bool f__ = t__ < nt0; const int tt__ = f__ ? t__ : t__ - nt0; \
        const bf16_t* kp__ = f__ ? s0.k : s1.k; const int ks__ = f__ ? s0.ks : s1.ks; \
        __builtin_amdgcn_global_load_lds((const unsigned*)(kp__ + (size_t)(tt__ * 64 + (lane ^ wid)) * ks__ + wid * 8), (LAS unsigned*)(lds + AT_K + (koff_) + wid * 1024), 16, 0, 0); } while (0)
#define AT_DMAV(t_, b_) do { const int t__ = (t_); const bool f__ = t__ < nt0; const int tt__ = f__ ? t__ : t__ - nt0; \
        const bf16_t* vp__ = f__ ? s0.v : s1.v; const int vs__ = f__ ? s0.vs : s1.vs; \
        _Pragma("unroll") for (int i__ = 0; i__ < NV; ++i__) { const int pz__ = wid + 8 * i__; \
            __builtin_amdgcn_global_load_lds((const unsigned*)(vp__ + (size_t)(tt__ * 64 + 16 * (pz__ & 3) + (lane >> 2)) * vs__ + (pz__ >> 2) * 32 + (lane & 3) * 8), \
                                             (LAS unsigned*)(lds + AT_V + (b_) * 16384 + (pz__ >> 2) * 4096 + (pz__ & 3) * 1024), 16, 0, 0); } } while (0)
#define AT_WAITV() asm volatile("s_waitcnt vmcnt(0)" ::: "memory")
    const int rs = NB ? min(max(R - 4, 0), 24) : 0;
    const int cs = NB ? min(max(c - 8, 0), 48) : 0;
    const LAS float* biasL = (const LAS float*)(lds + AT_BIAS);
    const int vlane = ((lane >> 4) & 1) * 32 + (lane & 3) * 8 + (4 * hi + ((lane & 15) >> 2)) * 64;
    int kl[4];
#pragma unroll
    for (int d0 = 0; d0 < 4; ++d0) kl[d0] = (2 * d0 + hi) * 1024 + (r32 ^ (2 * d0 + hi)) * 16;
    const LAS unsigned char* Kl = lds + AT_K;
#define AT_ACTIVE(t_) (!NB || (t_) < nt0 || (kr0 + ((t_) - nt0) >= rs && kr0 + ((t_) - nt0) < rs + 8))
    AT_DMAK(0, 0); AT_DMAV(0, 0);
    if (NT > 1) { AT_DMAK(1, 8192); AT_DMAV(1, 1); }
    if (NT > 2) AT_DMAK(2, 16384);
    AT_WAITV();
    AT_BAR();
    f32x16 p0, p1, negm = f32x16{}, LT = f32x16{};
    if (!NB) m_run = 0.f;
    if (AT_ACTIVE(0)) qk_tile(Kl, kl, qr, p0, p1, negm);
    int kcur = 0;
#define AT_STEP(t_) do { const int t = (t_); \
        const int knext = kcur == 16384 ? 0 : kcur + 8192; \
        if (AT_ACTIVE(t)) sm_pv<DV, NB>(p0, p1, lds + AT_V + (t & 1) * 16384 + vlane, OT, m_run, l_run, negm, LT, NB && t >= nt0, biasL + (kr0 + (t - nt0) - R + 7) * 31, c, cs, hi); \
        if (wtype == 0) { AT_WAITV(); AT_BAR(); if (t + 3 < NT) AT_DMAK(t + 3, kcur); if (t + 2 < NT) AT_DMAV(t + 2, t & 1); } \
        if (t + 1 < NT && AT_ACTIVE(t + 1)) qk_tile(Kl + knext, kl, qr, p0, p1, negm); \
        if (wtype != 0) { AT_WAITV(); AT_BAR(); if (t + 3 < NT) AT_DMAK(t + 3, kcur); if (t + 2 < NT) AT_DMAV(t + 2, t & 1); } \
        kcur = knext; } while (0)
    for (int t2 = 0; t2 < NT; ++t2) AT_STEP(t2);
    if (!NB) l_run = 0.5f * LT[0];
    AT_WAITV();
    AT_BAR();
#undef AT_DMAK
#undef AT_DMAV
#undef AT_WAITV
#undef AT_ACTIVE
#undef AT_STEP
}

__device__ __forceinline__ void load_q(bf16x8 (&qr)[4], const bf16_t* Q, int ldq) {
    const int tid = opaque_tid(), lane = tid & 63, r32 = lane & 31, hi = lane >> 5, wid = tid >> 6;
    const bf16_t* p = Q + (size_t)(wid * 32 + r32) * ldq + hi * 8;
#pragma unroll
    for (int d0 = 0; d0 < 4; ++d0) qr[d0] = *(const bf16x8*)(p + d0 * 16);
}
__device__ __forceinline__ void store_o64(const f32x16 (&OT)[2], float l_run, bf16_t* O  ) {
    const int tid = opaque_tid(), lane = tid & 63, r32 = lane & 31, hi = lane >> 5, wid = tid >> 6;
    const float inv = 1.f / (l_run + __shfl_xor(l_run, 32));
    bf16_t* op = O + (size_t)(wid * 32 + r32) * DM + 4 * hi;
#pragma unroll
    for (int d = 0; d < 2; ++d)
#pragma unroll
        for (int g = 0; g < 4; ++g) { u32x2 w; w.x = pk2(OT[d][4 * g] * inv, OT[d][4 * g + 1] * inv); w.y = pk2(OT[d][4 * g + 2] * inv, OT[d][4 * g + 3] * inv); *(u32x2*)(op + 32 * d + 8 * g) = w; }
}

__device__ __forceinline__ void attn_even_phase(const Args& a, LAS unsigned char* lds, int e, int vcu, int G) {
    const int tid = opaque_tid(), lane = tid & 63, r32 = lane & 31, wid = tid >> 6;
    unsigned char* ws = wsp(a);
    const bf16_t* QKV = (const bf16_t*)(ws + WS_U); bf16_t* OB = (bf16_t*)(ws + WS_O);
    for (int u = vcu; u < 1280; u += G) {
        bf16x8 qr[4]; f32x16 OT[2]; OT[0] = f32x16{}; OT[1] = f32x16{};
        float m_run = -1e30f, l_run = 0.f;
        if (u < 512) {
            const int b = u >> 6, h = (u >> 3) & 7, qb = u & 7, g = h >> 2;
            const size_t row0 = (size_t)b * 2048 + qb * 256;
            load_q(qr, QKV + row0 * NQ_E + 64 * h, NQ_E);
            const KVSrc s0{QKV + (size_t)b * 2048 * NQ_E + 512 + 64 * g, QKV + (size_t)b * 2048 * NQ_E + 640 + 64 * g, NQ_E, NQ_E};
            const size_t co = (size_t)(b * 2 + e) * 512 * 128 + 64 * g;
            const KVSrc s1{(const bf16_t*)(ws + WS_CAK) + co, (const bf16_t*)(ws + WS_CAV) + co, 128, 128};
            attn_pass<64, false>(lds, qr, s0, 32, s1, 8, OT, m_run, l_run, 0, 0, 0);
            store_o64(OT, l_run, OB + row0 * DM + 64 * h);
        } else if (u < 1024) {
            const int v = u - 512, b = v >> 6, h = (v >> 3) & 7, qb = v & 7;
            const size_t row0 = (size_t)b * 2048 + qb * 256;
            for (int i = tid; i < 465; i += 512) ((LAS float*)(lds + AT_BIAS))[i] = inp(a, 20)[(size_t)(e * 8 + h) * 465 + i] * LOG2E;
            load_q(qr, QKV + row0 * NQ_E + 768 + 64 * h, NQ_E);
            const size_t co = (size_t)(b * 2 + e) * 512 * 512 + 64 * h;
            const KVSrc s0{(const bf16_t*)(ws + WS_CBK) + co, (const bf16_t*)(ws + WS_CBV) + co, 512, 512};
            const int klo = min(max(4 * qb - 4, 0), 24), khi = min(max(4 * qb - 1, 0), 24) + 8;
            const size_t lo = ((size_t)b * 2048 + klo * 64) * NQ_E;
            const KVSrc s1{QKV + lo + 1280 + 64 * h, QKV + lo + 1792 + 64 * h, NQ_E, NQ_E};
            attn_pass<64, true>(lds, qr, s0, 8, s1, khi - klo, OT, m_run, l_run, 4 * qb + (wid >> 1), 32 * (wid & 1) + r32, klo);
            store_o64(OT, l_run, OB + row0 * DM + 512 + 64 * h);
        } else {
            const int v = u - 1024, isb = v >> 7, b = (v >> 3) & 15, h = v & 7;
            const size_t row0 = (size_t)NLAT + b * 256;
            const int qc = isb ? 768 + 64 * h : 64 * h, kc = isb ? 1280 + 64 * h : 512 + 64 * (h >> 2), vc = isb ? 1792 + 64 * h : 640 + 64 * (h >> 2);
            load_q(qr, QKV + row0 * NQ_E + qc, NQ_E);
            const KVSrc s0{QKV + row0 * NQ_E + kc, QKV + row0 * NQ_E + vc, NQ_E, NQ_E};
            attn_pass<64, false>(lds, qr, s0, 4, s0, 0, OT, m_run, l_run, 0, 0, 0);
            store_o64(OT, l_run, OB + row0 * DM + (isb ? 512 : 0) + 64 * h);
        }
    }
}

__device__ __forceinline__ void attn_odd_phase(const Args& a, LAS unsigned char* lds, int o, float lam_init, int vcu, int G) {
    const int tid = opaque_tid(), lane = tid & 63, r32 = lane & 31, hi = lane >> 5, wid = tid >> 6;
    unsigned char* ws = wsp(a);
    const bf16_t* QKV = (const bf16_t*)(ws + WS_U); bf16_t* OB = (bf16_t*)(ws + WS_O);
    const float* lp = inp(a, 23) + o * 256;
    const float lam = __expf(wave_sum(lp[lane] * lp[64 + lane])) - __expf(wave_sum(lp[128 + lane] * lp[192 + lane])) + lam_init;
    const float* sub = inp(a, 24) + o * 128;
    for (int u = vcu; u < 640; u += G) {
        int b, h, qb, nt0, nt1; size_t row0, krow0;
        if (u < 512) { b = u >> 6; h = (u >> 3) & 7; qb = u & 7; row0 = (size_t)b * 2048 + qb * 256; krow0 = (size_t)b * 2048; nt0 = 32; nt1 = 8; }
        else { const int v = u - 512; b = v >> 3; h = v & 7; qb = 0; row0 = (size_t)NLAT + b * 256; krow0 = row0; nt0 = 4; nt1 = 0; }
        LAS u32x4* o0s = (LAS u32x4*)(lds + 65536 + wid * 8192 + lane * 16);
#pragma unroll
        for (int j = 0; j < 2; ++j) {
            bf16x8 qr[4]; f32x16 OT[4];
#pragma unroll
            for (int d = 0; d < 4; ++d) OT[d] = f32x16{};
            float m_run = -1e30f, l_run = 0.f;
            load_q(qr, QKV + row0 * NQ_O + 128 * h + 64 * j, NQ_O);
            const KVSrc s0{QKV + krow0 * NQ_O + 1024 + 128 * h + 64 * j, QKV + krow0 * NQ_O + 2048 + 128 * h, NQ_O, NQ_O};
            const size_t co = (size_t)((b & 7) * 2 + o) * 512 * 1024 + 128 * h;
            const KVSrc s1{(const bf16_t*)(ws + WS_CCK) + co + 64 * j, (const bf16_t*)(ws + WS_CCV) + co, 1024, 1024};
            attn_pass<128, false>(lds, qr, s0, nt0, s1, nt1, OT, m_run, l_run, 0, 0, 0);
            const float inv = 1.f / (l_run + __shfl_xor(l_run, 32));
            if (j == 0) {
#pragma unroll
                for (int d = 0; d < 4; ++d)
#pragma unroll
                    for (int r = 0; r < 2; ++r) { u32x4 w; w.x = pk2(OT[d][8 * r] * inv, OT[d][8 * r + 1] * inv); w.y = pk2(OT[d][8 * r + 2] * inv, OT[d][8 * r + 3] * inv);
                        w.z = pk2(OT[d][8 * r + 4] * inv, OT[d][8 * r + 5] * inv); w.w = pk2(OT[d][8 * r + 6] * inv, OT[d][8 * r + 7] * inv); o0s[(d * 2 + r) * 64] = w; }
            } else {
                const float f1 = lam * inv; float ss = 0.f;
#pragma unroll
                for (int d = 0; d < 4; ++d)
#pragma unroll
                    for (int rr = 0; rr < 2; ++rr) { const u32x4 w = o0s[(d * 2 + rr) * 64];
#pragma unroll
                        for (int q = 0; q < 4; ++q) { const int r = 4 * rr + q;
                            const float a0 = __uint_as_float(w[q] << 16), a1 = __uint_as_float(w[q] & 0xffff0000u);
                            OT[d][2 * r] = a0 - OT[d][2 * r] * f1; OT[d][2 * r + 1] = a1 - OT[d][2 * r + 1] * f1;
                            ss += OT[d][2 * r] * OT[d][2 * r] + OT[d][2 * r + 1] * OT[d][2 * r + 1]; } }
                ss += __shfl_xor(ss, 32);
                const float rstd = rsqrtf(ss * (1.f / 128.f) + EPS) * (1.f - lam_init);
                bf16_t* op = OB + (row0 + wid * 32 + r32) * DM + 128 * h + 4 * hi;
#pragma unroll
                for (int d = 0; d < 4; ++d)
#pragma unroll
                    for (int g = 0; g < 4; ++g) {
                        const f32x4 sw = *(const f32x4*)(sub + 32 * d + 8 * g + 4 * hi);
                        u32x2 w; w.x = pk2(OT[d][4 * g] * rstd * sw[0], OT[d][4 * g + 1] * rstd * sw[1]); w.y = pk2(OT[d][4 * g + 2] * rstd * sw[2], OT[d][4 * g + 3] * rstd * sw[3]);
                        *(u32x2*)(op + 32 * d + 8 * g) = w;
                    }
            }
        }
    }
}

#define XB_TMO      128
#define XB_XCNT(j)  (256  + 64 * (j))
#define XB_XSUB(j)  (1280 + 64 * (j))
#define XB_XGEN(j)  (2304 + 64 * (j))
#define XB_TOP      3328
#define XB_TOPGEN   3392
#define XCD_BAR_WORDS 3456
#define XB_SPIN_CAP (1u << 18)

__device__ __forceinline__ unsigned xb_ld(unsigned* p)              { return __hip_atomic_load(p, __ATOMIC_RELAXED, __HIP_MEMORY_SCOPE_AGENT); }
__device__ __forceinline__ unsigned xb_add(unsigned* p, unsigned v) { return __hip_atomic_fetch_add(p, v, __ATOMIC_RELAXED, __HIP_MEMORY_SCOPE_AGENT); }
__device__ __forceinline__ unsigned xb_xcc_id() { return (unsigned)__builtin_amdgcn_s_getreg((3 << 11) | 20) & 0xFu; }
#define XB_SPIN(cond, bar) do { unsigned _sp = 0; while (cond) { __builtin_amdgcn_s_sleep(1); \
    if ((++_sp & 255u) == 0u) { if (xb_ld(&(bar)[XB_TMO])) break; if (_sp > XB_SPIN_CAP) { atomicAdd(&(bar)[XB_TMO], 1u); break; } } } } while (0)

struct XcdBarrier {
    unsigned* bar; unsigned x;
    volatile LAS unsigned* st;
};

__device__ __forceinline__ XcdBarrier xcd_barrier_post(unsigned* bar, volatile LAS unsigned* st) {
    XcdBarrier b; b.bar = bar; b.x = xb_xcc_id(); b.st = st;
    if (threadIdx.x == 0) (void)xb_add(&bar[XB_XCNT(b.x)], 1u);
    return b;
}
__device__ __forceinline__ void xcd_barrier_complete(unsigned* bar, unsigned x, unsigned& nloc, unsigned& nx) {
    const unsigned G = gridDim.x * gridDim.y * gridDim.z;
    unsigned sum, cnt, mine, sp = 0u;
    for (;;) {
        sum = 0u; cnt = 0u; mine = 0u;
#pragma unroll
        for (unsigned j = 0; j < 16; ++j) { const unsigned c = xb_ld(&bar[XB_XCNT(j)]); sum += c; cnt += (c > 0u) ? 1u : 0u; mine = (j == x) ? c : mine; }
        if (sum == G) break;
        __builtin_amdgcn_s_sleep(1);
        if ((++sp & 255u) == 0u) { if (xb_ld(&bar[XB_TMO])) break; if (sp > XB_SPIN_CAP) { atomicAdd(&bar[XB_TMO], 1u); break; } }
    }
    nloc = mine > 0u ? mine : 1u; nx = cnt > 0u ? cnt : 1u;
}

__device__ __forceinline__ void xcd_barrier(const XcdBarrier& b) {
    asm volatile("s_waitcnt vmcnt(0)" ::: "memory");
    __syncthreads();
    if (threadIdx.x == 0) {
        unsigned* bar = b.bar;
        __builtin_amdgcn_s_waitcnt(0);
        unsigned nloc = b.st[0], nx = b.st[1];
        if (nloc == 0u) { xcd_barrier_complete(bar, b.x, nloc, nx); b.st[0] = nloc; b.st[1] = nx; }
        const unsigned old = xb_add(&bar[XB_XSUB(b.x)], 1u);
        const unsigned gen = old / nloc;
        if (old + 1u == (gen + 1u) * nloc) {
            __builtin_amdgcn_fence(__ATOMIC_RELEASE, "agent");
            asm volatile("s_waitcnt vmcnt(0)" ::: "memory");
            const unsigned og = xb_add(&bar[XB_TOP], 1u);
            const unsigned tg = og / nx;
            if (og + 1u == (tg + 1u) * nx) xb_add(&bar[XB_TOPGEN], 1u);
            else XB_SPIN(xb_ld(&bar[XB_TOPGEN]) == tg, bar);
            __builtin_amdgcn_fence(__ATOMIC_ACQUIRE, "agent");
            xb_add(&bar[XB_XGEN(b.x)], 1u);
            asm volatile("s_waitcnt vmcnt(0)" ::: "memory");
        } else {
            XB_SPIN(xb_ld(&bar[XB_XGEN(b.x)]) == gen, bar);
            __builtin_amdgcn_fence(__ATOMIC_ACQUIRE, "agent");
            asm volatile("s_waitcnt vmcnt(0)" ::: "memory");
        }
    }
    __syncthreads();
}

__global__ void __launch_bounds__(512, 2) mega_fwd(Args a) {
    extern __shared__ __attribute__((aligned(16))) unsigned char lds_raw[];
    LAS unsigned char* lds = (LAS unsigned char*)lds_raw;
    cg::grid_group grid = cg::this_grid();
    const int G = gridDim.x; const int bx = blockIdx.x;
    const int vcu = (G % 8 == 0) ? (bx % 8) * (G / 8) + bx / 8 : bx;
    unsigned char* ws = wsp(a);
    const float* MOD = (const float*)(ws + WS_MOD);
    bf16_t* HB = (bf16_t*)(ws + WS_H); bf16_t* UB = (bf16_t*)(ws + WS_U); bf16_t* OB = (bf16_t*)(ws + WS_O); float* XB = (float*)(ws + WS_X);
    volatile LAS unsigned* bst = (volatile LAS unsigned*)(lds + 131072);
    if (threadIdx.x < 2) bst[threadIdx.x] = 0u;
    __syncthreads();
    const XcdBarrier xbar = xcd_barrier_post((unsigned*)(wsp(a) + WS_BAR), bst);
    int ph = 0;
#define GSYNC() do { if (a.ph_lo < 0) grid.sync(); else xcd_barrier(xbar); } while (0)
#ifndef DUP_MASK
#define DUP_MASK 0
#endif
#ifndef XSYNC
#define XSYNC 1
#endif
#ifndef TPROBE
#define TPROBE 0
#endif
    volatile LAS unsigned long long* tacc = (volatile LAS unsigned long long*)(lds + 131072 + 32);
    if (TPROBE && threadIdx.x == 0) { tacc[0] = 0ull; tacc[1] = 0ull; }
#define TP_BEGIN(cls) do { if (TPROBE && ((cls) & TPROBE) && blockIdx.x == 0 && threadIdx.x == 0) tacc[1] = __builtin_amdgcn_s_memrealtime(); } while (0)
#define TP_END(cls) do { if (TPROBE && ((cls) & TPROBE) && blockIdx.x == 0 && threadIdx.x == 0) tacc[0] += __builtin_amdgcn_s_memrealtime() - tacc[1]; } while (0)
#define RUNC(cls, ...) do { if (ph >= a.ph_lo && ph < a.ph_hi) { TP_BEGIN(cls); __VA_ARGS__; if (ph + 1 < a.ph_hi) GSYNC(); TP_END(cls); } ++ph; } while (0)
#define RUN(...) RUNC(8, __VA_ARGS__)
#define RUND(bit, ...) do { if (ph >= a.ph_lo && ph < a.ph_hi) { int nrep_ = (DUP_MASK & (bit)) ? 2 : 1; asm volatile("" : "+s"(nrep_)); for (int rep_ = 0; rep_ < nrep_; ++rep_) { TP_BEGIN(bit); __VA_ARGS__; if (rep_ + 1 < nrep_ || ph + 1 < a.ph_hi) { GSYNC(); if (XSYNC) { xcd_barrier(xbar); xcd_barrier(xbar); } } TP_END(bit); } } ++ph; } while (0)

#ifndef PH_MASK
#define PH_MASK 0xff
#endif
    RUND(1, if (PH_MASK & 1) prologue_phase(a, lds, vcu, G));
    RUNC(2, { bias_phase(a, lds, G); norm_phase(a, inp(a, 12), MOD, vcu, G); });
    const float* RSS = (const float*)(ws + WS_ROWSS); const float* BIASV = (const float*)(ws + WS_BIASV);
    for (int l = 0; l < 4; ++l) {
        const float* modl = MOD + (size_t)l * 9 * 9216;
        for (int half = 0; half < 2; ++half) {
            const int sub = half ? 2 : 0, lf = l * 2 + half;
            RUND(4, if (PH_MASK & 4) { pg8::Gemm g{HB, (const bf16_t*)(ws + WS_W13T) + (size_t)lf * 5632 * 1024, MROWS, 5632, 1024}; pg8::StaticOrder S; S.init(MROWS, 5632, G, bx);
                  EpiSwiGLU E{UB, RSS + (size_t)(l * 3 + sub) * MROWS, BIASV + (size_t)(l * 3 + sub) * 9 * 5632};
#if SPLIT_PROBE
                  { RangeOrder R1{S, 0, 4}; pg8::gemm_phase<EpiSwiGLU, RangeOrder, true, true>(lds, g, R1, E); xcd_barrier(xbar); RangeOrder R2{S, 4, 100}; pg8::gemm_phase<EpiSwiGLU, RangeOrder, true, true>(lds, g, R2, E); }
#else
                  pg8::gemm_phase<EpiSwiGLU, pg8::StaticOrder, true, true>(lds, g, S, E);
#endif
                  });
            RUN(if (PH_MASK & 8) { const bf16_t* W2 = (const bf16_t*)(ws + WS_W2T) + (size_t)lf * 1024 * DFF;
                  const int nl = half ? l + 1 : l, ns = half ? 0 : 1; const bool has = nl < 4;
                  EpiResid E{XB, modl + (3 * sub + 2) * 1024, 0.5f, has ? HB : nullptr, inp(a, 12) + (size_t)((has ? nl : 0) * 3 + ns) * DM,
                             MOD + (size_t)(has ? nl : 0) * 9 * 9216 + (3 * ns + 1) * 1024, (float*)(ws + WS_ROWSS) + (size_t)((has ? nl : 0) * 3 + ns) * MROWS, 0, 2};
                  { pg8::Gemm g{UB, W2, NLAT, 1024, DFF}; pg8::StaticOrder S; S.init(NLAT, 1024, G, bx);
                    pg8::gemm_phase<EpiResid, pg8::StaticOrder, true, true>(lds, g, S, E); }
                  for (int c = vcu; c < 256; c += G) small_gemm_resid(lds, UB, W2, DFF, c, E); });
            if (half == 0) {
                const int eo = l >> 1; const bool even = (l & 1) == 0;
                RUND(16, if (PH_MASK & 16) { const int nq = even ? NQ_E : NQ_O;
                      pg8::Gemm g{HB, even ? (const bf16_t*)(ws + WS_WINAB) + (size_t)eo * NQ_E * 1024 : (const bf16_t*)(ws + WS_WINC) + (size_t)eo * NQ_O * 1024, MROWS, nq, 1024};
                      pg8::StaticOrder S; S.init(MROWS, nq, G, bx);
                      EpiQKV E{UB, nq, even ? 1 : 0, eo, inp(a, 18) + eo * 64, inp(a, 19) + eo * 64, (const f32x2*)(ws + WS_ROPE), outp(a), RSS + (size_t)(l * 3 + 1) * MROWS, BIASV + (size_t)(l * 3 + 1) * 9 * 5632};
                      pg8::gemm_phase<EpiQKV, pg8::StaticOrder, true, true>(lds, g, S, E); });
                RUND(32, { if (even) { if (PH_MASK & 32) attn_even_phase(a, lds, eo, vcu, G); } else if (PH_MASK & 64) attn_odd_phase(a, lds, eo, l == 1 ? 0.35550906759096926f : 0.5560582041556405f, vcu, G); });
                RUN(if (PH_MASK & 8) { const bf16_t* WO = even ? (const bf16_t*)(ws + WS_WOUTAB) + (size_t)eo * 1024 * 1024 : (const bf16_t*)(ws + WS_WOUTC) + (size_t)eo * 1024 * 1024;
                      EpiResid E{XB, modl + 5 * 1024, 1.0f, HB, inp(a, 12) + (size_t)(l * 3 + 2) * DM, modl + 7 * 1024, (float*)(ws + WS_ROWSS) + (size_t)(l * 3 + 2) * MROWS, 0, 2};
                      { pg8::Gemm g{OB, WO, NLAT, 1024, 1024}; pg8::StaticOrder S; S.init(NLAT, 1024, G, bx);
                        pg8::gemm_phase<EpiResid, pg8::StaticOrder, true, true>(lds, g, S, E); }
                      for (int c = vcu; c < 256; c += G) small_gemm_resid(lds, OB, WO, 1024, c, E); });
            }
        }
    }
    if (TPROBE) {
        if (blockIdx.x == 0 && threadIdx.x == 0) { const unsigned long long t0 = __builtin_amdgcn_s_memrealtime(), d = tacc[0]; while (__builtin_amdgcn_s_memrealtime() - t0 < d) __builtin_amdgcn_s_sleep(8); }
        xcd_barrier(xbar);
    }
    RUNC(128, if (PH_MASK & 2) final_norm_phase(a, vcu, G));
#undef RUN
#undef RUND
#undef RUNC
}

extern "C" void kernel_launch(void* const* d_in, const int* in_sizes, int n_in, void* d_out, int out_size, void* d_ws, size_t ws_size, hipStream_t stream) {
    static int grid = 0;
    if (grid == 0) {
        int dev = 0, cus = 0, per_cu = 0;
        hipGetDevice(&dev);
        hipDeviceGetAttribute(&cus, hipDeviceAttributeMultiprocessorCount, dev);
        hipFuncSetAttribute((const void*)mega_fwd, hipFuncAttributeMaxDynamicSharedMemorySize, LDS_BYTES);
        hipOccupancyMaxActiveBlocksPerMultiprocessor(&per_cu, (const void*)mega_fwd, 512, LDS_BYTES);
        if (per_cu < 1) per_cu = 1;
        if (per_cu > 1) per_cu = 1;
        grid = cus * per_cu;
        if (n_in != 26 || ws_size < WS_END) { fprintf(stderr, "kernel_launch: unexpected n_in %d / ws %zu\n", n_in, ws_size); }
    }
    hipMemsetAsync((unsigned char*)d_ws + WS_BAR, 0, WS_BAR_BYTES, stream);
    Args a{};
    for (int i = 0; i < 26; ++i) a.in[i] = (const float*)d_in[i];
    a.out = (float*)d_out; a.ws = (unsigned char*)d_ws; a.ph_lo = 0; a.ph_hi = 1000;
    void* args[] = {&a};
    hipError_t e = hipLaunchCooperativeKernel((const void*)mega_fwd, dim3(grid), dim3(512), args, LDS_BYTES, stream);
    if (e != hipSuccess) fprintf(stderr, "cooperative launch failed: %s (grid %d)\n", hipGetErrorString(e), grid);
}
```

```cpp
#define DUP_MASK 0
#define XSYNC 0
#define SPLIT_PROBE 0
#define TPROBE 0
#include <hip/hip_runtime.h>
#include <hip/hip_cooperative_groups.h>
#include <cstdio>
#include <cstdint>
namespace cg = cooperative_groups;
__device__ __forceinline__ int opaque_tid() { int t = threadIdx.x; asm volatile("" : "+v"(t)); return t; }
namespace pg8 {
#define PG8_LAS __attribute__((address_space(3)))
typedef unsigned short bf16_t;
typedef short bf16x8 __attribute__((ext_vector_type(8)));
typedef float f32x4 __attribute__((ext_vector_type(4)));
typedef unsigned u32x4 __attribute__((ext_vector_type(4)));
constexpr int BM = 256, BK = 64, HALF = 128, HTB = HALF * BK * 2  , STAGE_BYTES = 8 * HTB, NXCD = 8, WGM = 8;

__host__ __device__ __forceinline__ int lds_byte(int r, int c) { const int st = (r >> 4) * 2 + (c >> 5), rr = r & 15, cc = c & 31, ob = rr * 64 + cc * 2; return st * 1024 + (ob ^ (((ob >> 9) & 1) << 5)); }
__host__ __device__ __forceinline__ void stage_rc(int b, int& R, int& C) { const int st = b / 1024, sb = b % 1024, swz = sb ^ (((sb >> 9) & 1) << 5); R = (st >> 1) * 16 + swz / 64; C = (st & 1) * 32 + (swz % 64) / 2; }
__host__ __device__ __forceinline__ int perm32(int rho) { const int n = rho >> 4, i = rho & 15; return 8 * (i >> 2) + 4 * n + (i & 3); }

struct Unit { int pm, pn; };
struct Gemm { const bf16_t* A; const bf16_t* Bt; int M, N, K; };

struct StaticOrder {
    int nM, nN, nwg, G, c;
    __host__ __device__ void init(int M, int N, int G_, int c_) { nM = M / BM; nN = N / BM; nwg = nM * nN; G = G_; c = c_; }
    __host__ __device__ bool next(int i, Unit& u) const {
        const long L = (long)i * G + c; if (L >= nwg) return false;
        int wgid = (int)L; { const int q = nwg / NXCD, r = nwg % NXCD, xcd = wgid % NXCD, off = wgid / NXCD; wgid = (xcd < r ? xcd * (q + 1) : r * (q + 1) + (xcd - r) * q) + off; }
        const int nig = WGM * nN, gid = wgid / nig, fm = gid * WGM, gsz = (nM - fm) < WGM ? (nM - fm) : WGM;
        u.pm = fm + ((wgid % nig) % gsz); u.pn = (wgid % nig) / gsz; return true;
    }
    __device__ __forceinline__ void a_ready(const Unit&) const {}
    __device__ __forceinline__ void done(const Unit&) const {}
};

template <class Epi, class Sched, bool ALIGN_EPI = false, bool SP2 = false, bool HALFM = false>
__device__ __forceinline__ void gemm_phase(PG8_LAS unsigned char* lds, const Gemm g, const Sched& S, const Epi& E) {
    const int tid = opaque_tid(), wid = __builtin_amdgcn_readfirstlane(tid >> 6), lane = tid & 63, wr = wid >> 2, wc = wid & 3, fr = lane & 15, fq = lane >> 4;
    const int K = g.K, nt = K / BK;
    unsigned voffA[2], voffB[2];
#pragma unroll
    for (int i = 0; i < 2; ++i) { int R, C; stage_rc(tid * 16 + i * 8192, R, C); const int Rb = Epi::PERM ? ((R & ~31) + perm32(R & 31)) : R;
        voffA[i] = (unsigned)(R * K + C) * 2u; voffB[i] = (unsigned)(Rb * K + C) * 2u; }
    const size_t kstep = (size_t)(BK * 2);
    const size_t hstep = (size_t)HALF * K * 2;
    const size_t tstep = 2 * hstep;
    const unsigned ldsw = (unsigned)wid * 1024u;
    const int aoff = lds_byte(wr * 64 + fr, fq * 8), boff = lds_byte(wc * 32 + fr, fq * 8);
#define PG8_SA(b, h) (((b) * 2 + (h)) * HTB)
#define PG8_SB(b, h) ((4 + (b) * 2 + (h)) * HTB)
#define PG8_STAGE(bufoff, gbase, voff) do { _Pragma("unroll") for (int _i = 0; _i < 2; ++_i) \
        __builtin_amdgcn_global_load_lds((const unsigned*)((const char*)(gbase) + (voff)[_i]), (PG8_LAS unsigned*)(lds + (bufoff) + ldsw + _i * 8192), 16, 0, 0); } while (0)
#define PG8_LDA(dst, b, h) do { _Pragma("unroll") for (int m = 0; m < 4; ++m) _Pragma("unroll") for (int k = 0; k < 2; ++k) dst[m][k] = *(const PG8_LAS bf16x8*)(lds + PG8_SA(b, h) + aoff + m * 2048 + k * 1024); } while (0)
#define PG8_LDB(dst, b, h) do { _Pragma("unroll") for (int n = 0; n < 2; ++n) _Pragma("unroll") for (int k = 0; k < 2; ++k) dst[n][k] = *(const PG8_LAS bf16x8*)(lds + PG8_SB(b, h) + boff + n * 2048 + k * 1024); } while (0)
#define PG8_MMA(ai, bj, At, Bt) do { if (HALFM && (ai) == 1) break; __builtin_amdgcn_s_setprio(1); _Pragma("unroll") for (int m = 0; m < 4; ++m) _Pragma("unroll") for (int n = 0; n < 2; ++n) _Pragma("unroll") for (int k = 0; k < 2; ++k) \
        acc[ai][bj][m][n] = __builtin_amdgcn_mfma_f32_16x16x32_bf16(Bt[n][k], At[m][k], acc[ai][bj][m][n], 0, 0, 0); __builtin_amdgcn_s_setprio(0); } while (0)
#define PG8_WAIT_V(n) asm volatile("s_waitcnt vmcnt(" #n ")" ::: "memory")
#define PG8_WAIT_L(n) asm volatile("s_waitcnt lgkmcnt(" #n ")" ::: "memory")
#define PG8_BAR __builtin_amdgcn_s_barrier()
#define PG8_SCHED __builtin_amdgcn_sched_barrier(0)
    Unit cur, nxt; int ui = 0;
    if (!S.next(0, cur)) return;
    f32x4 acc[2][2][4][2];
#pragma unroll
    for (int a = 0; a < 2; ++a)
#pragma unroll
        for (int b = 0; b < 2; ++b)
#pragma unroll
            for (int m = 0; m < 4; ++m)
#pragma unroll
                for (int n = 0; n < 2; ++n) acc[a][b][m][n] = (f32x4){0.f, 0.f, 0.f, 0.f};
    bf16x8 At[4][2], B0[2][2], B1[2][2];
    const char* cA = (const char*)g.A + (size_t)cur.pm * tstep; const char* cB = (const char*)g.Bt + (size_t)cur.pn * tstep;
    S.a_ready(cur);
    if constexpr (SP2) {
        PG8_STAGE(PG8_SB(0, 0), cB, voffB); PG8_STAGE(PG8_SB(0, 1), cB + hstep, voffB); PG8_STAGE(PG8_SA(0, 0), cA, voffA); PG8_STAGE(PG8_SA(0, 1), cA + hstep, voffA);
        if (wr == 1) PG8_BAR;
        PG8_WAIT_V(2); PG8_BAR;
        PG8_STAGE(PG8_SB(1, 0), cB + kstep, voffB); PG8_STAGE(PG8_SA(1, 0), cA + kstep, voffA); PG8_STAGE(PG8_SB(1, 1), cB + hstep + kstep, voffB);
        PG8_WAIT_V(6); PG8_BAR;
    } else {
        PG8_STAGE(PG8_SB(0, 0), cB, voffB); PG8_STAGE(PG8_SA(0, 0), cA, voffA); PG8_STAGE(PG8_SB(0, 1), cB + hstep, voffB); PG8_STAGE(PG8_SA(0, 1), cA + hstep, voffA);
        if (wr == 1) PG8_BAR;
        PG8_WAIT_V(4); PG8_BAR;
        PG8_STAGE(PG8_SB(1, 0), cB + kstep, voffB); PG8_STAGE(PG8_SA(1, 0), cA + kstep, voffA); PG8_STAGE(PG8_SB(1, 1), cB + hstep + kstep, voffB);
        PG8_WAIT_V(6); PG8_BAR;
    }
    for (;;) {
        const bool has_next = S.next(ui + 1, nxt);
        const char* nA = has_next ? (const char*)g.A + (size_t)nxt.pm * tstep : cA; const char* nB = has_next ? (const char*)g.Bt + (size_t)nxt.pn * tstep : cB;
        for (int t = 0; t < nt; t += 2) {
            const bool last = (t == nt - 2);
            const char* a1 = cA + (size_t)(t + 1) * kstep;
            const char* a2 = last ? nA : cA + (size_t)(t + 2) * kstep; const char* b2 = last ? nB : cB + (size_t)(t + 2) * kstep;
            const char* a3 = a2 + kstep; const char* b3 = b2 + kstep;
            if (last && has_next) S.a_ready(nxt);
            if constexpr (SP2) {
            PG8_LDB(B0, 0, 0); PG8_LDB(B1, 0, 1); PG8_SCHED; PG8_LDA(At, 0, 0); PG8_STAGE(PG8_SA(1, 1), a1 + hstep, voffA);
            PG8_WAIT_V(8); PG8_WAIT_L(0); PG8_BAR; PG8_MMA(0, 0, At, B0); PG8_MMA(0, 1, At, B1); PG8_BAR; PG8_SCHED;
            PG8_LDA(At, 0, 1); PG8_STAGE(PG8_SB(0, 0), b2, voffB); PG8_STAGE(PG8_SB(0, 1), b2 + hstep, voffB); PG8_STAGE(PG8_SA(0, 0), a2, voffA);
            PG8_WAIT_V(8); PG8_WAIT_L(0); PG8_BAR; PG8_MMA(1, 0, At, B0); PG8_MMA(1, 1, At, B1); PG8_BAR; PG8_SCHED;
            PG8_LDB(B0, 1, 0); PG8_LDB(B1, 1, 1); PG8_SCHED; PG8_LDA(At, 1, 0); PG8_STAGE(PG8_SA(0, 1), a2 + hstep, voffA);
            PG8_WAIT_V(8); PG8_WAIT_L(0); PG8_BAR; PG8_MMA(0, 0, At, B0); PG8_MMA(0, 1, At, B1); PG8_BAR; PG8_SCHED;
            PG8_LDA(At, 1, 1); PG8_STAGE(PG8_SB(1, 0), b3, voffB); PG8_STAGE(PG8_SB(1, 1), b3 + hstep, voffB); PG8_STAGE(PG8_SA(1, 0), a3, voffA);
            PG8_WAIT_V(8); PG8_WAIT_L(0); PG8_BAR; PG8_MMA(1, 0, At, B0); PG8_MMA(1, 1, At, B1); PG8_BAR; PG8_SCHED;
            } else {
            PG8_LDB(B0, 0, 0); PG8_SCHED; PG8_LDA(At, 0, 0); PG8_STAGE(PG8_SA(1, 1), a1 + hstep, voffA);
            PG8_WAIT_L(8); PG8_BAR; PG8_WAIT_L(0); PG8_MMA(0, 0, At, B0); PG8_BAR; PG8_SCHED;
            PG8_LDB(B1, 0, 1); PG8_STAGE(PG8_SB(0, 0), b2, voffB);
            PG8_BAR; PG8_WAIT_L(0); PG8_MMA(0, 1, At, B1); PG8_BAR;
            PG8_LDA(At, 0, 1); PG8_STAGE(PG8_SA(0, 0), a2, voffA);
            PG8_BAR; PG8_WAIT_L(0); PG8_MMA(1, 0, At, B0); PG8_BAR; PG8_SCHED;
            PG8_STAGE(PG8_SB(0, 1), b2 + hstep, voffB);
            PG8_WAIT_V(6); PG8_BAR; PG8_MMA(1, 1, At, B1); PG8_BAR;
            PG8_LDB(B0, 1, 0); PG8_SCHED; PG8_LDA(At, 1, 0); PG8_STAGE(PG8_SA(0, 1), a2 + hstep, voffA);
            PG8_WAIT_L(8); PG8_BAR; PG8_WAIT_L(0); PG8_MMA(0, 0, At, B0); PG8_BAR; PG8_SCHED;
            PG8_LDB(B1, 1, 1); PG8_STAGE(PG8_SB(1, 0), b3, voffB);
            PG8_BAR; PG8_WAIT_L(0); PG8_MMA(0, 1, At, B1); PG8_BAR;
            PG8_LDA(At, 1, 1); PG8_STAGE(PG8_SA(1, 0), a3, voffA);
            PG8_BAR; PG8_WAIT_L(0); PG8_MMA(1, 0, At, B0); PG8_BAR; PG8_SCHED;
            PG8_STAGE(PG8_SB(1, 1), b3 + hstep, voffB);
            PG8_WAIT_V(6); PG8_BAR; PG8_MMA(1, 1, At, B1); PG8_BAR;
            }
        }
        if constexpr (ALIGN_EPI) { if (wr == 0) PG8_BAR; }
        if constexpr (!Epi::AFTER_DRAIN) { E(acc, cur, wr, wc, fr, fq); S.done(cur); }
        if (!has_next) break;
#pragma unroll
        for (int a = 0; a < 2; ++a)
#pragma unroll
            for (int b = 0; b < 2; ++b)
#pragma unroll
                for (int m = 0; m < 4; ++m)
#pragma unroll
                    for (int n = 0; n < 2; ++n) acc[a][b][m][n] = (f32x4){0.f, 0.f, 0.f, 0.f};
        cur = nxt; cA = nA; cB = nB; ++ui;
        if constexpr (ALIGN_EPI) { if (wr == 1) PG8_BAR; }
    }
    PG8_WAIT_V(0);
    if constexpr (!ALIGN_EPI) { if (wr == 0) PG8_BAR; }
    PG8_BAR;
    if constexpr (Epi::AFTER_DRAIN) { E.fused(acc, cur, wr, wc, fr, fq, lds, wid, lane); S.done(cur); }
#undef PG8_SA
#undef PG8_SB
#undef PG8_STAGE
#undef PG8_LDA
#undef PG8_LDB
#undef PG8_MMA
#undef PG8_WAIT_V
#undef PG8_WAIT_L
#undef PG8_BAR
#undef PG8_SCHED
}
}

#define LAS __attribute__((address_space(3)))
typedef unsigned short bf16_t;
typedef short bf16x8 __attribute__((ext_vector_type(8)));
typedef short s16x4 __attribute__((ext_vector_type(4)));
typedef float f32x4 __attribute__((ext_vector_type(4)));
typedef float f32x2 __attribute__((ext_vector_type(2)));
typedef float f32x16 __attribute__((ext_vector_type(16)));
typedef unsigned u32x4 __attribute__((ext_vector_type(4)));
typedef unsigned u32x2 __attribute__((ext_vector_type(2)));
typedef __bf16 bf16x2_t __attribute__((ext_vector_type(2)));

constexpr int DM = 1024, NLAT = 16384, NCTX = 4096, MROWS = 20480, DFF = 2816;
constexpr int NQ_E = 2304, NQ_O = 3072;
constexpr float EPS = 1e-6f;
constexpr float LOG2E = 1.4426950408889634f;
constexpr float SCL2 = 0.125f * LOG2E;

constexpr size_t MiB = 1u << 20;
constexpr size_t WS_BAR = 65536, WS_BAR_BYTES = 16384;
constexpr size_t WS_ROPE = 4096;
constexpr size_t WS_MOD = 1 * MiB;
constexpr size_t WS_W13T = 4 * MiB;
constexpr size_t WS_W2T = 92 * MiB;
constexpr size_t WS_WINAB = 136 * MiB;
constexpr size_t WS_WOUTAB = 145 * MiB;
constexpr size_t WS_WINC = 149 * MiB;
constexpr size_t WS_WOUTC = 161 * MiB;
constexpr size_t WS_CAK = 165 * MiB, WS_CAV = 167 * MiB, WS_CBK = 169 * MiB, WS_CBV = 177 * MiB, WS_CCK = 185 * MiB, WS_CCV = 201 * MiB;
constexpr size_t WS_X = 217 * MiB;
constexpr size_t WS_H = 297 * MiB;
constexpr size_t WS_O = 337 * MiB;
constexpr size_t WS_U = 377 * MiB;
constexpr size_t WS_ROWSS = 3 * MiB;
constexpr size_t WS_BIASV = 497 * MiB;
constexpr size_t WS_END = 500 * MiB;

constexpr size_t OUT_YP = 0, OUT_YS = 4194304, OUT_AK = 20971520, OUT_AV = 22020096, OUT_BK = 23068672, OUT_BV = 27262976, OUT_CK = 31457280, OUT_CV = 39845888;

constexpr int LDS_BYTES = 131072 + 1024;

__device__ __forceinline__ unsigned pk2(float lo, float hi) { f32x2 v = {lo, hi}; bf16x2_t b = __builtin_convertvector(v, bf16x2_t); return __builtin_bit_cast(unsigned, b); }
__device__ __forceinline__ float wave_sum(float v) {
#pragma unroll
    for (int o = 1; o < 64; o <<= 1) v += __shfl_xor(v, o);
    return v;
}
__device__ __forceinline__ float fast_exp2(float x) { return __builtin_amdgcn_exp2f(x); }
__device__ __forceinline__ float fast_rcp(float x) { return __builtin_amdgcn_rcpf(x); }

struct Args { const float* in[26]; float* out; unsigned char* ws; int ph_lo, ph_hi; };
#define GAS __attribute__((address_space(1)))
__device__ __forceinline__ const float* inp(const Args& a, int i) { asm volatile("" : "+s"(i)); GAS const float* g = (GAS const float*)a.in[i]; return (const float*)g; }
__device__ __forceinline__ unsigned char* wsp(const Args& a) { GAS unsigned char* g = (GAS unsigned char*)a.ws; asm volatile("" : "+s"(g)); return (unsigned char*)g; }
__device__ __forceinline__ float* outp(const Args& a) { GAS float* g = (GAS float*)a.out; return (float*)g; }

struct EpiSwiGLU {
    static constexpr bool PERM = true, AFTER_DRAIN = false;
    bf16_t* U; const float* rowss; const float* bias;
    __device__ __forceinline__ void operator()(const f32x4 (&acc)[2][2][4][2], const pg8::Unit& u, int wr, int wc, int fr, int fq) const {
        const int row0 = u.pm * 256 + wr * 64 + fr, col0 = u.pn * 128 + wc * 32 + 8 * fq;
        const int mi = u.pm < 64 ? (u.pm >> 3) : 8;
        const float* bp = bias + (size_t)mi * 5632 + u.pn * 256 + wc * 32 + 8 * fq;
        f32x4 b4[2][2];
#pragma unroll
        for (int bj = 0; bj < 2; ++bj)
#pragma unroll
            for (int n = 0; n < 2; ++n) b4[bj][n] = *(const f32x4*)(bp + bj * 128 + 4 * n);
#pragma unroll
        for (int ai = 0; ai < 2; ++ai)
#pragma unroll
            for (int m = 0; m < 4; ++m) {
                const int row = row0 + ai * 128 + m * 16;
                const float rstd = rsqrtf(rowss[row] * (1.f / DM) + EPS);
                bf16_t* rowp = U + (size_t)row * DFF + col0;
                float o[8];
#pragma unroll
                for (int n = 0; n < 2; ++n)
#pragma unroll
                    for (int i = 0; i < 4; ++i) { const float a = acc[ai][0][m][n][i] * rstd + b4[0][n][i], b = acc[ai][1][m][n][i] * rstd + b4[1][n][i];
                        o[n * 4 + i] = a * fast_rcp(1.f + fast_exp2(-a * LOG2E)) * b; }
                u32x4 w; w.x = pk2(o[0], o[1]); w.y = pk2(o[2], o[3]); w.z = pk2(o[4], o[5]); w.w = pk2(o[6], o[7]);
                *(u32x4*)rowp = w;
            }
    }
};
struct EpiResid {
    static constexpr bool PERM = true, AFTER_DRAIN = false;
    float* x; const float* gate; float coef;
    bf16_t* hb; const float* fnw; const float* fscale; float* rowss;
    int roff, nai;
    __device__ __forceinline__ void operator()(const f32x4 (&acc)[2][2][4][2], const pg8::Unit& u, int wr, int wc, int fr, int fq) const {
        const int mi = u.pm < 64 ? (u.pm >> 3) : 8;
        const int col0 = u.pn * 256 + wc * 32 + 8 * fq;
        const float* g = gate + (size_t)mi * 9216 + col0;
        const float* fs = fscale + (size_t)mi * 9216 + col0;
        const float* fw = fnw + col0;
#pragma unroll
        for (int ai = 0; ai < 2; ++ai) {
            if (ai >= nai) break;
#pragma unroll
            for (int m = 0; m < 4; ++m) {
                const int row = u.pm * 256 + roff + ai * 128 + wr * 64 + m * 16 + fr;
                float* p = x + (size_t)row * DM + col0;
                float ss = 0.f;
#pragma unroll
                for (int bj = 0; bj < 2; ++bj) {
                    f32x4 xv[2];
#pragma unroll
                    for (int n = 0; n < 2; ++n) {
                        const f32x4 g4 = *(const f32x4*)(g + bj * 128 + 4 * n) * coef;
                        xv[n] = *(const f32x4*)(p + bj * 128 + 4 * n) + g4 * acc[ai][bj][m][n];
                        *(f32x4*)(p + bj * 128 + 4 * n) = xv[n];
                        ss += (xv[n][0] * xv[n][0] + xv[n][1] * xv[n][1]) + (xv[n][2] * xv[n][2] + xv[n][3] * xv[n][3]);
                    }
                    if (hb) {
#pragma unroll
                        for (int n = 0; n < 2; ++n) xv[n] = xv[n] * (*(const f32x4*)(fw + bj * 128 + 4 * n)) * (1.f + *(const f32x4*)(fs + bj * 128 + 4 * n));
                        u32x4 w; w.x = pk2(xv[0][0], xv[0][1]); w.y = pk2(xv[0][2], xv[0][3]); w.z = pk2(xv[1][0], xv[1][1]); w.w = pk2(xv[1][2], xv[1][3]);
                        *(u32x4*)(hb + (size_t)row * DM + col0 + bj * 128) = w;
                    }
                }
                if (hb) {
                    ss += __shfl_xor(ss, 16); ss += __shfl_xor(ss, 32);
                    if (fq == 0) unsafeAtomicAdd(rowss + row, ss);
                }
                asm volatile("" ::: "memory");
            }
        }
    }
};
__device__ __forceinline__ void small_gemm_resid(LAS unsigned char* lds, const bf16_t* A, const bf16_t* Wt, const int K, const int c, const EpiResid& E) {
    const int tid = opaque_tid(), lane = tid & 63, wid = __builtin_amdgcn_readfirstlane(tid >> 6), wr = wid >> 2, wc = wid & 3, fr = lane & 15, fq = lane >> 4;
    const int tm = c >> 3, tn = c & 7;
    const char* Ag = (const char*)(A + (size_t)(NLAT + tm * 128) * K);
    const char* Bg = (const char*)(Wt + (size_t)(tn * 128) * K);
    const int nt = K >> 6;
    unsigned voff[2];
#pragma unroll
    for (int i = 0; i < 2; ++i) { int R, C; pg8::stage_rc(tid * 16 + i * 8192, R, C); voff[i] = (unsigned)(R * K + C) * 2u; }
    const unsigned ldsw = (unsigned)wid * 1024u;
    const int aoff = pg8::lds_byte(wr * 64 + fr, fq * 8), boff = pg8::lds_byte(wc * 32 + fr, fq * 8);
#define SG_STAGE(slot_, kt_) do { _Pragma("unroll") for (int i_ = 0; i_ < 2; ++i_) { \
        __builtin_amdgcn_global_load_lds((const unsigned*)(Ag + (size_t)(kt_) * 128 + voff[i_]), (LAS unsigned*)(lds + (slot_) * 32768 + ldsw + i_ * 8192), 16, 0, 0); \
        __builtin_amdgcn_global_load_lds((const unsigned*)(Bg + (size_t)(kt_) * 128 + voff[i_]), (LAS unsigned*)(lds + (slot_) * 32768 + 16384 + ldsw + i_ * 8192), 16, 0, 0); } } while (0)
    f32x4 acc[4][2];
#pragma unroll
    for (int m = 0; m < 4; ++m)
#pragma unroll
        for (int n = 0; n < 2; ++n) acc[m][n] = (f32x4){0.f, 0.f, 0.f, 0.f};
    SG_STAGE(0, 0);
    if (nt > 1) SG_STAGE(1, 1);
    int slot = 0;
    for (int kt = 0; kt < nt; ++kt) {
        if (kt + 1 < nt) asm volatile("s_waitcnt vmcnt(4)" ::: "memory"); else asm volatile("s_waitcnt vmcnt(0)" ::: "memory");
        __builtin_amdgcn_s_barrier(); asm volatile("" ::: "memory");
        const int s2 = slot >= 1 ? slot - 1 : 2;
        if (kt + 2 < nt) SG_STAGE(s2, kt + 2);
        const LAS unsigned char* base = lds + slot * 32768;
        bf16x8 At[4][2], Bt[2][2];
#pragma unroll
        for (int n = 0; n < 2; ++n)
#pragma unroll
            for (int k = 0; k < 2; ++k) Bt[n][k] = *(const LAS bf16x8*)(base + 16384 + boff + n * 2048 + k * 1024);
#pragma unroll
        for (int m = 0; m < 4; ++m)
#pragma unroll
            for (int k = 0; k < 2; ++k) At[m][k] = *(const LAS bf16x8*)(base + aoff + m * 2048 + k * 1024);
#pragma unroll
        for (int m = 0; m < 4; ++m)
#pragma unroll
            for (int n = 0; n < 2; ++n)
#pragma unroll
                for (int k = 0; k < 2; ++k) acc[m][n] = __builtin_amdgcn_mfma_f32_16x16x32_bf16(Bt[n][k], At[m][k], acc[m][n], 0, 0, 0);
        asm volatile("s_waitcnt lgkmcnt(0)" ::: "memory");
        slot = slot == 2 ? 0 : slot + 1;
    }
#undef SG_STAGE
    asm volatile("s_waitcnt vmcnt(0)" ::: "memory"); __builtin_amdgcn_s_barrier(); asm volatile("" ::: "memory");
    const float* g = E.gate + (size_t)8 * 9216; const float* fs = E.fscale + (size_t)8 * 9216;
#pragma unroll
    for (int m = 0; m < 4; ++m) {
        const int row = NLAT + tm * 128 + 64 * wr + 16 * m + fr;
        float ss = 0.f;
#pragma unroll
        for (int n = 0; n < 2; ++n) {
            const int col = tn * 128 + 32 * wc + 16 * n + 4 * fq;
            float* p = E.x + (size_t)row * DM + col;
            f32x4 xv = *(const f32x4*)p + (*(const f32x4*)(g + col) * E.coef) * acc[m][n];
            *(f32x4*)p = xv;
            ss += (xv[0] * xv[0] + xv[1] * xv[1]) + (xv[2] * xv[2] + xv[3] * xv[3]);
            if (E.hb) {
                xv = xv * (*(const f32x4*)(E.fnw + col)) * (1.f + *(const f32x4*)(fs + col));
                u32x2 w; w.x = pk2(xv[0], xv[1]); w.y = pk2(xv[2], xv[3]);
                *(u32x2*)(E.hb + (size_t)row * DM + col) = w;
            }
        }
        if (E.hb) { ss += __shfl_xor(ss, 16); ss += __shfl_xor(ss, 32); if (fq == 0) unsafeAtomicAdd(E.rowss + row, ss); }
    }
    __syncthreads();
}
struct RangeOrder {
    pg8::StaticOrder S; int lo, hi;
    __device__ __forceinline__ bool next(int i, pg8::Unit& u) const { return (lo + i < hi) && S.next(lo + i, u); }
    __device__ __forceinline__ void a_ready(const pg8::Unit&) const {}
    __device__ __forceinline__ void done(const pg8::Unit&) const {}
};
struct OneUnit {
    int pm, pn;
    __device__ __forceinline__ bool next(int i, pg8::Unit& u) const { if (i) return false; u.pm = pm; u.pn = pn; return true; }
    __device__ __forceinline__ void a_ready(const pg8::Unit&) const {}
    __device__ __forceinline__ void done(const pg8::Unit&) const {}
};
struct EpiQKV {
    static constexpr bool PERM = true, AFTER_DRAIN = false;
    bf16_t* Q; int ldq; int even; int e; const float* qn; const float* kn; const f32x2* rope; float* out; const float* rowss; const float* bias;
    __device__ __forceinline__ void operator()(const f32x4 (&acc)[2][2][4][2], const pg8::Unit& u, int wr, int wc, int fr, int fq) const {
        const int hu = 4 * u.pn + wc;
        const bool lat = u.pm < 64;
        const float* bp = bias + (size_t)(u.pm < 64 ? (u.pm >> 3) : 8) * 5632 + u.pn * 256 + wc * 32 + 8 * fq;
        const int d0 = 8 * fq + 16 * (fq >> 1);
        bool do_rope; const float* nw = nullptr; float* ob = nullptr; int ow = 0;
        const bool isq = even ? (hu < 8 || (hu >= 12 && hu < 20)) : (hu < 16);
        if (even) {
            do_rope = hu < 10;
            if (hu < 8) nw = qn; else if (hu < 10) { nw = kn; ob = out + OUT_AK + 64 * (hu - 8); ow = 128; }
            else if (hu < 12) { ob = out + OUT_AV + 64 * (hu - 10); ow = 128; }
            else if (hu < 20) {}
            else if (hu < 28) { ob = out + OUT_BK + 64 * (hu - 20); ow = 512; }
            else { ob = out + OUT_BV + 64 * (hu - 28); ow = 512; }
        } else {
            do_rope = hu < 32;
            if (hu < 16) {} else if (hu < 32) { ob = out + OUT_CK + 64 * (hu - 16); ow = 1024; }
            else { ob = out + OUT_CV + 64 * (hu - 32); ow = 1024; }
        }
        f32x4 w4[2][2], b4[2][2];
#pragma unroll
        for (int bj = 0; bj < 2; ++bj)
#pragma unroll
            for (int n = 0; n < 2; ++n) { b4[bj][n] = *(const f32x4*)(bp + bj * 128 + 4 * n); if (nw) w4[bj][n] = *(const f32x4*)(nw + d0 + 16 * bj + 4 * n); }
#pragma unroll
        for (int ai = 0; ai < 2; ++ai)
#pragma unroll
            for (int m = 0; m < 4; ++m) {
                const int row = u.pm * 256 + ai * 128 + wr * 64 + m * 16 + fr;
                f32x4 v[2][2];
                const float rstd0 = rsqrtf(rowss[row] * (1.f / DM) + EPS);
#pragma unroll
                for (int bj = 0; bj < 2; ++bj)
#pragma unroll
                    for (int n = 0; n < 2; ++n) v[bj][n] = acc[ai][bj][m][n] * rstd0 + b4[bj][n];
                if (nw) {
                    float ss = 0.f;
#pragma unroll
                    for (int bj = 0; bj < 2; ++bj)
#pragma unroll
                        for (int n = 0; n < 2; ++n) ss += (v[bj][n][0] * v[bj][n][0] + v[bj][n][1] * v[bj][n][1]) + (v[bj][n][2] * v[bj][n][2] + v[bj][n][3] * v[bj][n][3]);
                    ss += __shfl_xor(ss, 16); ss += __shfl_xor(ss, 32);
                    const float rstd = rsqrtf(ss * (1.f / 64.f) + EPS);
#pragma unroll
                    for (int bj = 0; bj < 2; ++bj)
#pragma unroll
                        for (int n = 0; n < 2; ++n) v[bj][n] = v[bj][n] * rstd * w4[bj][n];
                }
                if (do_rope && lat) {
                    const int t = row & 2047;
                    const int pos = (fq < 2) ? (t >> 6) : (t & 63);
                    const f32x2* rp = rope + pos * 16 + 8 * (fq & 1);
#pragma unroll
                    for (int n = 0; n < 2; ++n)
#pragma unroll
                        for (int i = 0; i < 4; ++i) { const f32x2 cs = rp[4 * n + i]; const float x1 = v[0][n][i], x2 = v[1][n][i];
                            v[0][n][i] = x1 * cs.x - x2 * cs.y; v[1][n][i] = x2 * cs.x + x1 * cs.y; }
                }
                bf16_t* qp = Q + (size_t)row * ldq + 64 * hu + d0;
                if (isq) {
#pragma unroll
                    for (int bj = 0; bj < 2; ++bj)
#pragma unroll
                        for (int n = 0; n < 2; ++n) v[bj][n] = v[bj][n] * SCL2;
                }
#pragma unroll
                for (int bj = 0; bj < 2; ++bj) { u32x4 w; w.x = pk2(v[bj][0][0], v[bj][0][1]); w.y = pk2(v[bj][0][2], v[bj][0][3]); w.z = pk2(v[bj][1][0], v[bj][1][1]); w.w = pk2(v[bj][1][2], v[bj][1][3]);
                    *(u32x4*)(qp + 16 * bj) = w; }
                if (ob && !lat) {
                    const int cr = row - NLAT, b = cr >> 8, s = cr & 255;
                    float* op = ob + (size_t)((b * 2 + e) * 256 + s) * ow + d0;
#pragma unroll
                    for (int bj = 0; bj < 2; ++bj)
#pragma unroll
                        for (int n = 0; n < 2; ++n) *(f32x4*)(op + 16 * bj + 4 * n) = v[bj][n];
                }
            }
    }
};

__device__ __forceinline__ void transpose_item(const float* W, int K, int N, bf16_t* WT, int k0, int n0, int drow, LAS float* scr, int lane, int dhi = -1) {
#pragma unroll 8
    for (int i = 0; i < 32; ++i) { const int kk = 2 * i + (lane >> 5); scr[kk * 33 + (lane & 31)] = __builtin_nontemporal_load(W + (size_t)(k0 + kk) * N + n0 + (lane & 31)); }
    asm volatile("s_waitcnt lgkmcnt(0)" ::: "memory");
    const int c = lane & 7;
#pragma unroll
    for (int j = 0; j < 4; ++j) { const int n = (lane >> 3) + 8 * j; const LAS float* s = scr + (8 * c) * 33 + n;
        u32x4 o; o.x = pk2(s[0 * 33], s[1 * 33]); o.y = pk2(s[2 * 33], s[3 * 33]); o.z = pk2(s[4 * 33], s[5 * 33]); o.w = pk2(s[6 * 33], s[7 * 33]);
        const int dr = (n < 16 || dhi < 0) ? drow + n : dhi + n - 16;
        *(u32x4*)(WT + (size_t)dr * K + k0 + 8 * c) = o; }
    asm volatile("s_waitcnt lgkmcnt(0)" ::: "memory");
}
__device__ __forceinline__ int qkv_drow(int n0) { const int hu = n0 >> 6, g = (n0 >> 5) & 1; return 256 * (hu >> 2) + 32 * (hu & 3) + 16 * g; }

__device__ __forceinline__ void cvt_seg(const float* src, bf16_t* dst, int n4, int gt, int NT) {
    for (int i = gt; i < n4; i += NT) { const f32x4 v = __builtin_nontemporal_load((const f32x4*)src + i); u32x2 w; w.x = pk2(v[0], v[1]); w.y = pk2(v[2], v[3]); ((u32x2*)dst)[i] = w; }
}

__device__ __forceinline__ void prologue_phase(const Args& a, LAS unsigned char* lds, int vcu, int G) {
    const int tid = opaque_tid(), lane = tid & 63, wave = __builtin_amdgcn_readfirstlane(tid >> 6);
    unsigned char* ws = wsp(a);
    {
        LAS float* sc = (LAS float*)lds;
        LAS f32x4* red = (LAS f32x4*)(lds + 36864);
        const int first = G - 1 - (int)blockIdx.x;
        if (first < 144) {
            for (int i = tid; i < 9 * 1024; i += 512) { const int r = i >> 10, k = i & 1023; const float cv = r < 8 ? inp(a, 8)[r * 1024 + k] : inp(a, 9)[k]; sc[i] = cv / (1.f + __expf(-cv)); }
            __syncthreads();
            for (int item = first; item < 144; item += G) {
                const int l = item / 36, cb = item % 36, col = cb * 256 + lane * 4;
                const float* wp = inp(a, 10) + ((size_t)l * 1024 + wave * 128) * 9216 + col;
                f32x4 acc[9];
#pragma unroll
                for (int r = 0; r < 9; ++r) acc[r] = (f32x4){0.f, 0.f, 0.f, 0.f};
#pragma unroll 4
                for (int k = 0; k < 128; ++k) {
                    const f32x4 wv = __builtin_nontemporal_load((const f32x4*)(wp + (size_t)k * 9216));
#pragma unroll
                    for (int r = 0; r < 9; ++r) acc[r] += wv * sc[r * 1024 + wave * 128 + k];
                }
#pragma unroll
                for (int r = 0; r < 9; ++r) red[(wave * 9 + r) * 64 + lane] = acc[r];
                __syncthreads();
                for (int o = tid; o < 9 * 64; o += 512) {
                    const int r = o >> 6, ln = o & 63;
                    f32x4 s = *(const f32x4*)(inp(a, 11) + l * 9216 + cb * 256 + ln * 4);
#pragma unroll
                    for (int w = 0; w < 8; ++w) s += red[(w * 9 + r) * 64 + ln];
                    *(f32x4*)((float*)(ws + WS_MOD) + ((size_t)l * 9 + r) * 9216 + cb * 256 + ln * 4) = s;
                }
                __syncthreads();
            }
        }
        __syncthreads();
    }
    {
        LAS float* scr = (LAS float*)(lds + wave * 8704);
        const int gw = vcu * 8 + wave, NGW = G * 8;
        for (int it = gw; it < 41216; it += NGW) {
            if (it < 33792) {
                const int lf = it / 4224, r = it % 4224, which = r / 1408, q = r % 1408;
                if (which < 2) { const int kb = q / 88, nb = q % 88, n0 = 32 * nb; const int drow = 256 * (n0 >> 7) + (n0 & 127) + 128 * which;
                    transpose_item(inp(a, which == 0 ? 13 : 14) + (size_t)lf * 1024 * DFF, 1024, DFF, (bf16_t*)(ws + WS_W13T) + (size_t)lf * 5632 * 1024, 64 * kb, n0, drow, scr, lane); }
                else { const int kb = q / 32, nb = q % 32;
                    transpose_item(inp(a, 15) + (size_t)lf * DFF * 1024, DFF, 1024, (bf16_t*)(ws + WS_W2T) + (size_t)lf * 1024 * DFF, 64 * kb, 32 * nb, 32 * nb, scr, lane); }
            } else {
                int r = it - 33792;
                if (r < 2304) { const int e = r / 1152, q = r % 1152, kb = q / 72, nb = q % 72;
                    transpose_item(inp(a, 16) + (size_t)e * 1024 * NQ_E, 1024, NQ_E, (bf16_t*)(ws + WS_WINAB) + (size_t)e * NQ_E * 1024, 64 * kb, 32 * nb, qkv_drow(32 * nb), scr, lane, qkv_drow(32 * nb) + 128); continue; }
                r -= 2304;
                if (r < 3072) { const int e = r / 1536, q = r % 1536, kb = q / 96, nb = q % 96;
                    transpose_item(inp(a, 21) + (size_t)e * 1024 * NQ_O, 1024, NQ_O, (bf16_t*)(ws + WS_WINC) + (size_t)e * NQ_O * 1024, 64 * kb, 32 * nb, qkv_drow(32 * nb), scr, lane, qkv_drow(32 * nb) + 128); continue; }
                r -= 3072;
                if (r < 1024) { const int e = r / 512, q = r % 512, kb = q / 32, nb = q % 32;
                    transpose_item(inp(a, 17) + (size_t)e * 1024 * 1024, 1024, 1024, (bf16_t*)(ws + WS_WOUTAB) + (size_t)e * 1024 * 1024, 64 * kb, 32 * nb, 32 * nb, scr, lane); continue; }
                r -= 1024;
                { const int e = r / 512, q = r % 512, kb = q / 32, nb = q % 32;
                    transpose_item(inp(a, 22) + (size_t)e * 1024 * 1024, 1024, 1024, (bf16_t*)(ws + WS_WOUTC) + (size_t)e * 1024 * 1024, 64 * kb, 32 * nb, 32 * nb, scr, lane); }
            }
        }
    }
    {
        const int gt = blockIdx.x * 512 + tid, NT = G * 512;
        cvt_seg(inp(a, 2), (bf16_t*)(ws + WS_CAK), 1048576 / 4, gt, NT);
        cvt_seg(inp(a, 3), (bf16_t*)(ws + WS_CAV), 1048576 / 4, gt, NT);
        cvt_seg(inp(a, 4), (bf16_t*)(ws + WS_CBK), 4194304 / 4, gt, NT);
        cvt_seg(inp(a, 5), (bf16_t*)(ws + WS_CBV), 4194304 / 4, gt, NT);
        cvt_seg(inp(a, 6), (bf16_t*)(ws + WS_CCK), 8388608 / 4, gt, NT);
        cvt_seg(inp(a, 7), (bf16_t*)(ws + WS_CCV), 8388608 / 4, gt, NT);
        for (int i = gt; i < 12 * MROWS / 4; i += NT) ((f32x4*)(ws + WS_ROWSS))[i] = (f32x4){0.f, 0.f, 0.f, 0.f};
        if (gt < 1024) { const int pos = gt >> 4, f = gt & 15;
            const float inv = exp2f(-(float)f * (13.287712379549449f / 16.f));
            const float rev = (float)pos * inv * 0.15915494309189535f;
            f32x2 cs; cs.x = __builtin_amdgcn_cosf(rev); cs.y = __builtin_amdgcn_sinf(rev);
            ((f32x2*)(ws + WS_ROPE))[gt] = cs; }
    }
}

__device__ __forceinline__ void norm_phase(const Args& a, const float* nw, const float* modl, int vcu, int G) {
    const int tid = opaque_tid(), lane = tid & 63, wave = tid >> 6;
    float* xb = (float*)(wsp(a) + WS_X); bf16_t* hb = (bf16_t*)(wsp(a) + WS_H); float* rss = (float*)(wsp(a) + WS_ROWSS);
    for (int row = vcu * 8 + wave; row < MROWS; row += G * 8) {
        const float* xr = row < NLAT ? inp(a, 1) + (size_t)row * DM : inp(a, 0) + (size_t)(row - NLAT) * DM;
        f32x4 v[4]; float ss = 0.f;
#pragma unroll
        for (int j = 0; j < 4; ++j) { v[j] = ((const f32x4*)xr)[lane + 64 * j]; ss += (v[j][0] * v[j][0] + v[j][1] * v[j][1]) + (v[j][2] * v[j][2] + v[j][3] * v[j][3]); }
        ss = wave_sum(ss);
        if (lane == 0) rss[row] = ss;
#pragma unroll
        for (int j = 0; j < 4; ++j) ((f32x4*)(xb + (size_t)row * DM))[lane + 64 * j] = v[j];
        const int mi = row < NLAT ? (row >> 11) : 8;
        const float* sc = modl + (size_t)mi * 9216 + 1024;
#pragma unroll
        for (int j = 0; j < 4; ++j) {
            const int c4 = lane + 64 * j;
            const f32x4 o = v[j] * ((const f32x4*)nw)[c4] * (1.f + ((const f32x4*)sc)[c4]);
            u32x2 pw; pw.x = pk2(o[0], o[1]); pw.y = pk2(o[2], o[3]);
            ((u32x2*)(hb + (size_t)row * DM))[c4] = pw;
        }
    }
}
__device__ __forceinline__ void bias_phase(const Args& a, LAS unsigned char* lds, int G) {
    const int tid = opaque_tid(), lane = tid & 63, wave = tid >> 6;
    unsigned char* ws = wsp(a);
    LAS float* sh = (LAS float*)lds;
    int cur_g = -1;
    for (int it = blockIdx.x; it < 872; it += G) {
        int r = it, l = 0, sub = 0, base = 0;
        for (l = 0; l < 4; ++l) { const int nq = (l & 1) ? 48 : 36; const int tot = 176 + nq; if (r < tot) break; r -= tot; }
        { const int nq = (l & 1) ? 48 : 36; if (r < 88) { sub = 0; base = r; } else if (r < 88 + nq) { sub = 1; base = r - 88; } else { sub = 2; base = r - 88 - nq; } }
        const int g = l * 3 + sub;
        const bf16_t* Wt = sub == 1 ? ((l & 1) ? (const bf16_t*)(ws + WS_WINC) + (size_t)(l >> 1) * NQ_O * 1024 : (const bf16_t*)(ws + WS_WINAB) + (size_t)(l >> 1) * NQ_E * 1024)
                                    : (const bf16_t*)(ws + WS_W13T) + (size_t)(l * 2 + (sub >> 1)) * 5632 * 1024;
        if (g != cur_g) {
            __syncthreads();
            const float* modl = (const float*)(ws + WS_MOD) + (size_t)l * 9 * 9216 + (3 * sub) * 1024;
            for (int i = tid; i < 9 * 1024; i += 512) sh[i] = modl[(size_t)(i >> 10) * 9216 + (i & 1023)];
            __syncthreads();
            cur_g = g;
        }
        float* bo = (float*)(ws + WS_BIASV) + (size_t)g * 9 * 5632;
        for (int rr = 0; rr < 8; ++rr) {
            const int p = base * 64 + wave * 8 + rr;
            const u32x4 w0 = *(const u32x4*)(Wt + (size_t)p * 1024 + lane * 8), w1 = *(const u32x4*)(Wt + (size_t)p * 1024 + 512 + lane * 8);
            float wf[16];
#pragma unroll
            for (int q = 0; q < 4; ++q) { wf[2 * q] = __uint_as_float(w0[q] << 16); wf[2 * q + 1] = __uint_as_float(w0[q] & 0xffff0000u);
                                          wf[8 + 2 * q] = __uint_as_float(w1[q] << 16); wf[8 + 2 * q + 1] = __uint_as_float(w1[q] & 0xffff0000u); }
#pragma unroll
            for (int mi = 0; mi < 9; ++mi) {
                const LAS f32x4* s0 = (const LAS f32x4*)(sh + mi * 1024 + lane * 8); const LAS f32x4* s1 = (const LAS f32x4*)(sh + mi * 1024 + 512 + lane * 8);
                const f32x4 a0 = s0[0], a1 = s0[1], c0 = s1[0], c1 = s1[1];
                float acc = (wf[0] * a0[0] + wf[1] * a0[1]) + (wf[2] * a0[2] + wf[3] * a0[3]) + (wf[4] * a1[0] + wf[5] * a1[1]) + (wf[6] * a1[2] + wf[7] * a1[3])
                          + (wf[8] * c0[0] + wf[9] * c0[1]) + (wf[10] * c0[2] + wf[11] * c0[3]) + (wf[12] * c1[0] + wf[13] * c1[1]) + (wf[14] * c1[2] + wf[15] * c1[3]);
                acc = wave_sum(acc);
                if (lane == 0) bo[(size_t)mi * 5632 + p] = acc;
            }
        }
    }
    __syncthreads();
}
__device__ __forceinline__ void final_norm_phase(const Args& a, int vcu, int G) {
    const int tid = opaque_tid(), lane = tid & 63, wave = tid >> 6;
    const float* xb = (const float*)(wsp(a) + WS_X); const float* nw = inp(a, 25);
    for (int row = vcu * 8 + wave; row < MROWS; row += G * 8) {
        const float* xr = xb + (size_t)row * DM;
        float* orow = row < NLAT ? outp(a) + OUT_YS + (size_t)row * DM : outp(a) + OUT_YP + (size_t)(row - NLAT) * DM;
        f32x4 v[4]; float ss = 0.f;
#pragma unroll
        for (int j = 0; j < 4; ++j) { v[j] = ((const f32x4*)xr)[lane + 64 * j]; ss += (v[j][0] * v[j][0] + v[j][1] * v[j][1]) + (v[j][2] * v[j][2] + v[j][3] * v[j][3]); }
        const float rstd = rsqrtf(wave_sum(ss) * (1.f / DM) + EPS);
#pragma unroll
        for (int j = 0; j < 4; ++j) ((f32x4*)orow)[lane + 64 * j] = v[j] * rstd * ((const f32x4*)nw)[lane + 64 * j];
    }
}

struct KVSrc { const bf16_t* k; const bf16_t* v; int ks, vs; };
constexpr int AT_K = 0, AT_V = 24576, AT_BIAS = 57344;
__device__ __forceinline__ int crow(int r, int hi) { return (r & 3) + 8 * (r >> 2) + 4 * hi; }
typedef short v4i16_t __attribute__((ext_vector_type(4)));
__device__ __forceinline__ s16x4 vtr(const LAS unsigned char* p) { return __builtin_bit_cast(s16x4, __builtin_amdgcn_ds_read_tr16_b64_v4i16((LAS v4i16_t*)p)); }

__device__ __forceinline__ float xhalf_max(float m) {
    auto rr = __builtin_amdgcn_permlane32_swap(__float_as_uint(m), __float_as_uint(m), false, false);
    return fmaxf(__uint_as_float(rr[0]), __uint_as_float(rr[1]));
}
__device__ __forceinline__ void qk_tile(const LAS unsigned char* Kb, const int (&kl)[4], const bf16x8 (&qr)[4], f32x16& p0, f32x16& p1, const f32x16& cinit) {
    bf16x8 kf[8];
#pragma unroll
    for (int d0 = 0; d0 < 4; ++d0) { kf[2 * d0] = *(const LAS bf16x8*)(Kb + kl[d0]); kf[2 * d0 + 1] = *(const LAS bf16x8*)(Kb + kl[d0] + 512); }
    __builtin_amdgcn_sched_barrier(0);
    p0 = cinit; p1 = cinit;
#pragma unroll
    for (int d0 = 0; d0 < 4; ++d0) {
        p0 = __builtin_amdgcn_mfma_f32_32x32x16_bf16(kf[2 * d0], qr[d0], p0, 0, 0, 0);
        p1 = __builtin_amdgcn_mfma_f32_32x32x16_bf16(kf[2 * d0 + 1], qr[d0], p1, 0, 0, 0);
    }
}
template <int DV, bool NB>
__device__ __forceinline__ void sm_pv(f32x16& p0, f32x16& p1, const LAS unsigned char* Vb, f32x16 (&OT)[DV / 32], float& m_run, float& l_run, f32x16& negm, f32x16& LT,
                                      const bool masked, const LAS float* brow, const int c, const int cs, const int hi) {
    float ls0 = 0.f, ls1 = 0.f;
    if (NB) {
        float mn;
        if (masked) {
            int co = c - 4 * hi, cso = cs - 4 * hi; asm volatile("" : "+v"(co), "+v"(cso));
            const LAS float* bl = brow + (15 - co);
#pragma unroll
            for (int r = 0; r < 16; ++r) {
                const int kc0 = (r & 3) + 8 * (r >> 2), kc1 = kc0 + 32;
                const float b0 = bl[kc0], b1 = bl[kc1];
                p0[r] = ((unsigned)(kc0 - cso) < 16u) ? p0[r] + b0 : -1e30f;
                p1[r] = ((unsigned)(kc1 - cso) < 16u) ? p1[r] + b1 : -1e30f;
            }
        }
        float rm = fmaxf(p0[0], p1[0]);
#pragma unroll
        for (int r = 1; r < 16; ++r) rm = fmaxf(fmaxf(rm, p0[r]), p1[r]);
        rm = xhalf_max(rm);
        mn = fmaxf(m_run, rm);
#pragma unroll
        for (int r = 0; r < 16; ++r) { p0[r] = fast_exp2(p0[r] - mn); p1[r] = fast_exp2(p1[r] - mn); }
#pragma unroll
        for (int r = 0; r < 16; ++r) { ls0 += p0[r]; ls1 += p1[r]; }
        const float alpha = fast_exp2(m_run - mn);
        m_run = mn;
        l_run = l_run * alpha + (ls0 + ls1);
        if (__any(alpha != 1.f)) {
#pragma unroll
            for (int d = 0; d < DV / 32; ++d) OT[d] *= alpha;
        }
    } else {
        float rm = fmaxf(p0[0], p1[0]);
#pragma unroll
        for (int r = 1; r < 16; ++r) rm = fmaxf(fmaxf(rm, p0[r]), p1[r]);
        rm = xhalf_max(rm);
        if (__any(rm > 8.f)) {
            const float d = fmaxf(rm, 0.f);
            m_run += d;
#pragma unroll
            for (int r = 0; r < 16; ++r) { p0[r] -= d; p1[r] -= d; }
            const float alpha = fast_exp2(-d);
            LT *= alpha;
#pragma unroll
            for (int dd = 0; dd < DV / 32; ++dd) OT[dd] *= alpha;
#pragma unroll
            for (int r = 0; r < 16; ++r) negm[r] = -m_run;
        }
#pragma unroll
        for (int r = 0; r < 16; ++r) { p0[r] = fast_exp2(p0[r]); p1[r] = fast_exp2(p1[r]); }
    }
    bf16x8 pa[4];
#pragma unroll
    for (int k = 0; k < 4; ++k) {
        u32x4 w;
        if (k < 2) { w.x = pk2(p0[8 * k + 0], p0[8 * k + 1]); w.y = pk2(p0[8 * k + 2], p0[8 * k + 3]); w.z = pk2(p0[8 * k + 4], p0[8 * k + 5]); w.w = pk2(p0[8 * k + 6], p0[8 * k + 7]); }
        else { const int kk = k - 2; w.x = pk2(p1[8 * kk + 0], p1[8 * kk + 1]); w.y = pk2(p1[8 * kk + 2], p1[8 * kk + 3]); w.z = pk2(p1[8 * kk + 4], p1[8 * kk + 5]); w.w = pk2(p1[8 * kk + 6], p1[8 * kk + 7]); }
        pa[k] = __builtin_bit_cast(bf16x8, w);
    }
    if (!NB) {
        const bf16x8 ones = {0x3F80, 0x3F80, 0x3F80, 0x3F80, 0x3F80, 0x3F80, 0x3F80, 0x3F80};
#pragma unroll
        for (int k = 0; k < 4; ++k) LT = __builtin_amdgcn_mfma_f32_32x32x16_bf16(ones, pa[k], LT, 0, 0, 0);
    }
#pragma unroll
    for (int dd = 0; dd < DV / 64; ++dd) {
        s16x4 lo[2][4], hh[2][4];
#pragma unroll
        for (int d = 0; d < 2; ++d)
#pragma unroll
            for (int k = 0; k < 4; ++k) { lo[d][k] = vtr(Vb + (2 * dd + d) * 4096 + k * 1024); hh[d][k] = vtr(Vb + (2 * dd + d) * 4096 + k * 1024 + 512); }
        __builtin_amdgcn_sched_barrier(0);
#pragma unroll
        for (int k = 0; k < 4; ++k)
#pragma unroll
            for (int d = 0; d < 2; ++d) {
                const bf16x8 vf = {lo[d][k][0], lo[d][k][1], lo[d][k][2], lo[d][k][3], hh[d][k][0], hh[d][k][1], hh[d][k][2], hh[d][k][3]};
                OT[2 * dd + d] = __builtin_amdgcn_mfma_f32_32x32x16_bf16(vf, pa[k], OT[2 * dd + d], 0, 0, 0);
            }
    }
}

#define AT_BAR() do { asm volatile("s_waitcnt lgkmcnt(0)" ::: "memory"); __builtin_amdgcn_s_barrier(); asm volatile("" ::: "memory"); } while (0)
template <int DV, bool NB>
__device__ __forceinline__ void attn_pass(LAS unsigned char* lds, const bf16x8 (&qr)[4], const KVSrc s0, const int nt0, const KVSrc s1, const int nt1,
                                          f32x16 (&OT)[DV / 32], float& m_run, float& l_run,
                                          const int R, const int c, const int kr0) {
    constexpr int NV = DV / 64;
    const int tid = opaque_tid(), lane = tid & 63, r32 = lane & 31, hi = lane >> 5;
    const int NT = nt0 + nt1;
    const int wtype = 0;
    const int wid = __builtin_amdgcn_readfirstlane(tid >> 6);
#define AT_DMAK(t_, koff_) do { const int t__ = (t_); const bool f__ = t__ < nt0; const int tt__ = f__ ? t__ : t__ - nt0; \
        const bf16_t* kp__ = f__ ? s0.k : s1.k; const int ks__ = f__ ? s0.ks : s1.ks; \
        __builtin_amdgcn_global_load_lds((const unsigned*)(kp__ + (size_t)(tt__ * 64 + (lane ^ wid)) * ks__ + wid * 8), (LAS unsigned*)(lds + AT_K + (koff_) + wid * 1024), 16, 0, 0); } while (0)
#define AT_DMAV(t_, b_) do { const int t__ = (t_); const bool f__ = t__ < nt0; const int tt__ = f__ ? t__ : t__ - nt0; \
        const bf16_t* vp__ = f__ ? s0.v : s1.v; const int vs__ = f__ ? s0.vs : s1.vs; \
        _Pragma("unroll") for (int i__ = 0; i__ < NV; ++i__) { const int pz__ = wid + 8 * i__; \
            __builtin_amdgcn_global_load_lds((const unsigned*)(vp__ + (size_t)(tt__ * 64 + 16 * (pz__ & 3) + (lane >> 2)) * vs__ + (pz__ >> 2) * 32 + (lane & 3) * 8), \
                                             (LAS unsigned*)(lds + AT_V + (b_) * 16384 + (pz__ >> 2) * 4096 + (pz__ & 3) * 1024), 16, 0, 0); } } while (0)
#define AT_WAITV() asm volatile("s_waitcnt vmcnt(0)" ::: "memory")
    const int rs = NB ? min(max(R - 4, 0), 24) : 0;
    const int cs = NB ? min(max(c - 8, 0), 48) : 0;
    const LAS float* biasL = (const LAS float*)(lds + AT_BIAS);
    const int vlane = ((lane >> 4) & 1) * 32 + (lane & 3) * 8 + (4 * hi + ((lane & 15) >> 2)) * 64;
    int kl[4];
#pragma unroll
    for (int d0 = 0; d0 < 4; ++d0) kl[d0] = (2 * d0 + hi) * 1024 + (r32 ^ (2 * d0 + hi)) * 16;
    const LAS unsigned char* Kl = lds + AT_K;
#define AT_ACTIVE(t_) (!NB || (t_) < nt0 || (kr0 + ((t_) - nt0) >= rs && kr0 + ((t_) - nt0) < rs + 8))
    AT_DMAK(0, 0); AT_DMAV(0, 0);
    if (NT > 1) { AT_DMAK(1, 8192); AT_DMAV(1, 1); }
    if (NT > 2) AT_DMAK(2, 16384);
    AT_WAITV();
    AT_BAR();
    f32x16 p0, p1, negm = f32x16{}, LT = f32x16{};
    if (!NB) m_run = 0.f;
    if (AT_ACTIVE(0)) qk_tile(Kl, kl, qr, p0, p1, negm);
    int kcur = 0;
#define AT_STEP(t_) do { const int t = (t_); \
        const int knext = kcur == 16384 ? 0 : kcur + 8192; \
        if (AT_ACTIVE(t)) sm_pv<DV, NB>(p0, p1, lds + AT_V + (t & 1) * 16384 + vlane, OT, m_run, l_run, negm, LT, NB && t >= nt0, biasL + (kr0 + (t - nt0) - R + 7) * 31, c, cs, hi); \
        if (wtype == 0) { AT_WAITV(); AT_BAR(); if (t + 3 < NT) AT_DMAK(t + 3, kcur); if (t + 2 < NT) AT_DMAV(t + 2, t & 1); } \
        if (t + 1 < NT && AT_ACTIVE(t + 1)) qk_tile(Kl + knext, kl, qr, p0, p1, negm); \
        if (wtype != 0) { AT_WAITV(); AT_BAR(); if (t + 3 < NT) AT_DMAK(t + 3, kcur); if (t + 2 < NT) AT_DMAV(t + 2, t & 1); } \
        kcur = knext; } while (0)
    for (int t2 = 0; t2 < NT; ++t2) AT_STEP(t2);
    if (!NB) l_run = 0.5f * LT[0];
    AT_WAITV();
    AT_BAR();
#undef AT_DMAK
#undef AT_DMAV
#undef AT_WAITV
#undef AT_ACTIVE
#undef AT_STEP
}

__device__ __forceinline__ void load_q(bf16x8 (&qr)[4], const bf16_t* Q, int ldq) {
    const int tid = opaque_tid(), lane = tid & 63, r32 = lane & 31, hi = lane >> 5, wid = tid >> 6;
    const bf16_t* p = Q + (size_t)(wid * 32 + r32) * ldq + hi * 8;
#pragma unroll
    for (int d0 = 0; d0 < 4; ++d0) qr[d0] = *(const bf16x8*)(p + d0 * 16);
}
__device__ __forceinline__ void store_o64(const f32x16 (&OT)[2], float l_run, bf16_t* O  ) {
    const int tid = opaque_tid(), lane = tid & 63, r32 = lane & 31, hi = lane >> 5, wid = tid >> 6;
    const float inv = 1.f / (l_run + __shfl_xor(l_run, 32));
    bf16_t* op = O + (size_t)(wid * 32 + r32) * DM + 4 * hi;
#pragma unroll
    for (int d = 0; d < 2; ++d)
#pragma unroll
        for (int g = 0; g < 4; ++g) { u32x2 w; w.x = pk2(OT[d][4 * g] * inv, OT[d][4 * g + 1] * inv); w.y = pk2(OT[d][4 * g + 2] * inv, OT[d][4 * g + 3] * inv); *(u32x2*)(op + 32 * d + 8 * g) = w; }
}

__device__ __forceinline__ void attn_even_phase(const Args& a, LAS unsigned char* lds, int e, int vcu, int G) {
    const int tid = opaque_tid(), lane = tid & 63, r32 = lane & 31, wid = tid >> 6;
    unsigned char* ws = wsp(a);
    const bf16_t* QKV = (const bf16_t*)(ws + WS_U); bf16_t* OB = (bf16_t*)(ws + WS_O);
    for (int u = vcu; u < 1280; u += G) {
        bf16x8 qr[4]; f32x16 OT[2]; OT[0] = f32x16{}; OT[1] = f32x16{};
        float m_run = -1e30f, l_run = 0.f;
        if (u < 512) {
            const int b = u >> 6, h = (u >> 3) & 7, qb = u & 7, g = h >> 2;
            const size_t row0 = (size_t)b * 2048 + qb * 256;
            load_q(qr, QKV + row0 * NQ_E + 64 * h, NQ_E);
            const KVSrc s0{QKV + (size_t)b * 2048 * NQ_E + 512 + 64 * g, QKV + (size_t)b * 2048 * NQ_E + 640 + 64 * g, NQ_E, NQ_E};
            const size_t co = (size_t)(b * 2 + e) * 512 * 128 + 64 * g;
            const KVSrc s1{(const bf16_t*)(ws + WS_CAK) + co, (const bf16_t*)(ws + WS_CAV) + co, 128, 128};
            attn_pass<64, false>(lds, qr, s0, 32, s1, 8, OT, m_run, l_run, 0, 0, 0);
            store_o64(OT, l_run, OB + row0 * DM + 64 * h);
        } else if (u < 1024) {
            const int v = u - 512, b = v >> 6, h = (v >> 3) & 7, qb = v & 7;
            const size_t row0 = (size_t)b * 2048 + qb * 256;
            for (int i = tid; i < 465; i += 512) ((LAS float*)(lds + AT_BIAS))[i] = inp(a, 20)[(size_t)(e * 8 + h) * 465 + i] * LOG2E;
            load_q(qr, QKV + row0 * NQ_E + 768 + 64 * h, NQ_E);
            const size_t co = (size_t)(b * 2 + e) * 512 * 512 + 64 * h;
            const KVSrc s0{(const bf16_t*)(ws + WS_CBK) + co, (const bf16_t*)(ws + WS_CBV) + co, 512, 512};
            const int klo = min(max(4 * qb - 4, 0), 24), khi = min(max(4 * qb - 1, 0), 24) + 8;
            const size_t lo = ((size_t)b * 2048 + klo * 64) * NQ_E;
            const KVSrc s1{QKV + lo + 1280 + 64 * h, QKV + lo + 1792 + 64 * h, NQ_E, NQ_E};
            attn_pass<64, true>(lds, qr, s0, 8, s1, khi - klo, OT, m_run, l_run, 4 * qb + (wid >> 1), 32 * (wid & 1) + r32, klo);
            store_o64(OT, l_run, OB + row0 * DM + 512 + 64 * h);
        } else {
            const int v = u - 1024, isb = v >> 7, b = (v >> 3) & 15, h = v & 7;
            const size_t row0 = (size_t)NLAT + b * 256;
            const int qc = isb ? 768 + 64 * h : 64 * h, kc = isb ? 1280 + 64 * h : 512 + 64 * (h >> 2), vc = isb ? 1792 + 64 * h : 640 + 64 * (h >> 2);
            load_q(qr, QKV + row0 * NQ_E + qc, NQ_E);
            const KVSrc s0{QKV + row0 * NQ_E + kc, QKV + row0 * NQ_E + vc, NQ_E, NQ_E};
            attn_pass<64, false>(lds, qr, s0, 4, s0, 0, OT, m_run, l_run, 0, 0, 0);
            store_o64(OT, l_run, OB + row0 * DM + (isb ? 512 : 0) + 64 * h);
        }
    }
}

__device__ __forceinline__ void attn_odd_phase(const Args& a, LAS unsigned char* lds, int o, float lam_init, int vcu, int G) {
    const int tid = opaque_tid(), lane = tid & 63, r32 = lane & 31, hi = lane >> 5, wid = tid >> 6;
    unsigned char* ws = wsp(a);
    const bf16_t* QKV = (const bf16_t*)(ws + WS_U); bf16_t* OB = (bf16_t*)(ws + WS_O);
    const float* lp = inp(a, 23) + o * 256;
    const float lam = __expf(wave_sum(lp[lane] * lp[64 + lane])) - __expf(wave_sum(lp[128 + lane] * lp[192 + lane])) + lam_init;
    const float* sub = inp(a, 24) + o * 128;
    for (int u = vcu; u < 640; u += G) {
        int b, h, qb, nt0, nt1; size_t row0, krow0;
        if (u < 512) { b = u >> 6; h = (u >> 3) & 7; qb = u & 7; row0 = (size_t)b * 2048 + qb * 256; krow0 = (size_t)b * 2048; nt0 = 32; nt1 = 8; }
        else { const int v = u - 512; b = v >> 3; h = v & 7; qb = 0; row0 = (size_t)NLAT + b * 256; krow0 = row0; nt0 = 4; nt1 = 0; }
        LAS u32x4* o0s = (LAS u32x4*)(lds + 65536 + wid * 8192 + lane * 16);
#pragma unroll
        for (int j = 0; j < 2; ++j) {
            bf16x8 qr[4]; f32x16 OT[4];
#pragma unroll
            for (int d = 0; d < 4; ++d) OT[d] = f32x16{};
            float m_run = -1e30f, l_run = 0.f;
            load_q(qr, QKV + row0 * NQ_O + 128 * h + 64 * j, NQ_O);
            const KVSrc s0{QKV + krow0 * NQ_O + 1024 + 128 * h + 64 * j, QKV + krow0 * NQ_O + 2048 + 128 * h, NQ_O, NQ_O};
            const size_t co = (size_t)((b & 7) * 2 + o) * 512 * 1024 + 128 * h;
            const KVSrc s1{(const bf16_t*)(ws + WS_CCK) + co + 64 * j, (const bf16_t*)(ws + WS_CCV) + co, 1024, 1024};
            attn_pass<128, false>(lds, qr, s0, nt0, s1, nt1, OT, m_run, l_run, 0, 0, 0);
            const float inv = 1.f / (l_run + __shfl_xor(l_run, 32));
            if (j == 0) {
#pragma unroll
                for (int d = 0; d < 4; ++d)
#pragma unroll
                    for (int r = 0; r < 2; ++r) { u32x4 w; w.x = pk2(OT[d][8 * r] * inv, OT[d][8 * r + 1] * inv); w.y = pk2(OT[d][8 * r + 2] * inv, OT[d][8 * r + 3] * inv);
                        w.z = pk2(OT[d][8 * r + 4] * inv, OT[d][8 * r + 5] * inv); w.w = pk2(OT[d][8 * r + 6] * inv, OT[d][8 * r + 7] * inv); o0s[(d * 2 + r) * 64] = w; }
            } else {
                const float f1 = lam * inv; float ss = 0.f;
#pragma unroll
                for (int d = 0; d < 4; ++d)
#pragma unroll
                    for (int rr = 0; rr < 2; ++rr) { const u32x4 w = o0s[(d * 2 + rr) * 64];
#pragma unroll
                        for (int q = 0; q < 4; ++q) { const int r = 4 * rr + q;
                            const float a0 = __uint_as_float(w[q] << 16), a1 = __uint_as_float(w[q] & 0xffff0000u);
                            OT[d][2 * r] = a0 - OT[d][2 * r] * f1; OT[d][2 * r + 1] = a1 - OT[d][2 * r + 1] * f1;
                            ss += OT[d][2 * r] * OT[d][2 * r] + OT[d][2 * r + 1] * OT[d][2 * r + 1]; } }
                ss += __shfl_xor(ss, 32);
                const float rstd = rsqrtf(ss * (1.f / 128.f) + EPS) * (1.f - lam_init);
                bf16_t* op = OB + (row0 + wid * 32 + r32) * DM + 128 * h + 4 * hi;
#pragma unroll
                for (int d = 0; d < 4; ++d)
#pragma unroll
                    for (int g = 0; g < 4; ++g) {
                        const f32x4 sw = *(const f32x4*)(sub + 32 * d + 8 * g + 4 * hi);
                        u32x2 w; w.x = pk2(OT[d][4 * g] * rstd * sw[0], OT[d][4 * g + 1] * rstd * sw[1]); w.y = pk2(OT[d][4 * g + 2] * rstd * sw[2], OT[d][4 * g + 3] * rstd * sw[3]);
                        *(u32x2*)(op + 32 * d + 8 * g) = w;
                    }
            }
        }
    }
}

#define XB_TMO      128
#define XB_XCNT(j)  (256  + 64 * (j))
#define XB_XSUB(j)  (1280 + 64 * (j))
#define XB_XGEN(j)  (2304 + 64 * (j))
#define XB_TOP      3328
#define XB_TOPGEN   3392
#define XCD_BAR_WORDS 3456
#define XB_SPIN_CAP (1u << 18)

__device__ __forceinline__ unsigned xb_ld(unsigned* p)              { return __hip_atomic_load(p, __ATOMIC_RELAXED, __HIP_MEMORY_SCOPE_AGENT); }
__device__ __forceinline__ unsigned xb_add(unsigned* p, unsigned v) { return __hip_atomic_fetch_add(p, v, __ATOMIC_RELAXED, __HIP_MEMORY_SCOPE_AGENT); }
__device__ __forceinline__ unsigned xb_xcc_id() { return (unsigned)__builtin_amdgcn_s_getreg((3 << 11) | 20) & 0xFu; }
#define XB_SPIN(cond, bar) do { unsigned _sp = 0; while (cond) { __builtin_amdgcn_s_sleep(1); \
    if ((++_sp & 255u) == 0u) { if (xb_ld(&(bar)[XB_TMO])) break; if (_sp > XB_SPIN_CAP) { atomicAdd(&(bar)[XB_TMO], 1u); break; } } } } while (0)

struct XcdBarrier {
    unsigned* bar; unsigned x;
    volatile LAS unsigned* st;
};

__device__ __forceinline__ XcdBarrier xcd_barrier_post(unsigned* bar, volatile LAS unsigned* st) {
    XcdBarrier b; b.bar = bar; b.x = xb_xcc_id(); b.st = st;
    if (threadIdx.x == 0) (void)xb_add(&bar[XB_XCNT(b.x)], 1u);
    return b;
}
__device__ __forceinline__ void xcd_barrier_complete(unsigned* bar, unsigned x, unsigned& nloc, unsigned& nx) {
    const unsigned G = gridDim.x * gridDim.y * gridDim.z;
    unsigned sum, cnt, mine, sp = 0u;
    for (;;) {
        sum = 0u; cnt = 0u; mine = 0u;
#pragma unroll
        for (unsigned j = 0; j < 16; ++j) { const unsigned c = xb_ld(&bar[XB_XCNT(j)]); sum += c; cnt += (c > 0u) ? 1u : 0u; mine = (j == x) ? c : mine; }
        if (sum == G) break;
        __builtin_amdgcn_s_sleep(1);
        if ((++sp & 255u) == 0u) { if (xb_ld(&bar[XB_TMO])) break; if (sp > XB_SPIN_CAP) { atomicAdd(&bar[XB_TMO], 1u); break; } }
    }
    nloc = mine > 0u ? mine : 1u; nx = cnt > 0u ? cnt : 1u;
}

__device__ __forceinline__ void xcd_barrier(const XcdBarrier& b) {
    asm volatile("s_waitcnt vmcnt(0)" ::: "memory");
    __syncthreads();
    if (threadIdx.x == 0) {
        unsigned* bar = b.bar;
        __builtin_amdgcn_s_waitcnt(0);
        unsigned nloc = b.st[0], nx = b.st[1];
        if (nloc == 0u) { xcd_barrier_complete(bar, b.x, nloc, nx); b.st[0] = nloc; b.st[1] = nx; }
        const unsigned old = xb_add(&bar[XB_XSUB(b.x)], 1u);
        const unsigned gen = old / nloc;
        if (old + 1u == (gen + 1u) * nloc) {
            __builtin_amdgcn_fence(__ATOMIC_RELEASE, "agent");
            asm volatile("s_waitcnt vmcnt(0)" ::: "memory");
            const unsigned og = xb_add(&bar[XB_TOP], 1u);
            const unsigned tg = og / nx;
            if (og + 1u == (tg + 1u) * nx) xb_add(&bar[XB_TOPGEN], 1u);
            else XB_SPIN(xb_ld(&bar[XB_TOPGEN]) == tg, bar);
            __builtin_amdgcn_fence(__ATOMIC_ACQUIRE, "agent");
            xb_add(&bar[XB_XGEN(b.x)], 1u);
            asm volatile("s_waitcnt vmcnt(0)" ::: "memory");
        } else {
            XB_SPIN(xb_ld(&bar[XB_XGEN(b.x)]) == gen, bar);
            __builtin_amdgcn_fence(__ATOMIC_ACQUIRE, "agent");
            asm volatile("s_waitcnt vmcnt(0)" ::: "memory");
        }
    }
    __syncthreads();
}

__global__ void __launch_bounds__(512, 2) mega_fwd(Args a) {
    extern __shared__ __attribute__((aligned(16))) unsigned char lds_raw[];
    LAS unsigned char* lds = (LAS unsigned char*)lds_raw;
    cg::grid_group grid = cg::this_grid();
    const int G = gridDim.x; const int bx = blockIdx.x;
    const int vcu = (G % 8 == 0) ? (bx % 8) * (G / 8) + bx / 8 : bx;
    unsigned char* ws = wsp(a);
    const float* MOD = (const float*)(ws + WS_MOD);
    bf16_t* HB = (bf16_t*)(ws + WS_H); bf16_t* UB = (bf16_t*)(ws + WS_U); bf16_t* OB = (bf16_t*)(ws + WS_O); float* XB = (float*)(ws + WS_X);
    volatile LAS unsigned* bst = (volatile LAS unsigned*)(lds + 131072);
    if (threadIdx.x < 2) bst[threadIdx.x] = 0u;
    __syncthreads();
    const XcdBarrier xbar = xcd_barrier_post((unsigned*)(wsp(a) + WS_BAR), bst);
    int ph = 0;
#define GSYNC() do { if (a.ph_lo < 0) grid.sync(); else xcd_barrier(xbar); } while (0)
#ifndef DUP_MASK
#define DUP_MASK 0
#endif
#ifndef XSYNC
#define XSYNC 1
#endif
#ifndef TPROBE
#define TPROBE 0
#endif
    volatile LAS unsigned long long* tacc = (volatile LAS unsigned long long*)(lds + 131072 + 32);
    if (TPROBE && threadIdx.x == 0) { tacc[0] = 0ull; tacc[1] = 0ull; }
#define TP_BEGIN(cls) do { if (TPROBE && ((cls) & TPROBE) && blockIdx.x == 0 && threadIdx.x == 0) tacc[1] = __builtin_amdgcn_s_memrealtime(); } while (0)
#define TP_END(cls) do { if (TPROBE && ((cls) & TPROBE) && blockIdx.x == 0 && threadIdx.x == 0) tacc[0] += __builtin_amdgcn_s_memrealtime() - tacc[1]; } while (0)
#define RUNC(cls, ...) do { if (ph >= a.ph_lo && ph < a.ph_hi) { TP_BEGIN(cls); __VA_ARGS__; if (ph + 1 < a.ph_hi) GSYNC(); TP_END(cls); } ++ph; } while (0)
#define RUN(...) RUNC(8, __VA_ARGS__)
#define RUND(bit, ...) do { if (ph >= a.ph_lo && ph < a.ph_hi) { int nrep_ = (DUP_MASK & (bit)) ? 2 : 1; asm volatile("" : "+s"(nrep_)); for (int rep_ = 0; rep_ < nrep_; ++rep_) { TP_BEGIN(bit); __VA_ARGS__; if (rep_ + 1 < nrep_ || ph + 1 < a.ph_hi) { GSYNC(); if (XSYNC) { xcd_barrier(xbar); xcd_barrier(xbar); } } TP_END(bit); } } ++ph; } while (0)

#ifndef PH_MASK
#define PH_MASK 0xff
#endif
    RUND(1, if (PH_MASK & 1) prologue_phase(a, lds, vcu, G));
    RUNC(2, { bias_phase(a, lds, G); norm_phase(a, inp(a, 12), MOD, vcu, G); });
    const float* RSS = (const float*)(ws + WS_ROWSS); const float* BIASV = (const float*)(ws + WS_BIASV);
    for (int l = 0; l < 4; ++l) {
        const float* modl = MOD + (size_t)l * 9 * 9216;
        for (int half = 0; half < 2; ++half) {
            const int sub = half ? 2 : 0, lf = l * 2 + half;
            RUND(4, if (PH_MASK & 4) { pg8::Gemm g{HB, (const bf16_t*)(ws + WS_W13T) + (size_t)lf * 5632 * 1024, MROWS, 5632, 1024}; pg8::StaticOrder S; S.init(MROWS, 5632, G, bx);
                  EpiSwiGLU E{UB, RSS + (size_t)(l * 3 + sub) * MROWS, BIASV + (size_t)(l * 3 + sub) * 9 * 5632};
#if SPLIT_PROBE
                  { RangeOrder R1{S, 0, 4}; pg8::gemm_phase<EpiSwiGLU, RangeOrder, true, true>(lds, g, R1, E); xcd_barrier(xbar); RangeOrder R2{S, 4, 100}; pg8::gemm_phase<EpiSwiGLU, RangeOrder, true, true>(lds, g, R2, E); }
#else
                  pg8::gemm_phase<EpiSwiGLU, pg8::StaticOrder, true, true>(lds, g, S, E);
#endif
                  });
            RUN(if (PH_MASK & 8) { const bf16_t* W2 = (const bf16_t*)(ws + WS_W2T) + (size_t)lf * 1024 * DFF;
                  const int nl = half ? l + 1 : l, ns = half ? 0 : 1; const bool has = nl < 4;
                  EpiResid E{XB, modl + (3 * sub + 2) * 1024, 0.5f, has ? HB : nullptr, inp(a, 12) + (size_t)((has ? nl : 0) * 3 + ns) * DM,
                             MOD + (size_t)(has ? nl : 0) * 9 * 9216 + (3 * ns + 1) * 1024, (float*)(ws + WS_ROWSS) + (size_t)((has ? nl : 0) * 3 + ns) * MROWS, 0, 2};
                  { pg8::Gemm g{UB, W2, NLAT, 1024, DFF}; pg8::StaticOrder S; S.init(NLAT, 1024, G, bx);
                    pg8::gemm_phase<EpiResid, pg8::StaticOrder, true, true>(lds, g, S, E); }
                  for (int c = vcu; c < 256; c += G) small_gemm_resid(lds, UB, W2, DFF, c, E); });
            if (half == 0) {
                const int eo = l >> 1; const bool even = (l & 1) == 0;
                RUND(16, if (PH_MASK & 16) { const int nq = even ? NQ_E : NQ_O;
                      pg8::Gemm g{HB, even ? (const bf16_t*)(ws + WS_WINAB) + (size_t)eo * NQ_E * 1024 : (const bf16_t*)(ws + WS_WINC) + (size_t)eo * NQ_O * 1024, MROWS, nq, 1024};
                      pg8::StaticOrder S; S.init(MROWS, nq, G, bx);
                      EpiQKV E{UB, nq, even ? 1 : 0, eo, inp(a, 18) + eo * 64, inp(a, 19) + eo * 64, (const f32x2*)(ws + WS_ROPE), outp(a), RSS + (size_t)(l * 3 + 1) * MROWS, BIASV + (size_t)(l * 3 + 1) * 9 * 5632};
                      pg8::gemm_phase<EpiQKV, pg8::StaticOrder, true, true>(lds, g, S, E); });
                RUND(32, { if (even) { if (PH_MASK & 32) attn_even_phase(a, lds, eo, vcu, G); } else if (PH_MASK & 64) attn_odd_phase(a, lds, eo, l == 1 ? 0.35550906759096926f : 0.5560582041556405f, vcu, G); });
                RUN(if (PH_MASK & 8) { const bf16_t* WO = even ? (const bf16_t*)(ws + WS_WOUTAB) + (size_t)eo * 1024 * 1024 : (const bf16_t*)(ws + WS_WOUTC) + (size_t)eo * 1024 * 1024;
                      EpiResid E{XB, modl + 5 * 1024, 1.0f, HB, inp(a, 12) + (size_t)(l * 3 + 2) * DM, modl + 7 * 1024, (float*)(ws + WS_ROWSS) + (size_t)(l * 3 + 2) * MROWS, 0, 2};
                      { pg8::Gemm g{OB, WO, NLAT, 1024, 1024}; pg8::StaticOrder S; S.init(NLAT, 1024, G, bx);
                        pg8::gemm_phase<EpiResid, pg8::StaticOrder, true, true>(lds, g, S, E); }
                      for (int c = vcu; c < 256; c += G) small_gemm_resid(lds, OB, WO, 1024, c, E); });
            }
        }
    }
    if (TPROBE) {
        if (blockIdx.x == 0 && threadIdx.x == 0) { const unsigned long long t0 = __builtin_amdgcn_s_memrealtime(), d = tacc[0]; while (__builtin_amdgcn_s_memrealtime() - t0 < d) __builtin_amdgcn_s_sleep(8); }
        xcd_barrier(xbar);
    }
    RUNC(128, if (PH_MASK & 2) final_norm_phase(a, vcu, G));
#undef RUN
#undef RUND
#undef RUNC
}

extern "C" void kernel_launch(void* const* d_in, const int* in_sizes, int n_in, void* d_out, int out_size, void* d_ws, size_t ws_size, hipStream_t stream) {
    static int grid = 0;
    if (grid == 0) {
        int dev = 0, cus = 0, per_cu = 0;
        hipGetDevice(&dev);
        hipDeviceGetAttribute(&cus, hipDeviceAttributeMultiprocessorCount, dev);
        hipFuncSetAttribute((const void*)mega_fwd, hipFuncAttributeMaxDynamicSharedMemorySize, LDS_BYTES);
        hipOccupancyMaxActiveBlocksPerMultiprocessor(&per_cu, (const void*)mega_fwd, 512, LDS_BYTES);
        if (per_cu < 1) per_cu = 1;
        if (per_cu > 1) per_cu = 1;
        grid = cus * per_cu;
        if (n_in != 26 || ws_size < WS_END) { fprintf(stderr, "kernel_launch: unexpected n_in %d / ws %zu\n", n_in, ws_size); }
    }
    hipMemsetAsync((unsigned char*)d_ws + WS_BAR, 0, WS_BAR_BYTES, stream);
    Args a{};
    for (int i = 0; i < 26; ++i) a.in[i] = (const float*)d_in[i];
    a.out = (float*)d_out; a.ws = (unsigned char*)d_ws; a.ph_lo = 0; a.ph_hi = 1000;
    void* args[] = {&a};
    hipError_t e = hipLaunchCooperativeKernel((const void*)mega_fwd, dim3(grid), dim3(512), args, LDS_BYTES, stream);
    if (e != hipSuccess) fprintf(stderr, "cooperative launch failed: %s (grid %d)\n", hipGetErrorString(e), grid);
}
```
